# Optimizing an MI355X kernel written in HIP

```python
import math
import jax, jax.numpy as jnp
from jax import lax
import numpy as np

D_MODEL = 1024
BATCH = 8
SEQ = 4096
DEPTH = 2

HEAD_DIM = 64
N_MLSTM_HEADS = 4
N_DIL_HEADS = 6
N_SB_HEADS = 6
N_HEADS = N_MLSTM_HEADS + N_DIL_HEADS + N_SB_HEADS
D_MIX = N_HEADS * HEAD_DIM
D_ML = N_MLSTM_HEADS * HEAD_DIM
D_DIL = N_DIL_HEADS * HEAD_DIM
D_SB = N_SB_HEADS * HEAD_DIM
CONV_WIDTH = 4
MLSTM_CHUNK = 128
FGATE_BIAS_RANGE = (3.0, 6.0)
DIL_PATTERNS = ((128, 1), (512, 4), (2048, 16))
DIL_BLOCK = 128
ALIBI_MAX_BIAS = 8.0
SB_BLOCK = 128
N_EXPERTS = 16
N_GROUPS = 4
EXPERTS_PER_GROUP = N_EXPERTS // N_GROUPS
TOP_K = 2
D_EXPERT = 512
N_MOD = 6
EPS = 1e-6

OFF_ML_X = 0
OFF_ML_O = OFF_ML_X + D_ML
OFF_ML_I = OFF_ML_O + D_ML
OFF_ML_F = OFF_ML_I + N_MLSTM_HEADS
OFF_DIL = OFF_ML_F + N_MLSTM_HEADS
OFF_SB = OFF_DIL + 3 * D_DIL
D_IN_PROJ = OFF_SB + 3 * D_SB

kernel_name = 'hybrid_mlstm_dilated_stickbreaking_moe'


def rms_norm(x):
    xf = x.astype(jnp.float32)
    return xf * lax.rsqrt(jnp.mean(xf * xf, axis=-1, keepdims=True) + EPS)


def split_heads(t, n_heads):
    b, s, _ = t.shape
    return t.reshape(b, s, n_heads, HEAD_DIM).transpose(0, 2, 1, 3).astype(jnp.float32)


def mlstm_chunkwise(q, k, v, ig, lf):
    b, h, s, dh = q.shape
    nc = s // MLSTM_CHUNK

    def chunks(t):
        return jnp.moveaxis(t.reshape(b, h, nc, MLSTM_CHUNK, *t.shape[3:]), 2, 0)

    causal = jnp.tril(jnp.ones((MLSTM_CHUNK, MLSTM_CHUNK), dtype=bool))

    def step(carry, xs):
        c_st, n_st, m_st = carry
        qc, kc, vc, igc, lfc = xs
        cum = jnp.cumsum(lfc, axis=-1)
        log_d = jnp.where(causal, cum[..., :, None] - cum[..., None, :] + igc[..., None, :], -jnp.inf)
        log_inter = cum + m_st[..., None]
        m_t = jnp.maximum(log_inter, jnp.max(log_d, axis=-1))
        dmat = jnp.exp(log_d - m_t[..., None])
        inter = jnp.exp(log_inter - m_t)
        sw = jnp.einsum('bhtd,bhsd->bhts', qc, kc) * dmat
        num = inter[..., None] * jnp.einsum('bhtd,bhde->bhte', qc, c_st) + jnp.einsum('bhts,bhse->bhte', sw, vc)
        den = inter * jnp.einsum('bhtd,bhd->bht', qc, n_st) + jnp.sum(sw, axis=-1)
        h_out = num / jnp.maximum(jnp.abs(den), jnp.exp(-m_t))[..., None]
        last = cum[..., -1]
        log_w = last[..., None] - cum + igc
        m_new = jnp.maximum(last + m_st, jnp.max(log_w, axis=-1))
        w = jnp.exp(log_w - m_new[..., None])
        decay = jnp.exp(last + m_st - m_new)
        c_new = decay[..., None, None] * c_st + jnp.einsum('bhs,bhsd,bhse->bhde', w, kc, vc)
        n_new = decay[..., None] * n_st + jnp.einsum('bhs,bhsd->bhd', w, kc)
        return (c_new, n_new, m_new), h_out

    init = (jnp.zeros((b, h, dh, dh), jnp.float32), jnp.zeros((b, h, dh), jnp.float32),
            jnp.zeros((b, h), jnp.float32))
    _, hs = lax.scan(step, init, (chunks(q), chunks(k), chunks(v), chunks(ig), chunks(lf)))
    return jnp.moveaxis(hs, 0, 2).reshape(b, h, s, dh)


def mlstm_mixer(u, conv_w, conv_b, w_mq, w_mk, w_mv, gate_bias):
    xm = u[..., OFF_ML_X:OFF_ML_X + D_ML]
    xc = lax.conv_general_dilated(xm, conv_w[:, None, :].astype(xm.dtype), (1,), [(CONV_WIDTH - 1, 0)],
                                  dimension_numbers=('NWC', 'WIO', 'NWC'), feature_group_count=D_ML)
    xc = jax.nn.silu(xc + conv_b)
    xc_h = split_heads(xc, N_MLSTM_HEADS)
    q = jnp.einsum('bhsd,hde->bhse', xc_h, w_mq).astype(jnp.float32)
    k = (jnp.einsum('bhsd,hde->bhse', xc_h, w_mk) * HEAD_DIM ** -0.5).astype(jnp.float32)
    v = jnp.einsum('bhsd,hde->bhse', split_heads(xm, N_MLSTM_HEADS), w_mv).astype(jnp.float32)
    ig = (u[..., OFF_ML_I:OFF_ML_I + N_MLSTM_HEADS] + gate_bias[0]).astype(jnp.float32).transpose(0, 2, 1)
    lf = jax.nn.log_sigmoid((u[..., OFF_ML_F:OFF_ML_F + N_MLSTM_HEADS] + gate_bias[1]).astype(jnp.float32)).transpose(0, 2, 1)
    o = jax.nn.sigmoid(split_heads(u[..., OFF_ML_O:OFF_ML_O + D_ML], N_MLSTM_HEADS))
    return o * mlstm_chunkwise(q, k, v, ig, lf)


def dilated_pattern(q, k, v, slopes, window, dilation):
    b, h, s, dh = q.shape
    length = s // dilation
    span = window // dilation
    bq = math.gcd(length, DIL_BLOCK)
    nblk = length // bq

    def by_residue(t):
        return t.reshape(b, h, length, dilation, dh).transpose(0, 1, 3, 2, 4)

    pad = ((0, 0), (0, 0), (0, 0), (span, 0), (0, 0))
    qb = by_residue(q).reshape(b, h, dilation, nblk, bq, dh)
    kp = jnp.pad(by_residue(k), pad)
    vp = jnp.pad(by_residue(v), pad)
    key_idx = jnp.arange(nblk)[:, None] * bq + jnp.arange(bq + span)[None, :]
    kb = kp[:, :, :, key_idx, :]
    vb = vp[:, :, :, key_idx, :]
    steps = jnp.arange(bq)[:, None] - jnp.arange(bq + span)[None, :] + span
    key_pos = key_idx[:, None, :] - span
    valid = (steps >= 0) & (steps <= span) & (key_pos >= 0)
    scores = jnp.einsum('bhrnqd,bhrnkd->bhrnqk', qb, kb) * HEAD_DIM ** -0.5
    scores = scores - slopes[None, :, None, None, None, None] * (steps * dilation).astype(jnp.float32)
    scores = jnp.where(valid, scores, -jnp.inf)
    mx = jnp.max(scores, axis=-1, keepdims=True)
    p = jnp.exp(scores - mx)
    den = jnp.sum(p, axis=-1)
    out = jnp.einsum('bhrnqk,bhrnkd->bhrnqd', p, vb) / den[..., None]
    lse = mx[..., 0] + jnp.log(den)
    out = out.reshape(b, h, dilation, length, dh).transpose(0, 1, 3, 2, 4).reshape(b, h, s, dh)
    lse = lse.reshape(b, h, dilation, length).transpose(0, 1, 3, 2).reshape(b, h, s)
    return out, lse


def dilated_mixer(u):
    q = split_heads(u[..., OFF_DIL:OFF_DIL + D_DIL], N_DIL_HEADS)
    k = split_heads(u[..., OFF_DIL + D_DIL:OFF_DIL + 2 * D_DIL], N_DIL_HEADS)
    v = split_heads(u[..., OFF_DIL + 2 * D_DIL:OFF_DIL + 3 * D_DIL], N_DIL_HEADS)
    slopes = jnp.exp2(-ALIBI_MAX_BIAS * jnp.arange(1, N_DIL_HEADS + 1, dtype=jnp.float32) / N_DIL_HEADS)
    outs, lses = [], []
    for window, dilation in DIL_PATTERNS:
        o, l = dilated_pattern(q, k, v, slopes, window, dilation)
        outs.append(o)
        lses.append(l)
    weights = jax.nn.softmax(jnp.stack(lses), axis=0)
    return jnp.einsum('pbhs,pbhsd->bhsd', weights, jnp.stack(outs))


def stick_breaking_mixer(u):
    q = split_heads(u[..., OFF_SB:OFF_SB + D_SB], N_SB_HEADS)
    k = split_heads(u[..., OFF_SB + D_SB:OFF_SB + 2 * D_SB], N_SB_HEADS)
    v = split_heads(u[..., OFF_SB + 2 * D_SB:OFF_SB + 3 * D_SB], N_SB_HEADS)
    b, h, s, dh = q.shape
    nblk = s // SB_BLOCK
    qb = jnp.moveaxis(q.reshape(b, h, nblk, SB_BLOCK, dh), 2, 0)
    key_pos = jnp.arange(s)

    def block(args):
        qblk, bi = args
        z = jnp.einsum('bhqd,bhkd->bhqk', qblk, k) * HEAD_DIM ** -0.5
        qpos = bi * SB_BLOCK + jnp.arange(SB_BLOCK)
        causal = key_pos[None, :] < qpos[:, None]
        log_keep = jnp.where(causal, jax.nn.log_sigmoid(-z), 0.0)
        log_rest = lax.cumsum(log_keep, axis=3, reverse=True) - log_keep
        a = jnp.where(causal, jnp.exp(jax.nn.log_sigmoid(z) + log_rest), 0.0)
        return jnp.einsum('bhqk,bhkd->bhqd', a, v)

    ob = lax.map(block, (qb, jnp.arange(nblk)))
    return jnp.moveaxis(ob, 0, 2).reshape(b, h, s, dh)


def routed_moe(h, w_router, router_bias, w_gate_e, w_up_e, w_down_e):
    b, s, d = h.shape
    t = h.reshape(b * s, d)
    scores = jax.nn.sigmoid((t @ w_router).astype(jnp.float32))
    grouped = (scores + router_bias).reshape(-1, N_GROUPS, EXPERTS_PER_GROUP)
    group_score = jnp.sum(lax.top_k(grouped, TOP_K)[0], axis=-1)
    _, g_sel = lax.top_k(group_score, 1)
    in_group = jnp.take_along_axis(grouped, g_sel[:, :, None], axis=1)[:, 0]
    _, e_loc = lax.top_k(in_group, TOP_K)
    e_idx = g_sel * EXPERTS_PER_GROUP + e_loc
    w = jnp.take_along_axis(scores, e_idx, axis=1)
    w = w / jnp.sum(w, axis=-1, keepdims=True)
    combine = jnp.einsum('tk,tke->te', w, jax.nn.one_hot(e_idx, N_EXPERTS, dtype=jnp.float32))
    y = jnp.zeros((b * s, d), jnp.float32)
    for e in range(N_EXPERTS):
        he = jax.nn.silu(t @ w_gate_e[e]) * (t @ w_up_e[e])
        y = y + combine[:, e:e + 1] * (he @ w_down_e[e])
    return y.reshape(b, s, d)


def setup_inputs(seed: int = 0) -> dict:
    key = jax.random.key(seed)
    ks = jax.random.split(key, 20)
    f32 = jnp.float32

    def nrm(k, shape, scale):
        return jax.random.normal(k, shape, f32) * scale

    fgate = jnp.linspace(FGATE_BIAS_RANGE[0], FGATE_BIAS_RANGE[1], N_MLSTM_HEADS, dtype=f32)
    gate_bias = jnp.stack([nrm(ks[8], (DEPTH, N_MLSTM_HEADS), 0.1),
                           fgate[None, :] + nrm(ks[9], (DEPTH, N_MLSTM_HEADS), 0.1)], axis=1)
    return {
        'x': nrm(ks[0], (BATCH, SEQ, D_MODEL), 1.0),
        'c': nrm(ks[1], (BATCH, D_MODEL), 1.0),
        'w_in': nrm(ks[2], (DEPTH, D_MODEL, D_IN_PROJ), D_MODEL ** -0.5),
        'conv_w': nrm(ks[3], (DEPTH, CONV_WIDTH, D_ML), CONV_WIDTH ** -0.5),
        'conv_b': nrm(ks[4], (DEPTH, D_ML), 0.02),
        'w_mq': nrm(ks[5], (DEPTH, N_MLSTM_HEADS, HEAD_DIM, HEAD_DIM), HEAD_DIM ** -0.5),
        'w_mk': nrm(ks[6], (DEPTH, N_MLSTM_HEADS, HEAD_DIM, HEAD_DIM), HEAD_DIM ** -0.5),
        'w_mv': nrm(ks[7], (DEPTH, N_MLSTM_HEADS, HEAD_DIM, HEAD_DIM), HEAD_DIM ** -0.5),
        'gate_bias': gate_bias,
        'g_head': 1.0 + nrm(ks[10], (DEPTH, D_MIX), 0.02),
        'w_out': nrm(ks[11], (DEPTH, D_MIX, D_MODEL), D_MIX ** -0.5),
        'w_ada': nrm(ks[12], (DEPTH, D_MODEL, N_MOD * D_MODEL), 0.5 * D_MODEL ** -0.5),
        'b_ada': nrm(ks[13], (DEPTH, N_MOD * D_MODEL), 0.02),
        'w_router': nrm(ks[14], (D_MODEL, N_EXPERTS), D_MODEL ** -0.5),
        'router_bias': nrm(ks[15], (N_EXPERTS,), 0.01),
        'w_gate_e': nrm(ks[16], (DEPTH, N_EXPERTS, D_MODEL, D_EXPERT), D_MODEL ** -0.5),
        'w_up_e': nrm(ks[17], (DEPTH, N_EXPERTS, D_MODEL, D_EXPERT), D_MODEL ** -0.5),
        'w_down_e': nrm(ks[18], (DEPTH, N_EXPERTS, D_EXPERT, D_MODEL), D_EXPERT ** -0.5),
        'g_final': 1.0 + nrm(ks[19], (D_MODEL,), 0.02),
    }


def reference(x, c, w_in, conv_w, conv_b, w_mq, w_mk, w_mv, gate_bias, g_head, w_out,
              w_ada, b_ada, w_router, router_bias, w_gate_e, w_up_e, w_down_e, g_final):
    b, s, _ = x.shape
    c_act = jax.nn.silu(c.astype(jnp.float32))
    for l in range(DEPTH):
        mod = c_act @ w_ada[l] + b_ada[l]
        shift1, scale1, gate1, shift2, scale2, gate2 = [m[:, None, :] for m in jnp.split(mod, N_MOD, axis=-1)]
        h = rms_norm(x) * (1.0 + scale1) + shift1
        u = h @ w_in[l]
        y_ml = mlstm_mixer(u, conv_w[l], conv_b[l], w_mq[l], w_mk[l], w_mv[l], gate_bias[l])
        y_dil = dilated_mixer(u)
        y_sb = stick_breaking_mixer(u)
        y = jnp.concatenate([y_ml, y_dil, y_sb], axis=1)
        y = rms_norm(y) * g_head[l].reshape(N_HEADS, 1, HEAD_DIM)
        y = y.transpose(0, 2, 1, 3).reshape(b, s, D_MIX) @ w_out[l]
        x = x + gate1 * y
        h = rms_norm(x) * (1.0 + scale2) + shift2
        x = x + gate2 * routed_moe(h, w_router, router_bias, w_gate_e[l], w_up_e[l], w_down_e[l])
    return rms_norm(x) * g_final
```

```cpp
#include <hip/hip_runtime.h>
#include <stdint.h>
#include <stdio.h>

#define T_TOK 32768
#define SEQ 4096
#define DM 1024
#define NB 8
#define DIN 2824
#define LDU 2816
#define OFF_ML_X 0
#define OFF_ML_O 256
#define OFF_DIL 512
#define OFF_SB 1664
#define NMOD 6144
#define EPS 1e-6f
#define NBUCK 24

#define LAS __attribute__((address_space(3)))
typedef unsigned short bf16_t;
typedef short bf16x8 __attribute__((ext_vector_type(8)));
typedef float f32x4 __attribute__((ext_vector_type(4)));
typedef float f32x2 __attribute__((ext_vector_type(2)));
typedef unsigned u32x4 __attribute__((ext_vector_type(4)));
typedef unsigned u32x2 __attribute__((ext_vector_type(2)));

__device__ __forceinline__ float bf2f(bf16_t v) { return __uint_as_float(((unsigned)v) << 16); }
__device__ __forceinline__ unsigned f2bf_u(float f) { unsigned u = __float_as_uint(f); return (u + 0x7fffu + ((u >> 16) & 1u)) >> 16; }
__device__ __forceinline__ bf16_t f2bf(float f) { return (bf16_t)f2bf_u(f); }
__device__ __forceinline__ unsigned pk2(float lo, float hi) { return f2bf_u(lo) | (f2bf_u(hi) << 16); }
__device__ __forceinline__ float wave_sum(float v) {
#pragma unroll
    for (int o = 32; o > 0; o >>= 1) v += __shfl_xor(v, o, 64);
    return v;
}
__device__ __forceinline__ int lane_id_opaque() { int r; asm volatile("v_mbcnt_lo_u32_b32 %0, -1, 0\n\tv_mbcnt_hi_u32_b32 %0, -1, %0" : "=v"(r)); return r; }
__device__ __forceinline__ float wave_sum_l(float v, int lane) {
#pragma unroll
    for (int o = 32; o > 0; o >>= 1) v += __int_as_float(__builtin_amdgcn_ds_bpermute((lane ^ o) << 2, __float_as_int(v)));
    return v;
}
__device__ __forceinline__ float sigmoidf_(float x) { return 1.f / (1.f + __expf(-x)); }
__device__ __forceinline__ float softplusf_(float z) { return fmaxf(z, 0.f) + log1pf(__expf(-fabsf(z))); }

constexpr size_t MiB = 1u << 20;
constexpr size_t WS_CTL   = 0;
constexpr size_t CTL_BYTES = 1 * MiB;
constexpr size_t WS_MOD   = 1 * MiB;
constexpr size_t WS_GATE  = WS_MOD + 512 * 1024;
constexpr size_t WS_RW    = WS_GATE + 1 * MiB;
constexpr size_t WS_LIST  = WS_RW + 256 * 1024;
constexpr size_t WS_WIN   = 6 * MiB;
constexpr size_t WS_WOUT  = 17 * MiB;
constexpr size_t WS_WGU   = 21 * MiB;
constexpr size_t WS_WD    = 85 * MiB;
constexpr size_t WS_H     = 117 * MiB;
constexpr size_t WS_U     = 181 * MiB;
constexpr size_t WS_Y     = 357 * MiB;
constexpr size_t WS_QKV   = 421 * MiB;
constexpr size_t WS_OP01  = WS_H;
constexpr size_t WS_CLOC  = WS_H + 48 * MiB;
constexpr size_t WS_OP2   = 469 * MiB;
constexpr size_t WS_LSE   = 493 * MiB;
constexpr size_t WS_CT    = 496 * MiB;
constexpr size_t WS_MLS   = 504 * MiB;
constexpr size_t WS_END   = 507 * MiB;
constexpr size_t MLS_CUM = 0, MLS_AA = 512 * 1024, MLS_PM = 1024 * 1024, MLS_NLOC = 1536 * 1024, MLS_NC = 1792 * 1024, MLS_AMAX = 2048 * 1024, MLS_LSUM = 2052 * 1024, MLS_MC = 2056 * 1024, MLS_WT = 2304 * 1024;

constexpr int CW_BAR = 4096;
constexpr int CW_CNT = 8192;

namespace pg8 {
constexpr int BM = 256, BK = 64, HALF = 128, HTB = HALF * BK * 2, STAGE_BYTES = 8 * HTB, NXCD = 8, WGM = 8;
__host__ __device__ __forceinline__ int lds_byte(int r, int c) { const int st = (r >> 4) * 2 + (c >> 5), rr = r & 15, cc = c & 31, ob = rr * 64 + cc * 2; return st * 1024 + (ob ^ (((ob >> 9) & 1) << 5)); }
__host__ __device__ __forceinline__ void stage_rc(int b, int& R, int& C) { const int st = b / 1024, sb = b % 1024, swz = sb ^ (((sb >> 9) & 1) << 5); R = (st >> 1) * 16 + swz / 64; C = (st & 1) * 32 + (swz % 64) / 2; }
__host__ __device__ __forceinline__ int perm32(int rho) { const int n = rho >> 4, i = rho & 15; return 8 * (i >> 2) + 4 * n + (i & 3); }
struct Unit { int pm, pn; };
struct StaticOrder {
    int nM, nN, nwg, G, c;
    __device__ void init(int nM_, int nN_, int G_, int c_) { nM = nM_; nN = nN_; nwg = nM * nN; G = G_; c = c_; }
    __device__ bool next(int i, Unit& u) const {
        const long L = (long)i * G + c; if (L >= nwg) return false;
        int wgid = (int)L; { const int q = nwg / NXCD, r = nwg % NXCD, xcd = wgid % NXCD, off = wgid / NXCD; wgid = (xcd < r ? xcd * (q + 1) : r * (q + 1) + (xcd - r) * q) + off; }
        const int nig = WGM * nN, gid = wgid / nig, fm = gid * WGM, gsz = (nM - fm) < WGM ? (nM - fm) : WGM;
        u.pm = fm + ((wgid % nig) % gsz); u.pn = (wgid % nig) / gsz; return true;
    }
};
__device__ __forceinline__ unsigned cvt_pk_bf16(float lo, float hi) { unsigned r; asm volatile("v_cvt_pk_bf16_f32 %0, %1, %2" : "=v"(r) : "v"(lo), "v"(hi)); return r; }

template <class P, class Epi, class Sched>
__device__ __forceinline__ void gemm_phase(LAS unsigned char* lds, const P& pb, const Sched& S, const Epi& E, int wave_) {
    const int tid_ = wave_ * 64 + lane_id_opaque();
    const int tid = tid_, wid = __builtin_amdgcn_readfirstlane(tid >> 6), lane = tid & 63, wr = wid >> 2, wc = wid & 3, fr = lane & 15, fq = lane >> 4;
    const int nt = pb.nt();
    unsigned voffB[2];
#pragma unroll
    for (int i = 0; i < 2; ++i) { int R, C; stage_rc(tid * 16 + i * 8192, R, C); const int Rb = Epi::PERM ? ((R & ~31) + perm32(R & 31)) : R; voffB[i] = (unsigned)(Rb * pb.ldb() + C) * 2u; }
    const size_t hstepB = (size_t)HALF * pb.ldb() * 2;
    const unsigned ldsw = (unsigned)wid * 1024u;
    const int aoff = lds_byte(wr * 64 + fr, fq * 8), boff = lds_byte(wc * 32 + fr, fq * 8);
#define PG8_SA(b, h) (((b) * 2 + (h)) * HTB)
#define PG8_SB(b, h) ((4 + (b) * 2 + (h)) * HTB)
#define PG8_STAGE(bufoff, gbase, voff) do { _Pragma("unroll") for (int _i = 0; _i < 2; ++_i) \
        __builtin_amdgcn_global_load_lds((const unsigned*)((const char*)(gbase) + (voff)[_i]), (LAS unsigned*)(lds + (bufoff) + ldsw + _i * 8192), 16, 0, 0); } while (0)
#define PG8_LDA(dst, b, h) do { _Pragma("unroll") for (int m = 0; m < 4; ++m) _Pragma("unroll") for (int k = 0; k < 2; ++k) dst[m][k] = *(const LAS bf16x8*)(lds + PG8_SA(b, h) + aoff + m * 2048 + k * 1024); } while (0)
#define PG8_LDB(dst, b, h) do { _Pragma("unroll") for (int n = 0; n < 2; ++n) _Pragma("unroll") for (int k = 0; k < 2; ++k) dst[n][k] = *(const LAS bf16x8*)(lds + PG8_SB(b, h) + boff + n * 2048 + k * 1024); } while (0)
#define PG8_MMA(ai, bj, At, Bt) do { __builtin_amdgcn_s_setprio(1); _Pragma("unroll") for (int m = 0; m < 4; ++m) _Pragma("unroll") for (int n = 0; n < 2; ++n) _Pragma("unroll") for (int k = 0; k < 2; ++k) \
        acc[ai][bj][m][n] = __builtin_amdgcn_mfma_f32_16x16x32_bf16(Bt[n][k], At[m][k], acc[ai][bj][m][n], 0, 0, 0); __builtin_amdgcn_s_setprio(0); } while (0)
#define PG8_WAIT_V(n) asm volatile("s_waitcnt vmcnt(" #n ")" ::: "memory")
#define PG8_WAIT_L(n) asm volatile("s_waitcnt lgkmcnt(" #n ")" ::: "memory")
#define PG8_BAR __builtin_amdgcn_s_barrier()
#define PG8_SCHED __builtin_amdgcn_sched_barrier(0)
#define PG8_AOFF(dst, u) do { int _t = tid; asm volatile("" : "+v"(_t)); _Pragma("unroll") for (int _i = 0; _i < 2; ++_i) { int _R, _C; stage_rc(_t * 16 + _i * 8192, _R, _C); \
        _Pragma("unroll") for (int _h = 0; _h < 2; ++_h) dst[_h][_i] = pb.a_row(u, _h * HALF + _R) + (unsigned)_C * 2u; } } while (0)
    Unit cur, nxt; int ui = 0;
    if (!S.next(0, cur)) return;
    f32x4 acc[2][2][4][2];
#pragma unroll
    for (int a = 0; a < 2; ++a)
#pragma unroll
        for (int b = 0; b < 2; ++b)
#pragma unroll
            for (int m = 0; m < 4; ++m)
#pragma unroll
                for (int n = 0; n < 2; ++n) acc[a][b][m][n] = (f32x4){0.f, 0.f, 0.f, 0.f};
    bf16x8 At[4][2], B0[2][2], B1[2][2];
    unsigned ca[2][2], na[2][2];
    PG8_AOFF(ca, cur);
    const char* Ab = pb.a_base();
    {
        const char* b0 = pb.b_tile(cur, 0); const char* b1 = pb.b_tile(cur, 1);
        PG8_STAGE(PG8_SB(0, 0), b0, voffB); PG8_STAGE(PG8_SB(0, 1), b0 + hstepB, voffB); PG8_STAGE(PG8_SA(0, 0), Ab, ca[0]); PG8_STAGE(PG8_SA(0, 1), Ab, ca[1]);
        if (wr == 1) PG8_BAR;
        PG8_WAIT_V(2); PG8_BAR;
        PG8_STAGE(PG8_SB(1, 0), b1, voffB); PG8_STAGE(PG8_SA(1, 0), Ab + 128, ca[0]); PG8_STAGE(PG8_SB(1, 1), b1 + hstepB, voffB);
        PG8_WAIT_V(6); PG8_BAR;
    }
    for (;;) {
        const bool has_next = S.next(ui + 1, nxt);
        if (!has_next) nxt = cur;
        PG8_AOFF(na, nxt);
#define PG8_KPAIR(A2BASE, OFF2, B2, B3, A1P) do { \
              \
            PG8_LDB(B0, 0, 0); PG8_LDB(B1, 0, 1); PG8_SCHED; PG8_LDA(At, 0, 0); PG8_STAGE(PG8_SA(1, 1), A1P, ca[1]); \
            PG8_WAIT_V(8); PG8_WAIT_L(0); PG8_BAR; PG8_MMA(0, 0, At, B0); PG8_MMA(0, 1, At, B1); PG8_BAR; PG8_SCHED; \
              \
            PG8_LDA(At, 0, 1); PG8_STAGE(PG8_SB(0, 0), B2, voffB); PG8_STAGE(PG8_SB(0, 1), (B2) + hstepB, voffB); PG8_STAGE(PG8_SA(0, 0), A2BASE, OFF2[0]); \
            PG8_WAIT_V(8); PG8_WAIT_L(0); PG8_BAR; PG8_MMA(1, 0, At, B0); PG8_MMA(1, 1, At, B1); PG8_BAR; PG8_SCHED; \
              \
            PG8_LDB(B0, 1, 0); PG8_LDB(B1, 1, 1); PG8_SCHED; PG8_LDA(At, 1, 0); PG8_STAGE(PG8_SA(0, 1), A2BASE, OFF2[1]); \
            PG8_WAIT_V(8); PG8_WAIT_L(0); PG8_BAR; PG8_MMA(0, 0, At, B0); PG8_MMA(0, 1, At, B1); PG8_BAR; PG8_SCHED; \
              \
            PG8_LDA(At, 1, 1); PG8_STAGE(PG8_SB(1, 0), B3, voffB); PG8_STAGE(PG8_SB(1, 1), (B3) + hstepB, voffB); PG8_STAGE(PG8_SA(1, 0), (A2BASE) + 128, OFF2[0]); \
            PG8_WAIT_V(8); PG8_WAIT_L(0); PG8_BAR; PG8_MMA(1, 0, At, B0); PG8_MMA(1, 1, At, B1); PG8_BAR; PG8_SCHED; } while (0)
        for (int t = 0; t < nt - 2; t += 2) {
            const char* b2 = pb.b_tile(cur, t + 2); const char* b3 = pb.b_tile(cur, t + 3);
            const char* a1p = Ab + (size_t)(t + 1) * 128; const char* a2p = Ab + (size_t)(t + 2) * 128;
            PG8_KPAIR(a2p, ca, b2, b3, a1p);
        }
        {
            const char* b2 = pb.b_tile(nxt, 0); const char* b3 = pb.b_tile(nxt, 1);
            const char* a1p = Ab + (size_t)(nt - 1) * 128;
            PG8_KPAIR(Ab, na, b2, b3, a1p);
        }
#undef PG8_KPAIR
        if (wr == 0) PG8_BAR;
        E(acc, cur, wr, wc, fr, fq);
        if (!has_next) break;
#pragma unroll
        for (int a = 0; a < 2; ++a)
#pragma unroll
            for (int b = 0; b < 2; ++b)
#pragma unroll
                for (int m = 0; m < 4; ++m)
#pragma unroll
                    for (int n = 0; n < 2; ++n) acc[a][b][m][n] = (f32x4){0.f, 0.f, 0.f, 0.f};
        cur = nxt;
#pragma unroll
        for (int h = 0; h < 2; ++h)
#pragma unroll
            for (int i = 0; i < 2; ++i) ca[h][i] = na[h][i];
        ++ui;
        if (wr == 1) PG8_BAR;
    }
    PG8_WAIT_V(0);
    PG8_BAR;
#undef PG8_SA
#undef PG8_SB
#undef PG8_STAGE
#undef PG8_LDA
#undef PG8_LDB
#undef PG8_MMA
#undef PG8_WAIT_V
#undef PG8_WAIT_L
#undef PG8_BAR
#undef PG8_SCHED
#undef PG8_AOFF
}
}
using pg8::Unit;

struct ProbDense {
    const char* A; const char* B; int K;
    __device__ __forceinline__ int nt() const { return K / 64; }
    __device__ __forceinline__ int ldb() const { return K; }
    __device__ __forceinline__ const char* a_base() const { return A; }
    __device__ __forceinline__ unsigned a_row(const Unit& u, int r) const { return (unsigned)((u.pm * 256 + r) * K) * 2u; }
    __device__ __forceinline__ const char* b_tile(const Unit& u, int t) const { return B + (size_t)u.pn * 256 * K * 2 + (size_t)t * 128; }
};
__device__ __forceinline__ int bucket_e0(int k) { const int g = k / 6, p = k % 6; return 4 * g + (p < 3 ? 0 : (p < 5 ? 1 : 2)); }
__device__ __forceinline__ int bucket_e1(int k) { const int g = k / 6, p = k % 6; return 4 * g + (p < 3 ? p + 1 : (p < 5 ? p - 1 : 3)); }
struct ProbGU {
    const char* H; const char* W; const int* list; const LAS int* tab;
    __device__ __forceinline__ int nt() const { return 16; }
    __device__ __forceinline__ int ldb() const { return 1024; }
    __device__ __forceinline__ const char* a_base() const { return H; }
    __device__ __forceinline__ unsigned a_row(const Unit& u, int r) const {
        const int k = tab[32 + u.pm], rr = tab[192 + u.pm] + r; int tok = 0; if (rr < tab[k]) tok = list[(size_t)k * T_TOK + rr]; return (unsigned)tok * 2048u; }
    __device__ __forceinline__ const char* b_tile(const Unit& u, int t) const {
        const int k = __builtin_amdgcn_readfirstlane(tab[32 + u.pm]); const int e = (u.pn < 4) ? bucket_e0(k) : bucket_e1(k);
        return W + (size_t)e * (1024 * 1024 * 2) + (size_t)(u.pn & 3) * 256 * 2048 + (size_t)t * 128; }
};
struct ProbDown {
    const char* HE; const char* W; const LAS int* tab;
    __device__ __forceinline__ int nt() const { return 16; }
    __device__ __forceinline__ int ldb() const { return 512; }
    __device__ __forceinline__ const char* a_base() const { return HE; }
    __device__ __forceinline__ unsigned a_row(const Unit& u, int r) const { return (unsigned)(u.pm * 256 + r) * 2048u; }
    __device__ __forceinline__ const char* b_tile(const Unit& u, int t) const {
        const int k = __builtin_amdgcn_readfirstlane(tab[32 + u.pm]); const int e = (t < 8) ? bucket_e0(k) : bucket_e1(k);
        return W + (size_t)e * (1024 * 512 * 2) + (size_t)u.pn * 256 * 1024 + (size_t)(t & 7) * 128; }
};

struct EpiU {
    static constexpr bool PERM = true;
    bf16_t* O;
    __device__ __forceinline__ void operator()(const f32x4 (&acc)[2][2][4][2], const Unit& u, int wr, int wc, int fr, int fq) const {
        const int row0 = u.pm * 256 + wr * 64 + fr, col0 = u.pn * 256 + wc * 32 + 8 * fq;
#pragma unroll
        for (int ai = 0; ai < 2; ++ai)
#pragma unroll
            for (int m = 0; m < 4; ++m) { bf16_t* rowp = O + (size_t)(row0 + ai * 128 + m * 16) * LDU + col0;
#pragma unroll
                for (int bj = 0; bj < 2; ++bj) { const f32x4 v0 = acc[ai][bj][m][0], v1 = acc[ai][bj][m][1];
                    u32x4 w; w.x = pg8::cvt_pk_bf16(v0[0], v0[1]); w.y = pg8::cvt_pk_bf16(v0[2], v0[3]); w.z = pg8::cvt_pk_bf16(v1[0], v1[1]); w.w = pg8::cvt_pk_bf16(v1[2], v1[3]);
                    *(u32x4*)(rowp + bj * 128) = w; } }
    }
};
struct EpiOut {
    static constexpr bool PERM = false;
    const float* xin; float* X; const float* gate;
    __device__ __forceinline__ void operator()(const f32x4 (&acc)[2][2][4][2], const Unit& u, int wr, int wc, int fr, int fq) const {
        const int b = (u.pm * 256) / SEQ; const int col0 = u.pn * 256 + wc * 32 + 4 * fq;
        f32x4 gv[2][2];
#pragma unroll
        for (int bj = 0; bj < 2; ++bj)
#pragma unroll
            for (int n = 0; n < 2; ++n) gv[bj][n] = *(const f32x4*)(gate + (size_t)b * NMOD + col0 + bj * 128 + n * 16);
#pragma unroll
        for (int ai = 0; ai < 2; ++ai)
#pragma unroll
            for (int m = 0; m < 4; ++m) { const size_t off = (size_t)(u.pm * 256 + ai * 128 + wr * 64 + m * 16 + fr) * DM + col0;
#pragma unroll
                for (int bj = 0; bj < 2; ++bj)
#pragma unroll
                    for (int n = 0; n < 2; ++n) { const f32x4 xi = *(const f32x4*)(xin + off + bj * 128 + n * 16); *(f32x4*)(X + off + bj * 128 + n * 16) = xi + gv[bj][n] * acc[ai][bj][m][n]; } }
    }
};
struct EpiGU {
    static constexpr bool PERM = true;
    bf16_t* HE; const int* list; const float* rw; const LAS int* tab;
    __device__ __forceinline__ void operator()(const f32x4 (&acc)[2][2][4][2], const Unit& u, int wr, int wc, int fr, int fq) const {
        const int k = tab[32 + u.pm], r0 = tab[192 + u.pm], cnt = tab[k]; const int part = u.pn >> 2;
        const int hcol0 = part * 512 + ((u.pn & 3) * 256 + wc * 32 + 8 * fq) / 2;
#pragma unroll
        for (int ai = 0; ai < 2; ++ai)
#pragma unroll
            for (int m = 0; m < 4; ++m) { const int r = ai * 128 + wr * 64 + m * 16 + fr; const int rr = r0 + r;
                if (rr < cnt) { const int tok = list[(size_t)k * T_TOK + rr]; const float w = rw[tok * 2 + part];
                    bf16_t* rowp = HE + (size_t)(u.pm * 256 + r) * 1024 + hcol0;
#pragma unroll
                    for (int bj = 0; bj < 2; ++bj) { const f32x4 v0 = acc[ai][bj][m][0], v1 = acc[ai][bj][m][1];
                        const float h0 = v0[0] * sigmoidf_(v0[0]) * v0[1] * w, h1 = v0[2] * sigmoidf_(v0[2]) * v0[3] * w, h2 = v1[0] * sigmoidf_(v1[0]) * v1[1] * w, h3 = v1[2] * sigmoidf_(v1[2]) * v1[3] * w;
                        u32x2 o; o.x = pg8::cvt_pk_bf16(h0, h1); o.y = pg8::cvt_pk_bf16(h2, h3);
                        *(u32x2*)(rowp + bj * 64) = o; } } }
    }
};
struct EpiDown {
    static constexpr bool PERM = false;
    float* X; const int* list; const float* gate; const LAS int* tab;
    __device__ __forceinline__ void operator()(const f32x4 (&acc)[2][2][4][2], const Unit& u, int wr, int wc, int fr, int fq) const {
        const int k = tab[32 + u.pm], r0 = tab[192 + u.pm], cnt = tab[k]; const int col0 = u.pn * 256 + wc * 32 + 4 * fq;
#pragma unroll
        for (int ai = 0; ai < 2; ++ai)
#pragma unroll
            for (int m = 0; m < 4; ++m) { const int rr = r0 + ai * 128 + wr * 64 + m * 16 + fr;
                if (rr < cnt) { const int tok = list[(size_t)k * T_TOK + rr]; const int b = tok / SEQ; float* xr = X + (size_t)tok * DM + col0; const float* gr = gate + (size_t)b * NMOD + col0;
#pragma unroll
                    for (int bj = 0; bj < 2; ++bj)
#pragma unroll
                        for (int n = 0; n < 2; ++n) { const f32x4 g = *(const f32x4*)(gr + bj * 128 + n * 16); const f32x4 xi = *(const f32x4*)(xr + bj * 128 + n * 16); *(f32x4*)(xr + bj * 128 + n * 16) = xi + g * acc[ai][bj][m][n]; } } }
    }
};

#define XB_TMO      128
#define XB_XCNT(j)  (256  + 64 * (j))
#define XB_XSUB(j)  (1280 + 64 * (j))
#define XB_XGEN(j)  (2304 + 64 * (j))
#define XB_TOP      3328
#define XB_TOPGEN   3392
#define XCD_BAR_WORDS 3456
#define XB_SPIN_CAP (1u << 18)
__device__ __forceinline__ unsigned xb_ld(unsigned* p)              { return __hip_atomic_load(p, __ATOMIC_RELAXED, __HIP_MEMORY_SCOPE_AGENT); }
__device__ __forceinline__ unsigned xb_add(unsigned* p, unsigned v) { return __hip_atomic_fetch_add(p, v, __ATOMIC_RELAXED, __HIP_MEMORY_SCOPE_AGENT); }
__device__ __forceinline__ unsigned xb_xcc_id() { return (unsigned)__builtin_amdgcn_s_getreg((3 << 11) | 20) & 0xFu; }
#define XB_SPIN(cond, bar) do { unsigned _sp = 0; while (cond) { __builtin_amdgcn_s_sleep(1); \
    if ((++_sp & 255u) == 0u) { if (xb_ld(&(bar)[XB_TMO])) break; if (_sp > XB_SPIN_CAP) { atomicAdd(&(bar)[XB_TMO], 1u); break; } } } } while (0)
struct XcdBarrier { unsigned* bar; unsigned x; volatile LAS unsigned* st; };
__device__ __forceinline__ XcdBarrier xcd_barrier_post(unsigned* bar, volatile LAS unsigned* st, bool leader) {
    XcdBarrier b; b.bar = bar; b.x = xb_xcc_id(); b.st = st;
    if (leader) (void)xb_add(&bar[XB_XCNT(b.x)], 1u);
    return b;
}
__device__ __forceinline__ void xcd_barrier_complete(unsigned* bar, unsigned x, unsigned& nloc, unsigned& nx) {
    const unsigned G = gridDim.x * gridDim.y * gridDim.z;
    unsigned sum, cnt, mine, sp = 0u;
    for (;;) {
        sum = 0u; cnt = 0u; mine = 0u;
#pragma unroll
        for (unsigned j = 0; j < 16; ++j) { const unsigned c = xb_ld(&bar[XB_XCNT(j)]); sum += c; cnt += (c > 0u) ? 1u : 0u; mine = (j == x) ? c : mine; }
        if (sum == G) break;
        __builtin_amdgcn_s_sleep(1);
        if ((++sp & 255u) == 0u) { if (xb_ld(&bar[XB_TMO])) break; if (sp > XB_SPIN_CAP) { atomicAdd(&bar[XB_TMO], 1u); break; } }
    }
    nloc = mine > 0u ? mine : 1u; nx = cnt > 0u ? cnt : 1u;
}
__device__ __forceinline__ void xcd_barrier(const XcdBarrier& b, int wave_) {
    asm volatile("s_waitcnt vmcnt(0)" ::: "memory");
    __syncthreads();
    if (wave_ == 0 && lane_id_opaque() == 0) {
        unsigned* bar = b.bar; asm volatile("" : "+s"(bar));
        __builtin_amdgcn_s_waitcnt(0);
        unsigned nloc = b.st[0], nx = b.st[1];
        if (nloc == 0u) { xcd_barrier_complete(bar, b.x, nloc, nx); b.st[0] = nloc; b.st[1] = nx; }
        const unsigned old = xb_add(&bar[XB_XSUB(b.x)], 1u);
        const unsigned gen = old / nloc;
        if (old + 1u == (gen + 1u) * nloc) {
            __builtin_amdgcn_fence(__ATOMIC_RELEASE, "agent");
            asm volatile("s_waitcnt vmcnt(0)" ::: "memory");
            const unsigned og = xb_add(&bar[XB_TOP], 1u);
            const unsigned tg = og / nx;
            if (og + 1u == (tg + 1u) * nx) xb_add(&bar[XB_TOPGEN], 1u);
            else XB_SPIN(xb_ld(&bar[XB_TOPGEN]) == tg, bar);
            __builtin_amdgcn_fence(__ATOMIC_ACQUIRE, "agent");
            xb_add(&bar[XB_XGEN(b.x)], 1u);
            asm volatile("s_waitcnt vmcnt(0)" ::: "memory");
        } else {
            XB_SPIN(xb_ld(&bar[XB_XGEN(b.x)]) == gen, bar);
            __builtin_amdgcn_fence(__ATOMIC_ACQUIRE, "agent");
            asm volatile("s_waitcnt vmcnt(0)" ::: "memory");
        }
    }
    __syncthreads();
}

constexpr int NWAVES = 8;
constexpr int RING_BYTES = 131072;
constexpr int TAB_OFF = RING_BYTES;
constexpr int MISC_OFF = TAB_OFF + 2048;
constexpr int LDS_BYTES = 147456;

struct Args {
    const float* x; const float* c; const float* w_in; const float* conv_w; const float* conv_b; const float* w_mq; const float* w_mk; const float* w_mv;
    const float* gate_bias; const float* g_head; const float* w_out; const float* w_ada; const float* b_ada; const float* w_router; const float* router_bias;
    const float* w_gate_e; const float* w_up_e; const float* w_down_e; const float* g_final;
    float* out; unsigned char* ws; int ph_lo, ph_hi;
};

template <class SrcF>
__device__ __forceinline__ void transpose_item(const SrcF& src, bf16_t* WT, int Kd, int k0, int n0, LAS float* scr, int lane) {
#pragma unroll 8
    for (int i = 0; i < 32; ++i) { const int kk = 2 * i + (lane >> 5); scr[kk * 33 + (lane & 31)] = src(k0 + kk, n0 + (lane & 31)); }
    asm volatile("s_waitcnt lgkmcnt(0)" ::: "memory");
    const int c = lane & 7;
#pragma unroll
    for (int j = 0; j < 4; ++j) { const int n = (lane >> 3) + 8 * j; const LAS float* s = scr + (8 * c) * 33 + n;
        u32x4 o; o.x = pk2(s[0 * 33], s[1 * 33]); o.y = pk2(s[2 * 33], s[3 * 33]); o.z = pk2(s[4 * 33], s[5 * 33]); o.w = pk2(s[6 * 33], s[7 * 33]);
        *(u32x4*)(WT + (size_t)(n0 + n) * Kd + k0 + 8 * c) = o; }
    asm volatile("s_waitcnt lgkmcnt(0)" ::: "memory");
}

__device__ __forceinline__ void phase_prologue(const Args& a, LAS unsigned char* lds, int gw, int ngw, int wave_) {
    const int lane = lane_id_opaque(), tid = wave_ * 64 + lane;
    LAS float* cact = (LAS float*)(lds + 98304);
    for (int i = tid; i < 8192; i += NWAVES * 64) { const float cv = a.c[i]; cact[i] = cv * sigmoidf_(cv); }
    __syncthreads();
    float* mod = (float*)(a.ws + WS_MOD);
    for (int it = gw; it < 2 * 96; it += ngw) {
        const int l = it / 96, j = (it % 96) * 64 + lane;
        const float* w = a.w_ada + (size_t)l * 1024 * NMOD + j;
        float acc[8];
#pragma unroll
        for (int b = 0; b < 8; ++b) acc[b] = a.b_ada[l * NMOD + j];
        for (int k = 0; k < 1024; k += 8) {
            float wv[8];
#pragma unroll
            for (int kk = 0; kk < 8; ++kk) wv[kk] = w[(size_t)(k + kk) * NMOD];
#pragma unroll
            for (int kk = 0; kk < 8; ++kk)
#pragma unroll
                for (int b = 0; b < 8; ++b) acc[b] += cact[b * 1024 + k + kk] * wv[kk];
        }
#pragma unroll
        for (int b = 0; b < 8; ++b) mod[((size_t)l * 8 + b) * NMOD + j] = acc[b];
    }
    { bf16_t* WT = (bf16_t*)(a.ws + WS_MLS + MLS_WT);
      for (int i = gw * 64 + lane; i < 2 * 3 * 4 * 4096; i += ngw * 64) {
          const int d = i & 63, e = (i >> 6) & 63, h = (i >> 12) & 3, w = (i >> 14) % 3, l = i / (3 * 4 * 4096);
          const float* src = (w == 0) ? a.w_mq : (w == 1 ? a.w_mk : a.w_mv);
          const float v = src[((size_t)(l * 4 + h) * 64 + d) * 64 + e];
          WT[i] = f2bf(w == 1 ? v * 0.125f : v); } }
    LAS float* scr = (LAS float*)(lds + (tid >> 6) * 8704);
    constexpr int I_IN = 16 * 88, I_OUT = 16 * 32, I_GU = 16 * 16 * 32, I_D = 16 * 8 * 32, I_L = I_IN + I_OUT + I_GU + I_D;
    for (int it = gw; it < 2 * I_L; it += ngw) {
        const int l = it / I_L; int r = it % I_L;
        if (r < I_IN) { const int kb = r / 88, nb = r % 88; const float* W = a.w_in + (size_t)l * 1024 * DIN;
            transpose_item([&](int k, int n) { return W[(size_t)k * DIN + (n < 512 ? n : n + 8)]; }, (bf16_t*)(a.ws + WS_WIN) + (size_t)l * LDU * 1024, 1024, kb * 64, nb * 32, scr, lane); continue; }
        r -= I_IN;
        if (r < I_OUT) { const int kb = r / 32, nb = r % 32; const float* W = a.w_out + (size_t)l * 1024 * 1024;
            transpose_item([&](int k, int n) { return W[(size_t)k * 1024 + n]; }, (bf16_t*)(a.ws + WS_WOUT) + (size_t)l * 1024 * 1024, 1024, kb * 64, nb * 32, scr, lane); continue; }
        r -= I_OUT;
        if (r < I_GU) { const int e = r / 512, rr = r % 512, kb = rr / 32, nb = rr % 32;
            const float* Wg = a.w_gate_e + ((size_t)l * 16 + e) * 1024 * 512; const float* Wu = a.w_up_e + ((size_t)l * 16 + e) * 1024 * 512;
            transpose_item([&](int k, int n) { return (n & 1) ? Wu[(size_t)k * 512 + (n >> 1)] : Wg[(size_t)k * 512 + (n >> 1)]; }, (bf16_t*)(a.ws + WS_WGU) + ((size_t)l * 16 + e) * 1024 * 1024, 1024, kb * 64, nb * 32, scr, lane); continue; }
        r -= I_GU;
        { const int e = r / 256, rr = r % 256, kb = rr / 32, nb = rr % 32; const float* W = a.w_down_e + ((size_t)l * 16 + e) * 512 * 1024;
            transpose_item([&](int k, int n) { return W[(size_t)k * 1024 + n]; }, (bf16_t*)(a.ws + WS_WD) + ((size_t)l * 16 + e) * 1024 * 512, 512, kb * 64, nb * 32, scr, lane); }
    }
}

template <int MODE>
__device__ __forceinline__ void phase_norm(const Args& a, int l, const float* xin, LAS unsigned char* lds, int gw, int ngw, int wave_) {
    const int lane = lane_id_opaque(), tid = wave_ * 64 + lane;
    constexpr int NC = (MODE == 1) ? 8 : 16;
    LAS float* wl = (LAS float*)lds;
    const float* modl = (const float*)(a.ws + WS_MOD) + (size_t)l * 8 * NMOD;
    const int shift_off = (MODE == 1) ? 0 : 3072, scale_off = (MODE == 1) ? 1024 : 4096;
    if (MODE == 1) { const float* W = a.w_in + (size_t)l * 1024 * DIN + 512; for (int i = tid; i < 1024 * 8; i += NWAVES * 64) wl[(i & 7) * 1024 + (i >> 3)] = W[(size_t)(i >> 3) * DIN + (i & 7)]; }
    else { for (int i = tid; i < 1024 * 16; i += NWAVES * 64) wl[(i & 15) * 1024 + (i >> 4)] = a.w_router[i]; }
    __syncthreads();
    bf16_t* H = (bf16_t*)(a.ws + WS_H);
    float* gate = (float*)(a.ws + WS_GATE); float* rw = (float*)(a.ws + WS_RW); int* list = (int*)(a.ws + WS_LIST);
    int* cnt = (int*)(a.ws + WS_CTL) + CW_CNT + l * 32;
    const int rows_per = (T_TOK + ngw - 1) / ngw;
    for (int i = 0; i < rows_per; ++i) {
        const int t = gw * rows_per + i; if (t >= T_TOK) break; const int b = t / SEQ;
        const f32x4* xr = (const f32x4*)(xin + (size_t)t * DM) + lane;
        f32x4 v[4]; float ss = 0.f;
#pragma unroll
        for (int j = 0; j < 4; ++j) { v[j] = xr[64 * j]; ss += (v[j][0] * v[j][0] + v[j][1] * v[j][1]) + (v[j][2] * v[j][2] + v[j][3] * v[j][3]); }
        ss = wave_sum_l(ss, lane);
        const float rstd = rsqrtf(ss * (1.f / 1024.f) + EPS);
        float lg[NC];
#pragma unroll
        for (int e = 0; e < NC; ++e) lg[e] = 0.f;
#pragma unroll
        for (int j = 0; j < 4; ++j) {
            const int k0 = 4 * lane + 256 * j;
            const f32x4 sc = *(const f32x4*)(modl + (size_t)b * NMOD + scale_off + k0), sh = *(const f32x4*)(modl + (size_t)b * NMOD + shift_off + k0);
            f32x4 h;
#pragma unroll
            for (int q = 0; q < 4; ++q) h[q] = v[j][q] * rstd * (1.f + sc[q]) + sh[q];
            u32x2 o; o.x = pk2(h[0], h[1]); o.y = pk2(h[2], h[3]);
            *(u32x2*)(H + (size_t)t * DM + k0) = o;
#pragma unroll
            for (int e = 0; e < NC; ++e) { const f32x4 w = *(const LAS f32x4*)(wl + e * 1024 + k0); lg[e] += (h[0] * w[0] + h[1] * w[1]) + (h[2] * w[2] + h[3] * w[3]); }
        }
#pragma unroll
        for (int e = 0; e < NC; ++e) lg[e] = wave_sum_l(lg[e], lane);
        if (MODE == 1) {
            if (lane == 0) { *(f32x4*)(gate + (size_t)t * 8) = (f32x4){lg[0], lg[1], lg[2], lg[3]}; *(f32x4*)(gate + (size_t)t * 8 + 4) = (f32x4){lg[4], lg[5], lg[6], lg[7]}; }
        } else {
            float sc[16], bs[16];
#pragma unroll
            for (int e = 0; e < 16; ++e) { sc[e] = sigmoidf_(lg[e]); bs[e] = sc[e] + a.router_bias[e]; }
            float best_gs = -1e30f; int bk = 0; float bw0 = 0.f, bw1 = 0.f;
#pragma unroll
            for (int g = 0; g < 4; ++g) {
                int i0 = 0; float v0 = bs[4 * g]; float s0 = sc[4 * g];
#pragma unroll
                for (int j = 1; j < 4; ++j) if (bs[4 * g + j] > v0) { v0 = bs[4 * g + j]; i0 = j; s0 = sc[4 * g + j]; }
                int i1 = -1; float v1 = -1e30f; float s1 = 0.f;
#pragma unroll
                for (int j = 0; j < 4; ++j) if (j != i0 && bs[4 * g + j] > v1) { v1 = bs[4 * g + j]; i1 = j; s1 = sc[4 * g + j]; }
                const float gs = v0 + v1;
                if (gs > best_gs) { best_gs = gs;
                    const int lo = i0 < i1 ? i0 : i1, hi = i0 < i1 ? i1 : i0; const float wlo = i0 < i1 ? s0 : s1, whi = i0 < i1 ? s1 : s0;
                    const int p = (lo == 0) ? (hi - 1) : (lo == 1 ? hi + 1 : 5);
                    bk = 6 * g + p; bw0 = wlo; bw1 = whi; }
            }
            if (lane == 0) {
                const float inv = 1.f / (bw0 + bw1);
                const int pos = atomicAdd(&cnt[bk], 1); list[(size_t)bk * T_TOK + pos] = t; *(f32x2*)(rw + (size_t)t * 2) = (f32x2){bw0 * inv, bw1 * inv};
            }
        }
    }
}

__device__ __forceinline__ void build_moe_tab(const Args& a, int l, LAS int* tab, int wave_) {
    const int tid = wave_ * 64 + lane_id_opaque();
    const int* cnt = (const int*)(a.ws + WS_CTL) + CW_CNT + l * 32;
    if (tid < 32) tab[tid] = (tid < NBUCK) ? cnt[tid] : 0;
    __syncthreads();
    if (tid < NBUCK) {
        int base = 0;
#pragma unroll 1
        for (int j = 0; j < tid; ++j) base += (tab[j] + 255) >> 8;
        const int mine = (tab[tid] + 255) >> 8;
#pragma unroll 1
        for (int i = 0; i < mine; ++i) { tab[32 + base + i] = tid; tab[192 + base + i] = i * 256; }
        if (tid == NBUCK - 1) tab[352] = base + mine;
    }
    __syncthreads();
}

__device__ __forceinline__ void phase_final(const Args& a, int gw, int ngw) {
    const int lane = lane_id_opaque();
    for (int t = gw; t < T_TOK; t += ngw) {
        f32x4* xr = (f32x4*)(a.out + (size_t)t * DM) + lane; f32x4 v[4]; float ss = 0.f;
#pragma unroll
        for (int j = 0; j < 4; ++j) { v[j] = xr[64 * j]; ss += (v[j][0] * v[j][0] + v[j][1] * v[j][1]) + (v[j][2] * v[j][2] + v[j][3] * v[j][3]); }
        ss = wave_sum_l(ss, lane);
        const float rstd = rsqrtf(ss * (1.f / 1024.f) + EPS);
#pragma unroll
        for (int j = 0; j < 4; ++j) { const f32x4 g = *((const f32x4*)a.g_final + lane + 64 * j); xr[64 * j] = v[j] * rstd * g; }
    }
}


typedef float f32x16 __attribute__((ext_vector_type(16)));
typedef short s16x4 __attribute__((ext_vector_type(4)));
typedef short v4i16_t __attribute__((ext_vector_type(4)));
#define MFMA32(a, b, c) __builtin_amdgcn_mfma_f32_32x32x16_bf16((a), (b), (c), 0, 0, 0)
__device__ __forceinline__ int crow(int i, int h) { return (i & 3) + 8 * (i >> 2) + 4 * h; }
__device__ __forceinline__ unsigned cvtpk(float lo, float hi) { typedef float f2_t __attribute__((ext_vector_type(2))); typedef __bf16 b2_t __attribute__((ext_vector_type(2)));
    f2_t v = {lo, hi}; b2_t b = __builtin_convertvector(v, b2_t); return __builtin_bit_cast(unsigned, b); }
__device__ __forceinline__ bf16x8 pack8(const f32x16& x, int s) { u32x4 p; p.x = cvtpk(x[8 * s], x[8 * s + 1]); p.y = cvtpk(x[8 * s + 2], x[8 * s + 3]); p.z = cvtpk(x[8 * s + 4], x[8 * s + 5]); p.w = cvtpk(x[8 * s + 6], x[8 * s + 7]); return __builtin_bit_cast(bf16x8, p); }
__device__ __forceinline__ void halves(float v, float& v0, float& v1) { auto rr = __builtin_amdgcn_permlane32_swap(__float_as_uint(v), __float_as_uint(v), false, false); v0 = __uint_as_float(rr[0]); v1 = __uint_as_float(rr[1]); }
__device__ __forceinline__ s16x4 vtr(const LAS unsigned char* p) { return __builtin_bit_cast(s16x4, __builtin_amdgcn_ds_read_tr16_b64_v4i16((LAS v4i16_t*)p)); }
__device__ __forceinline__ bf16x8 vt_frag(const LAS unsigned char* vl, int vtr0, int s, int db) {
    const s16x4 lo = vtr(vl + vtr0 + s * 2048 + db * 64), hi = vtr(vl + vtr0 + s * 2048 + 1024 + db * 64);
    return __builtin_shufflevector(lo, hi, 0, 1, 2, 3, 4, 5, 6, 7); }

#ifndef SB_EARLY_EXIT
#define SB_EARLY_EXIT 1
#endif
__device__ __forceinline__ void sb_item(const bf16_t* U, const float* gh  , bf16_t* Y, LAS unsigned char* vl, int b, int h, int qt, int lane) {
    const int r = lane & 31, hh = lane >> 5;
    const size_t rowb = (size_t)b * SEQ;
    const bf16_t* Qp = U + (rowb + 32 * qt + r) * LDU + OFF_SB + h * 64 + 8 * hh;
    bf16x8 qf[4];
#pragma unroll
    for (int d0 = 0; d0 < 4; ++d0) qf[d0] = *(const bf16x8*)(Qp + 16 * d0);
    f32x16 o0, o1;
#pragma unroll
    for (int i = 0; i < 16; ++i) { o0[i] = 0.f; o1[i] = 0.f; }
    float carry = 1.f;
    const bf16_t* Kb = U + rowb * LDU + OFF_SB + 384 + h * 64; const bf16_t* Vb = Kb + 384;
    const int vrow = lane >> 3, vseg = lane & 7;
    const int i16 = lane & 15, q4 = i16 >> 2, p4 = i16 & 3, blk = (lane >> 4) & 1;
    const int vtr0 = (4 * hh + q4) * 128 + (16 * blk + 4 * p4) * 2;
#pragma unroll 1
    for (int kt = qt; kt >= 0; --kt) {
        const bf16_t* Kp = Kb + (size_t)(32 * kt + r) * LDU + 8 * hh;
        bf16x8 kf[4];
#pragma unroll
        for (int d0 = 0; d0 < 4; ++d0) kf[d0] = *(const bf16x8*)(Kp + 16 * d0);
        u32x4 vv[4];
#pragma unroll
        for (int i = 0; i < 4; ++i) vv[i] = *(const u32x4*)(Vb + (size_t)(32 * kt + vrow + 8 * i) * LDU + 8 * vseg);
#pragma unroll
        for (int i = 0; i < 4; ++i) *(LAS u32x4*)(vl + (vrow + 8 * i) * 128 + vseg * 16) = vv[i];
        f32x16 sc;
#pragma unroll
        for (int i = 0; i < 16; ++i) sc[i] = 0.f;
#pragma unroll
        for (int d0 = 0; d0 < 4; ++d0) sc = MFMA32(kf[d0], qf[d0], sc);
        float sg[16], kp[16];
#pragma unroll
        for (int i = 0; i < 16; ++i) {
            const float z = fmaxf(sc[i] * 0.125f, -80.f);
            const float e = __expf(-z); float sig = __builtin_amdgcn_rcpf(1.f + e); float keep = e * sig;
            if (kt == qt) { const bool valid = crow(i, hh) < r; sig = valid ? sig : 0.f; keep = valid ? keep : 1.f; }
            sg[i] = sig; kp[i] = keep;
        }
        float G0[4], G1[4], PP[4];
#pragma unroll
        for (int g = 0; g < 4; ++g) { const float G = (kp[4 * g] * kp[4 * g + 1]) * (kp[4 * g + 2] * kp[4 * g + 3]); halves(G, G0[g], G1[g]); PP[g] = G0[g] * G1[g]; }
        float SP[4]; SP[3] = 1.f; SP[2] = PP[3]; SP[1] = PP[3] * PP[2]; SP[0] = SP[1] * PP[1];
        const float total = SP[0] * PP[0];
#pragma unroll
        for (int g = 0; g < 4; ++g) {
            const float r3 = carry * SP[g] * (hh ? 1.f : G1[g]);
            const float r2 = r3 * kp[4 * g + 3], r1 = r2 * kp[4 * g + 2], r0 = r1 * kp[4 * g + 1];
            sc[4 * g + 3] = sg[4 * g + 3] * r3; sc[4 * g + 2] = sg[4 * g + 2] * r2; sc[4 * g + 1] = sg[4 * g + 1] * r1; sc[4 * g] = sg[4 * g] * r0;
        }
        carry *= total;
        const bf16x8 pb0 = pack8(sc, 0), pb1 = pack8(sc, 1);
        o0 = MFMA32(vt_frag(vl, vtr0, 0, 0), pb0, o0); o0 = MFMA32(vt_frag(vl, vtr0, 1, 0), pb1, o0);
        o1 = MFMA32(vt_frag(vl, vtr0, 0, 1), pb0, o1); o1 = MFMA32(vt_frag(vl, vtr0, 1, 1), pb1, o1);
#if SB_EARLY_EXIT
        if (__builtin_amdgcn_ballot_w64(carry >= 1e-37f) == 0ull) break;
#endif
    }
    float ss = 0.f;
#pragma unroll
    for (int i = 0; i < 16; ++i) ss += o0[i] * o0[i] + o1[i] * o1[i];
    float s0, s1; halves(ss, s0, s1);
    const float rs = rsqrtf((s0 + s1) * (1.f / 64.f) + EPS);
    bf16_t* yr = Y + (rowb + 32 * qt + r) * 1024 + (10 + h) * 64;
#pragma unroll
    for (int g = 0; g < 4; ++g) {
        const int d0 = 8 * g + 4 * hh;
        const f32x4 ga = *(const f32x4*)(gh + d0), gb = *(const f32x4*)(gh + 32 + d0);
        u32x2 wa, wb; wa.x = cvtpk(o0[4 * g] * rs * ga[0], o0[4 * g + 1] * rs * ga[1]); wa.y = cvtpk(o0[4 * g + 2] * rs * ga[2], o0[4 * g + 3] * rs * ga[3]);
        wb.x = cvtpk(o1[4 * g] * rs * gb[0], o1[4 * g + 1] * rs * gb[1]); wb.y = cvtpk(o1[4 * g + 2] * rs * gb[2], o1[4 * g + 3] * rs * gb[3]);
        *(u32x2*)(yr + d0) = wa; *(u32x2*)(yr + 32 + d0) = wb;
    }
}
__device__ __forceinline__ void phase_sb(const Args& a, int l, LAS unsigned char* lds, int gw, int ngw, int wave_) {
    const int lane = lane_id_opaque();
    LAS unsigned char* vl = lds + wave_ * 16384;
    const bf16_t* U = (const bf16_t*)(a.ws + WS_U); bf16_t* Y = (bf16_t*)(a.ws + WS_Y);
    for (int it = gw; it < NB * 6 * 128; it += ngw) {
        const int qt = 127 - (it % 128), h = (it / 128) % 6, b = it / 768;
        sb_item(U, a.g_head + l * 1024 + (10 + h) * 64, Y, vl, b, h, qt, lane);
    }
}


__device__ __forceinline__ void dil_item(const bf16_t* U, bf16_t* OP, float* LSE, LAS unsigned char* vl, int b, int h, int p, int qi, int lane) {
    const int r = lane & 31, hh = lane >> 5;
    const int sh = 2 * p, d = 1 << sh, nblk = (SEQ >> sh) / 32, c = qi / nblk, m0 = 32 * (qi % nblk);
    const size_t rowb = (size_t)b * SEQ;
    const int tq = ((m0 + r) << sh) + c;
    const bf16_t* Qp = U + (rowb + tq) * LDU + OFF_DIL + h * 64 + 8 * hh;
    bf16x8 qf[4];
#pragma unroll
    for (int d0 = 0; d0 < 4; ++d0) qf[d0] = *(const bf16x8*)(Qp + 16 * d0);
    const float sb = exp2f(-8.f * (float)(h + 1) / 6.f) * (float)d;
    f32x16 o0, o1;
#pragma unroll
    for (int i = 0; i < 16; ++i) { o0[i] = 0.f; o1[i] = 0.f; }
    float m_run = -1e30f, l_run = 0.f;
    const bf16_t* Kb = U + rowb * LDU + OFF_DIL + 384 + h * 64; const bf16_t* Vb = Kb + 384;
    const int vrow = lane >> 3, vseg = lane & 7;
    const int i16 = lane & 15, q4 = i16 >> 2, p4 = i16 & 3, blk = (lane >> 4) & 1;
    const int vtr0 = (4 * hh + q4) * 128 + (16 * blk + 4 * p4) * 2;
#pragma unroll 1
    for (int j = 4; j >= 0; --j) {
        const int mk0 = m0 - 128 + 32 * j;
        if (mk0 < 0) break;
        const bf16_t* Kp = Kb + (size_t)(((mk0 + r) << sh) + c) * LDU + 8 * hh;
        bf16x8 kf[4];
#pragma unroll
        for (int d0 = 0; d0 < 4; ++d0) kf[d0] = *(const bf16x8*)(Kp + 16 * d0);
        u32x4 vv[4];
#pragma unroll
        for (int i = 0; i < 4; ++i) vv[i] = *(const u32x4*)(Vb + (size_t)(((mk0 + vrow + 8 * i) << sh) + c) * LDU + 8 * vseg);
#pragma unroll
        for (int i = 0; i < 4; ++i) *(LAS u32x4*)(vl + (vrow + 8 * i) * 128 + vseg * 16) = vv[i];
        f32x16 sc;
#pragma unroll
        for (int i = 0; i < 16; ++i) sc[i] = 0.f;
#pragma unroll
        for (int d0 = 0; d0 < 4; ++d0) sc = MFMA32(kf[d0], qf[d0], sc);
        float mx = -1e30f;
        const float base2 = -sb * (float)(r + 128 - 32 * j - 4 * hh);
#pragma unroll
        for (int i = 0; i < 16; ++i) {
            const int cr = crow(i, hh);
            float v = fmaf(sb, (float)((i & 3) + 8 * (i >> 2)), fmaf(sc[i], 0.125f, base2));
            const bool valid = (j == 4) ? (cr <= r) : ((j == 0) ? (cr >= r) : true);
            v = valid ? v : -1e30f;
            sc[i] = v; mx = fmaxf(mx, v);
        }
        float mx0, mx1; halves(mx, mx0, mx1);
        const float m_new = fmaxf(m_run, fmaxf(mx0, mx1));
        const float corr = __expf(m_run - m_new);
        float ps = 0.f;
#pragma unroll
        for (int i = 0; i < 16; ++i) { const float pe = __expf(sc[i] - m_new); sc[i] = pe; ps += pe; }
        float ps0, ps1; halves(ps, ps0, ps1);
        l_run = l_run * corr + (ps0 + ps1);
        m_run = m_new;
#pragma unroll
        for (int i = 0; i < 16; ++i) { o0[i] *= corr; o1[i] *= corr; }
        const bf16x8 pb0 = pack8(sc, 0), pb1 = pack8(sc, 1);
        o0 = MFMA32(vt_frag(vl, vtr0, 0, 0), pb0, o0); o0 = MFMA32(vt_frag(vl, vtr0, 1, 0), pb1, o0);
        o1 = MFMA32(vt_frag(vl, vtr0, 0, 1), pb0, o1); o1 = MFMA32(vt_frag(vl, vtr0, 1, 1), pb1, o1);
    }
    const float inv = 1.f / l_run;
    bf16_t* orow = OP + (rowb + tq) * 384 + h * 64;
#pragma unroll
    for (int g = 0; g < 4; ++g) {
        const int d0 = 8 * g + 4 * hh;
        u32x2 wa, wb; wa.x = cvtpk(o0[4 * g] * inv, o0[4 * g + 1] * inv); wa.y = cvtpk(o0[4 * g + 2] * inv, o0[4 * g + 3] * inv);
        wb.x = cvtpk(o1[4 * g] * inv, o1[4 * g + 1] * inv); wb.y = cvtpk(o1[4 * g + 2] * inv, o1[4 * g + 3] * inv);
        *(u32x2*)(orow + d0) = wa; *(u32x2*)(orow + 32 + d0) = wb;
    }
    if (hh == 0) LSE[(rowb + tq) * 6 + h] = m_run + __logf(l_run);
}
__device__ __forceinline__ bf16_t* dil_op(unsigned char* ws, int p) { return (p < 2) ? (bf16_t*)(ws + WS_OP01) + (size_t)p * T_TOK * 384 : (bf16_t*)(ws + WS_OP2); }
__device__ __forceinline__ void phase_dil(const Args& a, int l, LAS unsigned char* lds, int gw, int ngw, int wave_) {
    const int lane = lane_id_opaque();
    LAS unsigned char* vl = lds + wave_ * 16384;
    const bf16_t* U = (const bf16_t*)(a.ws + WS_U);
    for (int it = gw; it < 3 * NB * 6 * 128; it += ngw) {
        const int qi = it % 128, h = (it / 128) % 6, b = (it / 768) % NB, p = it / (768 * NB);
        dil_item(U, dil_op(a.ws, p), (float*)(a.ws + WS_LSE) + (size_t)p * T_TOK * 6, vl, b, h, p, qi, lane);
    }
}
__device__ __forceinline__ void phase_dil_merge(const Args& a, int l, int gw, int ngw) {
    const int lane = lane_id_opaque();
    const bf16_t* O0 = dil_op(a.ws, 0); const bf16_t* O1 = dil_op(a.ws, 1); const bf16_t* O2 = dil_op(a.ws, 2);
    const float* L0 = (const float*)(a.ws + WS_LSE); const float* L1 = L0 + (size_t)T_TOK * 6; const float* L2 = L1 + (size_t)T_TOK * 6;
    bf16_t* Y = (bf16_t*)(a.ws + WS_Y);
    for (int t = gw; t < T_TOK; t += ngw) {
#pragma unroll
        for (int hd = 0; hd < 6; ++hd) {
            const float l0 = L0[(size_t)t * 6 + hd], l1 = L1[(size_t)t * 6 + hd], l2 = L2[(size_t)t * 6 + hd];
            const float mx = fmaxf(l0, fmaxf(l1, l2));
            const float w0 = __expf(l0 - mx), w1 = __expf(l1 - mx), w2 = __expf(l2 - mx); const float inv = 1.f / (w0 + w1 + w2);
            const size_t o = (size_t)t * 384 + hd * 64 + lane;
            const float v = (w0 * bf2f(O0[o]) + w1 * bf2f(O1[o]) + w2 * bf2f(O2[o])) * inv;
            const float ss = wave_sum_l(v * v, lane);
            Y[(size_t)t * 1024 + (4 + hd) * 64 + lane] = f2bf(v * rsqrtf(ss * (1.f / 64.f) + EPS) * a.g_head[l * 1024 + (4 + hd) * 64 + lane]);
        }
    }
}


__device__ __forceinline__ float bperm_f(float v, int srclane) { return __int_as_float(__builtin_amdgcn_ds_bpermute((srclane & 63) << 2, __float_as_int(v))); }
__device__ __forceinline__ float scan_add64(float v, int lane) {
#pragma unroll
    for (int o = 1; o < 64; o <<= 1) { const float t = bperm_f(v, lane - o); v = (lane >= o) ? v + t : v; }
    return v; }
__device__ __forceinline__ float scan_max64(float v, int lane) {
#pragma unroll
    for (int o = 1; o < 64; o <<= 1) { const float t = bperm_f(v, lane - o); v = (lane >= o) ? fmaxf(v, t) : v; }
    return v; }
__device__ __forceinline__ float bcast63(float v) { return __int_as_float(__builtin_amdgcn_readlane(__float_as_int(v), 63)); }

__device__ __forceinline__ void ml_b1_item(const Args& a, int l, LAS unsigned char* wl  , int b, int h, int c) {
    const int bh = b * 4 + h;
    const size_t rowb = (size_t)b * SEQ + 128 * c;
    unsigned char* mls = a.ws + WS_MLS;
    LAS float* cw = (LAS float*)(wl + 8192);
    float w0, w1;
    const bf16_t* U = (const bf16_t*)(a.ws + WS_U);
    bf16_t* Qm = (bf16_t*)(a.ws + WS_QKV); bf16_t* Km = Qm + (size_t)T_TOK * 256; bf16_t* Vm = Km + (size_t)T_TOK * 256;
    { const int lane = lane_id_opaque();
    const float* GATE = (const float*)(a.ws + WS_GATE);
    const float gbi = a.gate_bias[l * 8 + h], gbf = a.gate_bias[l * 8 + 4 + h];
    const size_t t0 = rowb + lane, t1 = t0 + 64;
    const float ig0 = GATE[t0 * 8 + h] + gbi, ig1 = GATE[t1 * 8 + h] + gbi;
    const float lf0 = -softplusf_(-(GATE[t0 * 8 + 4 + h] + gbf)), lf1 = -softplusf_(-(GATE[t1 * 8 + 4 + h] + gbf));
    const float c0 = scan_add64(lf0, lane); const float c1 = scan_add64(lf1, lane) + bcast63(c0);
    const float a0 = ig0 - c0, a1 = ig1 - c1;
    const float p0 = scan_max64(a0, lane); const float p1 = fmaxf(scan_max64(a1, lane), bcast63(p0));
    const float Amax = bcast63(p1), Lsum = bcast63(c1);
    ((float*)(mls + MLS_CUM))[t0 * 4 + h] = c0; ((float*)(mls + MLS_CUM))[t1 * 4 + h] = c1;
    ((float*)(mls + MLS_AA))[t0 * 4 + h] = a0;  ((float*)(mls + MLS_AA))[t1 * 4 + h] = a1;
    ((float*)(mls + MLS_PM))[t0 * 4 + h] = p0;  ((float*)(mls + MLS_PM))[t1 * 4 + h] = p1;
    if (lane == 0) { ((float*)(mls + MLS_AMAX))[bh * 32 + c] = Amax; ((float*)(mls + MLS_LSUM))[bh * 32 + c] = Lsum; }
    w0 = __expf(a0 - Amax); w1 = __expf(a1 - Amax);
#pragma unroll
    for (int j = 0; j < 4; ++j) cw[j * 64 + lane] = a.conv_w[(l * 4 + j) * 256 + h * 64 + lane];
    cw[256 + lane] = a.conv_b[l * 256 + h * 64 + lane];
    }
    const bf16_t* WT = (const bf16_t*)(mls + MLS_WT) + (size_t)(l * 3 * 4 + h) * 4096;
    LAS unsigned char* vt = wl; LAS unsigned char* kt = wl + 4096;
    f32x16 acc[2][2], nacc[2];
#pragma unroll
    for (int i = 0; i < 16; ++i) { acc[0][0][i] = 0.f; acc[0][1][i] = 0.f; acc[1][0][i] = 0.f; acc[1][1][i] = 0.f; nacc[0][i] = 0.f; nacc[1][i] = 0.f; }
    bf16x8 ones;
#pragma unroll
    for (int j = 0; j < 8; ++j) ones[j] = (short)0x3F80;
#pragma unroll 1
    for (int st = 0; st < 4; ++st) {
        const int lane = lane_id_opaque(); const int r = lane & 31, hh = lane >> 5;
        const int i16 = lane & 15, q4 = i16 >> 2, p4 = i16 & 3, blk = (lane >> 4) & 1;
        const int vtr0 = (4 * hh + q4) * 128 + (16 * blk + 4 * p4) * 2;
        const size_t row = rowb + 32 * st + r; const int tt = 128 * c + 32 * st + r;
        const float wt = bperm_f((st < 2) ? w0 : w1, 32 * (st & 1) + r);
        bf16x8 xcf[4], xmf[4];
#pragma unroll
        for (int d0 = 0; d0 < 4; ++d0) {
            const int ch = 16 * d0 + 8 * hh;
            bf16x8 x[4];
#pragma unroll
            for (int j = 0; j < 4; ++j) { const bool ok = (tt - 3 + j >= 0); const bf16x8 ld = *(const bf16x8*)(U + (ok ? row - 3 + j : row) * LDU + OFF_ML_X + h * 64 + ch);
                const u32x4 lu = __builtin_bit_cast(u32x4, ld); u32x4 z; z.x = ok ? lu.x : 0u; z.y = ok ? lu.y : 0u; z.z = ok ? lu.z : 0u; z.w = ok ? lu.w : 0u; x[j] = __builtin_bit_cast(bf16x8, z); }
            xmf[d0] = x[3];
            float xv[8];
            { const f32x4 ba = *(const LAS f32x4*)(cw + 256 + ch), bb = *(const LAS f32x4*)(cw + 256 + ch + 4);
              xv[0] = ba[0]; xv[1] = ba[1]; xv[2] = ba[2]; xv[3] = ba[3]; xv[4] = bb[0]; xv[5] = bb[1]; xv[6] = bb[2]; xv[7] = bb[3]; }
#pragma unroll
            for (int j = 0; j < 4; ++j) { const f32x4 wa = *(const LAS f32x4*)(cw + j * 64 + ch), wb = *(const LAS f32x4*)(cw + j * 64 + ch + 4);
#pragma unroll
                for (int e = 0; e < 4; ++e) { xv[e] += wa[e] * bf2f((bf16_t)x[j][e]); xv[4 + e] += wb[e] * bf2f((bf16_t)x[j][4 + e]); } }
            u32x4 pk;
            pk.x = cvtpk(xv[0] * sigmoidf_(xv[0]), xv[1] * sigmoidf_(xv[1])); pk.y = cvtpk(xv[2] * sigmoidf_(xv[2]), xv[3] * sigmoidf_(xv[3]));
            pk.z = cvtpk(xv[4] * sigmoidf_(xv[4]), xv[5] * sigmoidf_(xv[5])); pk.w = cvtpk(xv[6] * sigmoidf_(xv[6]), xv[7] * sigmoidf_(xv[7]));
            xcf[d0] = __builtin_bit_cast(bf16x8, pk);
            __builtin_amdgcn_sched_barrier(0);
        }
#pragma unroll
        for (int w = 0; w < 3; ++w) {
#pragma unroll
            for (int eb = 0; eb < 2; ++eb) {
                f32x16 pr;
#pragma unroll
                for (int i = 0; i < 16; ++i) pr[i] = 0.f;
#pragma unroll
                for (int d0 = 0; d0 < 4; ++d0) { const bf16x8 wf = *(const bf16x8*)(WT + (size_t)w * 4 * 4096 + (32 * eb + r) * 64 + 16 * d0 + 8 * hh); pr = MFMA32(wf, (w == 2) ? xmf[d0] : xcf[d0], pr); }
                bf16_t* dst = ((w == 0) ? Qm : (w == 1 ? Km : Vm)) + row * 256 + h * 64 + 32 * eb;
#pragma unroll
                for (int g = 0; g < 4; ++g) {
                    const int e0 = 8 * g + 4 * hh;
                    u32x2 o; o.x = cvtpk(pr[4 * g], pr[4 * g + 1]); o.y = cvtpk(pr[4 * g + 2], pr[4 * g + 3]);
                    *(u32x2*)(dst + e0) = o;
                    if (w == 1) { u32x2 k2; k2.x = cvtpk(pr[4 * g] * wt, pr[4 * g + 1] * wt); k2.y = cvtpk(pr[4 * g + 2] * wt, pr[4 * g + 3] * wt); *(LAS u32x2*)(kt + r * 128 + (32 * eb + e0) * 2) = k2; }
                    if (w == 2) *(LAS u32x2*)(vt + r * 128 + (32 * eb + e0) * 2) = o;
                }
                __builtin_amdgcn_sched_barrier(0);
            }
        }
#pragma unroll
        for (int sk = 0; sk < 2; ++sk) {
            const bf16x8 kb0 = vt_frag(kt, vtr0, sk, 0), kb1 = vt_frag(kt, vtr0, sk, 1), va0 = vt_frag(vt, vtr0, sk, 0), va1 = vt_frag(vt, vtr0, sk, 1);
            acc[0][0] = MFMA32(va0, kb0, acc[0][0]); acc[0][1] = MFMA32(va0, kb1, acc[0][1]);
            acc[1][0] = MFMA32(va1, kb0, acc[1][0]); acc[1][1] = MFMA32(va1, kb1, acc[1][1]);
            nacc[0] = MFMA32(ones, kb0, nacc[0]); nacc[1] = MFMA32(ones, kb1, nacc[1]);
        }
    }
    const int lane = lane_id_opaque(); const int r = lane & 31, hh = lane >> 5;
    float* CL = (float*)(a.ws + WS_CLOC) + (size_t)(bh * 32 + c) * 4096;
#pragma unroll
    for (int eb = 0; eb < 2; ++eb)
#pragma unroll
        for (int db = 0; db < 2; ++db)
#pragma unroll
            for (int i = 0; i < 16; ++i) CL[(32 * eb + crow(i, hh)) * 64 + 32 * db + r] = acc[eb][db][i];
    if (hh == 0) { float* NL = (float*)(mls + MLS_NLOC) + (size_t)(bh * 32 + c) * 64; NL[r] = nacc[0][0]; NL[32 + r] = nacc[1][0]; }
}

__device__ __forceinline__ void phase_ml_b2(const Args& a, int gthread, int nthreads) {
    unsigned char* mls = a.ws + WS_MLS;
    const float* AM = (const float*)(mls + MLS_AMAX); const float* LS = (const float*)(mls + MLS_LSUM);
    for (int idx = gthread; idx < 32 * 4096; idx += nthreads) {
        const int bh = idx >> 12, ed = idx & 4095;
        const float* CL = (const float*)(a.ws + WS_CLOC) + (size_t)bh * 32 * 4096 + ed;
        bf16_t* CT = (bf16_t*)(a.ws + WS_CT) + (size_t)bh * 32 * 4096 + ed;
        const bool isn = ed < 64;
        const float* NL = (const float*)(mls + MLS_NLOC) + (size_t)bh * 32 * 64 + (ed & 63);
        float* NCp = (float*)(mls + MLS_NC) + (size_t)bh * 32 * 64 + (ed & 63);
        float C = 0.f, n = 0.f, m = 0.f;
#pragma unroll 4
        for (int c = 0; c < 32; ++c) {
            CT[(size_t)c * 4096] = f2bf(C);
            if (isn) NCp[c * 64] = n;
            if (ed == 0) ((float*)(mls + MLS_MC))[bh * 32 + c] = m;
            const float A = AM[bh * 32 + c], L = LS[bh * 32 + c];
            const float M = fmaxf(m, A); const float dec = __expf(m - M), sc = __expf(A - M);
            C = dec * C + sc * CL[(size_t)c * 4096];
            if (isn) n = dec * n + sc * NL[c * 64];
            m = L + M;
        }
    }
}

__device__ __forceinline__ void ml_b3_item(const Args& a, int l, LAS unsigned char* wl, int b, int h, int c, int qt, int lane) {
    const int r = lane & 31, hh = lane >> 5, bh = b * 4 + h;
    const size_t rowc = (size_t)b * SEQ + 128 * c, rowq = rowc + 32 * qt + r;
    unsigned char* mls = a.ws + WS_MLS;
    const bf16_t* Qm = (const bf16_t*)(a.ws + WS_QKV); const bf16_t* Km = Qm + (size_t)T_TOK * 256; const bf16_t* Vm = Km + (size_t)T_TOK * 256;
    LAS float* atab = (LAS float*)(wl + 4096);
    atab[lane] = ((const float*)(mls + MLS_AA))[(rowc + lane) * 4 + h]; atab[64 + lane] = ((const float*)(mls + MLS_AA))[(rowc + 64 + lane) * 4 + h];
    const float cum_t = ((const float*)(mls + MLS_CUM))[rowq * 4 + h], pm_t = ((const float*)(mls + MLS_PM))[rowq * 4 + h];
    const float m_c = ((const float*)(mls + MLS_MC))[bh * 32 + c];
    const float M_t = fmaxf(m_c, pm_t), inter = __expf(m_c - M_t), m_t = cum_t + M_t;
    bf16x8 qf[4];
#pragma unroll
    for (int d0 = 0; d0 < 4; ++d0) qf[d0] = *(const bf16x8*)(Qm + rowq * 256 + h * 64 + 16 * d0 + 8 * hh);
    const bf16_t* CT = (const bf16_t*)(a.ws + WS_CT) + (size_t)(bh * 32 + c) * 4096;
    f32x16 n0, n1;
#pragma unroll
    for (int i = 0; i < 16; ++i) { n0[i] = 0.f; n1[i] = 0.f; }
#pragma unroll
    for (int d0 = 0; d0 < 4; ++d0) { n0 = MFMA32(*(const bf16x8*)(CT + (size_t)r * 64 + 16 * d0 + 8 * hh), qf[d0], n0); n1 = MFMA32(*(const bf16x8*)(CT + (size_t)(32 + r) * 64 + 16 * d0 + 8 * hh), qf[d0], n1); }
    const float* NCp = (const float*)(mls + MLS_NC) + (size_t)(bh * 32 + c) * 64;
    float qn = 0.f;
#pragma unroll
    for (int d0 = 0; d0 < 4; ++d0) { const f32x4 na = *(const f32x4*)(NCp + 16 * d0 + 8 * hh), nb = *(const f32x4*)(NCp + 16 * d0 + 8 * hh + 4);
#pragma unroll
        for (int e = 0; e < 4; ++e) { qn += bf2f((bf16_t)qf[d0][e]) * na[e]; qn += bf2f((bf16_t)qf[d0][4 + e]) * nb[e]; } }
    float qn0, qn1; halves(qn, qn0, qn1); qn = qn0 + qn1;
#pragma unroll
    for (int i = 0; i < 16; ++i) { n0[i] *= inter; n1[i] *= inter; }
    float dsum = 0.f;
    const int vrow = lane >> 3, vseg = lane & 7;
    const int i16 = lane & 15, q4 = i16 >> 2, p4 = i16 & 3, blk = (lane >> 4) & 1;
    const int vtr0 = (4 * hh + q4) * 128 + (16 * blk + 4 * p4) * 2;
    LAS unsigned char* vl = wl;
#pragma unroll 1
    for (int kt = 0; kt <= qt; ++kt) {
        const bf16_t* Kp = Km + (rowc + 32 * kt + r) * 256 + h * 64 + 8 * hh;
        bf16x8 kf[4];
#pragma unroll
        for (int d0 = 0; d0 < 4; ++d0) kf[d0] = *(const bf16x8*)(Kp + 16 * d0);
        u32x4 vv[4];
#pragma unroll
        for (int i = 0; i < 4; ++i) vv[i] = *(const u32x4*)(Vm + (rowc + 32 * kt + vrow + 8 * i) * 256 + h * 64 + 8 * vseg);
#pragma unroll
        for (int i = 0; i < 4; ++i) *(LAS u32x4*)(vl + (vrow + 8 * i) * 128 + vseg * 16) = vv[i];
        f32x16 sc;
#pragma unroll
        for (int i = 0; i < 16; ++i) sc[i] = 0.f;
#pragma unroll
        for (int d0 = 0; d0 < 4; ++d0) sc = MFMA32(kf[d0], qf[d0], sc);
#pragma unroll
        for (int g = 0; g < 4; ++g) {
            const f32x4 av = *(const LAS f32x4*)(atab + 32 * kt + 8 * g + 4 * hh);
#pragma unroll
            for (int e = 0; e < 4; ++e) { const int i = 4 * g + e; float dm = __expf(av[e] - M_t); if (kt == qt && crow(i, hh) > r) dm = 0.f; const float pv = sc[i] * dm; sc[i] = pv; dsum += pv; }
        }
        const bf16x8 pb0 = pack8(sc, 0), pb1 = pack8(sc, 1);
        n0 = MFMA32(vt_frag(vl, vtr0, 0, 0), pb0, n0); n0 = MFMA32(vt_frag(vl, vtr0, 1, 0), pb1, n0);
        n1 = MFMA32(vt_frag(vl, vtr0, 0, 1), pb0, n1); n1 = MFMA32(vt_frag(vl, vtr0, 1, 1), pb1, n1);
    }
    float ds0, ds1; halves(dsum, ds0, ds1);
    const float den = inter * qn + (ds0 + ds1);
    const float hinv = 1.f / fmaxf(fabsf(den), __expf(-m_t));
    const bf16_t* U = (const bf16_t*)(a.ws + WS_U);
    const bf16_t* og = U + rowq * LDU + OFF_ML_O + h * 64;
    float ss = 0.f;
#pragma unroll
    for (int g = 0; g < 4; ++g) {
        const int d0 = 8 * g + 4 * hh;
        const u32x2 ga = *(const u32x2*)(og + d0), gb = *(const u32x2*)(og + 32 + d0);
        const float oa[4] = {__uint_as_float(ga.x << 16), __uint_as_float(ga.x & 0xffff0000u), __uint_as_float(ga.y << 16), __uint_as_float(ga.y & 0xffff0000u)};
        const float ob[4] = {__uint_as_float(gb.x << 16), __uint_as_float(gb.x & 0xffff0000u), __uint_as_float(gb.y << 16), __uint_as_float(gb.y & 0xffff0000u)};
#pragma unroll
        for (int e = 0; e < 4; ++e) { const float va = sigmoidf_(oa[e]) * n0[4 * g + e] * hinv, vb = sigmoidf_(ob[e]) * n1[4 * g + e] * hinv; n0[4 * g + e] = va; n1[4 * g + e] = vb; ss += va * va + vb * vb; }
    }
    float s0, s1; halves(ss, s0, s1);
    const float rs = rsqrtf((s0 + s1) * (1.f / 64.f) + EPS);
    const float* gh = a.g_head + l * 1024 + h * 64;
    bf16_t* yr = (bf16_t*)(a.ws + WS_Y) + rowq * 1024 + h * 64;
#pragma unroll
    for (int g = 0; g < 4; ++g) {
        const int d0 = 8 * g + 4 * hh;
        const f32x4 ga = *(const f32x4*)(gh + d0), gb = *(const f32x4*)(gh + 32 + d0);
        u32x2 wa, wb; wa.x = cvtpk(n0[4 * g] * rs * ga[0], n0[4 * g + 1] * rs * ga[1]); wa.y = cvtpk(n0[4 * g + 2] * rs * ga[2], n0[4 * g + 3] * rs * ga[3]);
        wb.x = cvtpk(n1[4 * g] * rs * gb[0], n1[4 * g + 1] * rs * gb[1]); wb.y = cvtpk(n1[4 * g + 2] * rs * gb[2], n1[4 * g + 3] * rs * gb[3]);
        *(u32x2*)(yr + d0) = wa; *(u32x2*)(yr + 32 + d0) = wb;
    }
}
__device__ __forceinline__ void phase_ml_b1(const Args& a, int l, LAS unsigned char* lds, int gw, int ngw, int wave_) {
    for (int it = gw; it < NB * 4 * 32; it += ngw) ml_b1_item(a, l, lds + wave_ * 16384, it / 128, (it / 32) & 3, it & 31);
}
__device__ __forceinline__ void phase_ml_b3(const Args& a, int l, LAS unsigned char* lds, int gw, int ngw, int wave_) {
    const int lane = lane_id_opaque();
    for (int it = gw; it < NB * 4 * 32 * 4; it += ngw) ml_b3_item(a, l, lds + wave_ * 16384, it / 512, (it / 128) & 3, (it >> 2) & 31, 3 - (it & 3), lane);
}

__device__ __forceinline__ Args load_args() {
#if defined(__HIP_DEVICE_COMPILE__)
    typedef const __attribute__((address_space(4))) Args* KArgs;
    KArgs p_ = (KArgs)__builtin_amdgcn_kernarg_segment_ptr(); asm volatile("" : "+s"(p_)); return *p_;
#else
    return Args{};
#endif
}
#define KA() load_args()
__global__ void __launch_bounds__(NWAVES * 64, 2) fwd(Args a_unused) {
    extern __shared__ __attribute__((aligned(16))) unsigned char lds_raw[];
    LAS unsigned char* lds = (LAS unsigned char*)lds_raw;
    const int wave = __builtin_amdgcn_readfirstlane((int)threadIdx.x >> 6);
    const int G = gridDim.x, gw = blockIdx.x * NWAVES + wave, ngw = G * NWAVES;
    volatile LAS unsigned* MISC = (volatile LAS unsigned*)(lds + MISC_OFF);
    { const int t0 = wave * 64 + lane_id_opaque(); if (t0 < 32) MISC[t0] = 0u; }
    __syncthreads();
    int lo, hi; unsigned* ctl; { const Args a = KA(); ctl = (unsigned*)(a.ws + WS_CTL); lo = a.ph_lo; hi = a.ph_hi; }
    XcdBarrier bar; bar.bar = ctl + CW_BAR; bar.x = 0; bar.st = nullptr;
    if (hi - lo > 1) bar = xcd_barrier_post(ctl + CW_BAR, MISC + 8, wave == 0 && lane_id_opaque() == 0);
#define IN(k) (lo <= (k) && (k) < hi)
#ifndef DISMASK
#define DISMASK 0
#endif
#define DIS(k) ((DISMASK >> (k)) & 1)
#define SEAM(k) do { if (IN(k) && IN((k) + 1)) xcd_barrier(bar, wave); } while (0)
    if (IN(0) && !DIS(0)) { const Args a = KA(); phase_prologue(a, lds, gw, ngw, wave); }
    SEAM(0);
    for (int l = 0; l < 2; ++l) {
        const int pb = 1 + 10 * l;
        if (IN(pb + 0) && !DIS(1)) { const Args a = KA(); const float* xin = (l == 0) ? a.x : a.out; phase_norm<1>(a, l, xin, lds, gw, ngw, wave); __syncthreads(); }
        SEAM(pb + 0);
        if (IN(pb + 1) && !DIS(2)) { const Args a = KA();
            ProbDense P{(const char*)(a.ws + WS_H), (const char*)(a.ws + WS_WIN) + (size_t)l * LDU * 1024 * 2, 1024};
            pg8::StaticOrder S; S.init(T_TOK / 256, LDU / 256, G, (int)blockIdx.x);
            EpiU E{(bf16_t*)(a.ws + WS_U)};
            pg8::gemm_phase(lds, P, S, E, wave);
        }
        SEAM(pb + 1);
        if (IN(pb + 2) && !DIS(8)) { const Args a = KA(); phase_ml_b1(a, l, lds, gw, ngw, wave); phase_sb(a, l, lds, gw, ngw, wave); }
        SEAM(pb + 2);
        if (IN(pb + 3) && !DIS(9)) { const Args a = KA(); phase_ml_b2(a, (int)blockIdx.x * (NWAVES * 64) + wave * 64 + lane_id_opaque(), G * NWAVES * 64); phase_dil(a, l, lds, gw, ngw, wave); }
        SEAM(pb + 3);
        if (IN(pb + 4) && !DIS(10)) { const Args a = KA(); phase_ml_b3(a, l, lds, gw, ngw, wave); phase_dil_merge(a, l, gw, ngw); }
        SEAM(pb + 4);
        if (IN(pb + 5) && !DIS(3)) { const Args a = KA(); const float* xin = (l == 0) ? a.x : a.out; const float* modl = (const float*)(a.ws + WS_MOD) + (size_t)l * 8 * NMOD;
            ProbDense P{(const char*)(a.ws + WS_Y), (const char*)(a.ws + WS_WOUT) + (size_t)l * 1024 * 1024 * 2, 1024};
            pg8::StaticOrder S; S.init(T_TOK / 256, 4, G, (int)blockIdx.x);
            EpiOut E{xin, a.out, modl + 2048};
            pg8::gemm_phase(lds, P, S, E, wave);
        }
        SEAM(pb + 5);
        if (IN(pb + 6) && !DIS(4)) { const Args a = KA(); phase_norm<2>(a, l, a.out, lds, gw, ngw, wave); __syncthreads(); }
        SEAM(pb + 6);
        if (IN(pb + 7) && !DIS(5)) { const Args a = KA();
            LAS int* tab = (LAS int*)(lds + TAB_OFF); build_moe_tab(a, l, tab, wave);
            const int nMt = tab[352];
            ProbGU P{(const char*)(a.ws + WS_H), (const char*)(a.ws + WS_WGU) + (size_t)l * 16 * 1024 * 1024 * 2, (const int*)(a.ws + WS_LIST), tab};
            pg8::StaticOrder S; S.init(nMt, 8, G, (int)blockIdx.x);
            EpiGU E{(bf16_t*)(a.ws + WS_U), (const int*)(a.ws + WS_LIST), (const float*)(a.ws + WS_RW), tab};
            pg8::gemm_phase(lds, P, S, E, wave);
        }
        SEAM(pb + 7);
        if (IN(pb + 8) && !DIS(6)) { const Args a = KA(); const float* modl = (const float*)(a.ws + WS_MOD) + (size_t)l * 8 * NMOD;
            LAS int* tab = (LAS int*)(lds + TAB_OFF); build_moe_tab(a, l, tab, wave);
            const int nMt = tab[352];
            ProbDown P{(const char*)(a.ws + WS_U), (const char*)(a.ws + WS_WD) + (size_t)l * 16 * 1024 * 512 * 2, tab};
            pg8::StaticOrder S; S.init(nMt, 4, G, (int)blockIdx.x);
            EpiDown E{a.out, (const int*)(a.ws + WS_LIST), modl + 5120, tab};
            pg8::gemm_phase(lds, P, S, E, wave);
        }
        SEAM(pb + 8);
    }
    if (IN(21) && !DIS(7)) { const Args a = KA(); phase_final(a, gw, ngw); }
#undef IN
#undef SEAM
}

__global__ void __launch_bounds__(256) k_qkvm(const bf16_t* __restrict__ U, const float* __restrict__ conv_w, const float* __restrict__ conv_b,
                                              const float* __restrict__ wq, const float* __restrict__ wk, const float* __restrict__ wv, bf16_t* __restrict__ Q, bf16_t* __restrict__ K, bf16_t* __restrict__ V) {
    __shared__ float xc[4][64], xm[4][64];
    const int tid = threadIdx.x, ti = tid >> 6, e = tid & 63;
    const int nitem = (T_TOK / 4) * 4;
    for (int item = blockIdx.x; item < nitem; item += gridDim.x) {
        const int h = item & 3, t = (item >> 2) * 4 + ti;
        const int ts = t % SEQ; const int ch = h * 64 + e;
        float a = conv_b[ch];
#pragma unroll
        for (int j = 0; j < 4; ++j) { const int tt = ts - 3 + j; if (tt >= 0) a += conv_w[j * 256 + ch] * bf2f(U[(size_t)(t - 3 + j) * LDU + OFF_ML_X + ch]); }
        __syncthreads();
        xc[ti][e] = a * sigmoidf_(a);
        xm[ti][e] = bf2f(U[(size_t)t * LDU + OFF_ML_X + ch]);
        __syncthreads();
        float q = 0.f, k = 0.f, v = 0.f;
        for (int d = 0; d < 64; ++d) { const float c = xc[ti][d]; q += c * wq[(h * 64 + d) * 64 + e]; k += c * wk[(h * 64 + d) * 64 + e]; v += xm[ti][d] * wv[(h * 64 + d) * 64 + e]; }
        Q[(size_t)t * 256 + ch] = f2bf(q); K[(size_t)t * 256 + ch] = f2bf(k * 0.125f); V[(size_t)t * 256 + ch] = f2bf(v);
    }
}
__global__ void __launch_bounds__(256) k_mlstm_seq(const bf16_t* __restrict__ Q, const bf16_t* __restrict__ K, const bf16_t* __restrict__ V, const float* __restrict__ gate, const float* __restrict__ gate_bias,
                                                   const bf16_t* __restrict__ U, const float* __restrict__ g_head, bf16_t* __restrict__ Y) {
    __shared__ float sq[32][64], sk[32][64], sv[32][64], sig[32], slf[32];
    __shared__ float red[2][4][64]; __shared__ float sden[2];
    const int tid = threadIdx.x, e = tid & 63, dg = tid >> 6;
    const int b = blockIdx.x >> 2, h = blockIdx.x & 3;
    float C[16];
#pragma unroll
    for (int i = 0; i < 16; ++i) C[i] = 0.f;
    float nst = 0.f, m = 0.f;
    const float bi = gate_bias[h], bff = gate_bias[4 + h];
    for (int t0 = 0; t0 < SEQ; t0 += 32) {
        __syncthreads();
        for (int i = tid; i < 32 * 64; i += 256) { const int tt = i >> 6, d = i & 63; const size_t r = (size_t)(b * SEQ + t0 + tt) * 256 + h * 64 + d; sq[tt][d] = bf2f(Q[r]); sk[tt][d] = bf2f(K[r]); sv[tt][d] = bf2f(V[r]); }
        if (tid < 32) { const size_t r = (size_t)(b * SEQ + t0 + tid) * 8; sig[tid] = gate[r + h] + bi; const float fp = gate[r + 4 + h] + bff; slf[tid] = -softplusf_(-fp); }
        __syncthreads();
        for (int tt = 0; tt < 32; ++tt) {
            const int pb = tt & 1;
            const float ig = sig[tt], lf = slf[tt];
            const float mn = fmaxf(lf + m, ig);
            const float a = __expf(lf + m - mn), bc = __expf(ig - mn);
            m = mn;
            const float ve = sv[tt][e];
            float part = 0.f;
#pragma unroll
            for (int i = 0; i < 16; ++i) { const int d = dg * 16 + i; C[i] = a * C[i] + bc * sk[tt][d] * ve; part += sq[tt][d] * C[i]; }
            red[pb][dg][e] = part;
            if (tid < 64) { nst = a * nst + bc * sk[tt][tid]; const float qn = wave_sum(sq[tt][tid] * nst); if (tid == 0) sden[pb] = qn; }
            __syncthreads();
            if (tid < 64) {
                const float num = red[pb][0][e] + red[pb][1][e] + red[pb][2][e] + red[pb][3][e];
                const float den = sden[pb];
                const float hv = num / fmaxf(fabsf(den), __expf(-m));
                const size_t row = (size_t)(b * SEQ + t0 + tt);
                const float o = sigmoidf_(bf2f(U[row * LDU + OFF_ML_O + h * 64 + e])) * hv;
                const float ss = wave_sum(o * o);
                Y[row * 1024 + h * 64 + e] = f2bf(o * rsqrtf(ss * (1.f / 64.f) + EPS) * g_head[h * 64 + e]);
            }
        }
    }
}
__global__ void __launch_bounds__(256) k_dil(const bf16_t* __restrict__ U, const float* __restrict__ g_head, bf16_t* __restrict__ Y) {
    const int lane = threadIdx.x & 63;
    const int wave = (blockIdx.x * blockDim.x + threadIdx.x) >> 6, nw = (gridDim.x * blockDim.x) >> 6;
    for (int item = wave; item < NB * 6 * SEQ; item += nw) {
        const int t = item % SEQ, h = (item / SEQ) % 6, b = item / (SEQ * 6);
        const size_t row = (size_t)b * SEQ + t;
        const float q = bf2f(U[row * LDU + OFF_DIL + h * 64 + lane]);
        const float slope = exp2f(-8.f * (float)(h + 1) / 6.f);
        float m = -INFINITY, l = 0.f, acc = 0.f;
        for (int p = 0; p < 3; ++p) {
            const int d = (p == 0) ? 1 : (p == 1 ? 4 : 16);
            for (int j = 0; j <= 128; ++j) {
                const int tk = t - j * d; if (tk < 0) break;
                const size_t kr = ((size_t)b * SEQ + tk) * LDU + OFF_DIL + h * 64 + lane;
                const float kv = bf2f(U[kr + 384]), vv = bf2f(U[kr + 768]);
                const float s = wave_sum(q * kv) * 0.125f - slope * (float)(j * d);
                const float mn = fmaxf(m, s); const float corr = __expf(m - mn), pe = __expf(s - mn);
                l = l * corr + pe; acc = acc * corr + pe * vv; m = mn;
            }
        }
        const float o = acc / l;
        const float ss = wave_sum(o * o);
        Y[row * 1024 + (4 + h) * 64 + lane] = f2bf(o * rsqrtf(ss * (1.f / 64.f) + EPS) * g_head[(4 + h) * 64 + lane]);
    }
}
__global__ void __launch_bounds__(256) k_sb(const bf16_t* __restrict__ U, const float* __restrict__ g_head, bf16_t* __restrict__ Y) {
    const int lane = threadIdx.x & 63;
    const int wave = (blockIdx.x * blockDim.x + threadIdx.x) >> 6, nw = (gridDim.x * blockDim.x) >> 6;
    for (int item = wave; item < NB * 6 * SEQ; item += nw) {
        const int t = item % SEQ, h = (item / SEQ) % 6, b = item / (SEQ * 6);
        const size_t row = (size_t)b * SEQ + t;
        const float q = bf2f(U[row * LDU + OFF_SB + h * 64 + lane]);
        float run = 0.f, acc = 0.f;
        for (int s = t - 1; s >= 0; --s) {
            const size_t kr = ((size_t)b * SEQ + s) * LDU + OFF_SB + h * 64 + lane;
            const float kv = bf2f(U[kr + 384]), vv = bf2f(U[kr + 768]);
            const float z = wave_sum(q * kv) * 0.125f;
            const float lk = -softplusf_(z);
            acc += __expf(z + lk + run) * vv;
            run += lk;
            if (run < -104.f) break;
        }
        const float ss = wave_sum(acc * acc);
        Y[row * 1024 + (10 + h) * 64 + lane] = f2bf(acc * rsqrtf(ss * (1.f / 64.f) + EPS) * g_head[(10 + h) * 64 + lane]);
    }
}

extern "C" void kernel_launch(void* const* d_in, const int* in_sizes, int n_in, void* d_out, int out_size, void* d_ws, size_t ws_size, hipStream_t stream) {
    static int grid = 0;
    if (grid == 0) {
        int dev = 0, cus = 0;
        if (ws_size < WS_END) { fprintf(stderr, "kernel_launch: workspace too small (%zu < %zu)\n", ws_size, (size_t)WS_END); grid = -1; return; }
        if (hipGetDevice(&dev) != hipSuccess || hipDeviceGetAttribute(&cus, hipDeviceAttributeMultiprocessorCount, dev) != hipSuccess) { grid = -1; return; }
        if (hipFuncSetAttribute((const void*)fwd, hipFuncAttributeMaxDynamicSharedMemorySize, LDS_BYTES) != hipSuccess) { fprintf(stderr, "kernel_launch: hipFuncSetAttribute failed\n"); grid = -1; return; }
        (void)hipGetLastError();
        grid = cus;
    }
    if (grid < 0) return;
    Args a{};
    a.x = (const float*)d_in[0]; a.c = (const float*)d_in[1]; a.w_in = (const float*)d_in[2]; a.conv_w = (const float*)d_in[3]; a.conv_b = (const float*)d_in[4];
    a.w_mq = (const float*)d_in[5]; a.w_mk = (const float*)d_in[6]; a.w_mv = (const float*)d_in[7]; a.gate_bias = (const float*)d_in[8]; a.g_head = (const float*)d_in[9];
    a.w_out = (const float*)d_in[10]; a.w_ada = (const float*)d_in[11]; a.b_ada = (const float*)d_in[12]; a.w_router = (const float*)d_in[13]; a.router_bias = (const float*)d_in[14];
    a.w_gate_e = (const float*)d_in[15]; a.w_up_e = (const float*)d_in[16]; a.w_down_e = (const float*)d_in[17]; a.g_final = (const float*)d_in[18];
    a.out = (float*)d_out; a.ws = (unsigned char*)d_ws;
    char* ws = (char*)d_ws;
    (void)hipMemsetAsync(ws + WS_CTL, 0, CTL_BYTES, stream);
    float* gate = (float*)(ws + WS_GATE); bf16_t* U = (bf16_t*)(ws + WS_U);
    bf16_t* Y = (bf16_t*)(ws + WS_Y); bf16_t* Qm = (bf16_t*)(ws + WS_QKV); bf16_t* Km = Qm + (size_t)T_TOK * 256; bf16_t* Vm = Km + (size_t)T_TOK * 256;
#define RUN(lo_, hi_) do { a.ph_lo = (lo_); a.ph_hi = (hi_); hipLaunchKernelGGL(fwd, dim3(grid), dim3(NWAVES * 64), LDS_BYTES, stream, a); } while (0)
#if defined(MK_SPLIT)
    RUN(0, 1);
    for (int l = 0; l < 2; ++l) { const int pb = 1 + 10 * l; for (int k = 0; k < 9; ++k) RUN(pb + k, pb + k + 1); }
    RUN(21, 22);
#else
    RUN(0, 22);
#endif
#undef RUN
}
```

```cpp
#include <hip/hip_runtime.h>
#include <stdint.h>
#include <stdio.h>

#define T_TOK 32768
#define SEQ 4096
#define DM 1024
#define NB 8
#define DIN 2824
#define LDU 2816
#define OFF_ML_X 0
#define OFF_ML_O 256
#define OFF_DIL 512
#define OFF_SB 1664
#define NMOD 6144
#define EPS 1e-6f
#define NBUCK 24

#define LAS __attribute__((address_space(3)))
typedef unsigned short bf16_t;
typedef short bf16x8 __attribute__((ext_vector_type(8)));
typedef float f32x4 __attribute__((ext_vector_type(4)));
typedef float f32x2 __attribute__((ext_vector_type(2)));
typedef unsigned u32x4 __attribute__((ext_vector_type(4)));
typedef unsigned u32x2 __attribute__((ext_vector_type(2)));

__device__ __forceinline__ float bf2f(bf16_t v) { return __uint_as_float(((unsigned)v) << 16); }
__device__ __forceinline__ unsigned f2bf_u(float f) { unsigned u = __float_as_uint(f); return (u + 0x7fffu + ((u >> 16) & 1u)) >> 16; }
__device__ __forceinline__ bf16_t f2bf(float f) { return (bf16_t)f2bf_u(f); }
__device__ __forceinline__ unsigned pk2(float lo, float hi) { return f2bf_u(lo) | (f2bf_u(hi) << 16); }
__device__ __forceinline__ float wave_sum(float v) {
#pragma unroll
    for (int o = 32; o > 0; o >>= 1) v += __shfl_xor(v, o, 64);
    return v;
}
__device__ __forceinline__ float bperm_f(float v, int srclane) { return __int_as_float(__builtin_amdgcn_ds_bpermute((srclane & 63) << 2, __float_as_int(v))); }
__device__ __forceinline__ int lane_id_opaque() { int r; asm volatile("v_mbcnt_lo_u32_b32 %0, -1, 0\n\tv_mbcnt_hi_u32_b32 %0, -1, %0" : "=v"(r)); return r; }
__device__ __forceinline__ float wave_sum_l(float v, int lane) {
#pragma unroll
    for (int o = 32; o > 0; o >>= 1) v += __int_as_float(__builtin_amdgcn_ds_bpermute((lane ^ o) << 2, __float_as_int(v)));
    return v;
}
__device__ __forceinline__ float sigmoidf_(float x) { return 1.f / (1.f + __expf(-x)); }
__device__ __forceinline__ float softplusf_(float z) { return fmaxf(z, 0.f) + log1pf(__expf(-fabsf(z))); }

constexpr size_t MiB = 1u << 20;
constexpr size_t WS_CTL   = 0;
constexpr size_t CTL_BYTES = 1 * MiB;
constexpr size_t WS_MOD   = 1 * MiB;
constexpr size_t WS_GATE  = WS_MOD + 512 * 1024;
constexpr size_t WS_RW    = WS_GATE + 1 * MiB;
constexpr size_t WS_LIST  = WS_RW + 256 * 1024;
constexpr size_t WS_WIN   = 6 * MiB;
constexpr size_t WS_WOUT  = 17 * MiB;
constexpr size_t WS_WGU   = 21 * MiB;
constexpr size_t WS_WD    = 85 * MiB;
constexpr size_t WS_H     = 117 * MiB;
constexpr size_t WS_U     = 181 * MiB;
constexpr size_t WS_Y     = 357 * MiB;
constexpr size_t WS_QKV   = 421 * MiB;
constexpr size_t WS_OP01  = WS_H;
constexpr size_t WS_CLOC  = WS_H + 48 * MiB;
constexpr size_t WS_OP2   = 469 * MiB;
constexpr size_t WS_LSE   = 493 * MiB;
constexpr size_t WS_CT    = 496 * MiB;
constexpr size_t WS_MLS   = 504 * MiB;
constexpr size_t WS_END   = 507 * MiB;
constexpr size_t MLS_CUM = 0, MLS_AA = 512 * 1024, MLS_PM = 1024 * 1024, MLS_NLOC = 1536 * 1024, MLS_NC = 1792 * 1024, MLS_AMAX = 2048 * 1024, MLS_LSUM = 2052 * 1024, MLS_MC = 2056 * 1024, MLS_WT = 2304 * 1024;

constexpr int CW_BAR = 4096;
constexpr int CW_CNT = 8192;

namespace pg8 {
constexpr int BM = 256, BK = 64, HALF = 128, HTB = HALF * BK * 2, STAGE_BYTES = 8 * HTB, NXCD = 8, WGM = 8;
__host__ __device__ __forceinline__ int lds_byte(int r, int c) { const int st = (r >> 4) * 2 + (c >> 5), rr = r & 15, cc = c & 31, ob = rr * 64 + cc * 2; return st * 1024 + (ob ^ (((ob >> 9) & 1) << 5)); }
__host__ __device__ __forceinline__ void stage_rc(int b, int& R, int& C) { const int st = b / 1024, sb = b % 1024, swz = sb ^ (((sb >> 9) & 1) << 5); R = (st >> 1) * 16 + swz / 64; C = (st & 1) * 32 + (swz % 64) / 2; }
__host__ __device__ __forceinline__ int perm32(int rho) { const int n = rho >> 4, i = rho & 15; return 8 * (i >> 2) + 4 * n + (i & 3); }
struct Unit { int pm, pn; };
struct StaticOrder {
    int nM, nN, nwg, G, c;
    __device__ void init(int nM_, int nN_, int G_, int c_) { nM = nM_; nN = nN_; nwg = nM * nN; G = G_; c = c_; }
    __device__ bool next(int i, Unit& u) const {
        const long L = (long)i * G + c; if (L >= nwg) return false;
        int wgid = (int)L; { const int q = nwg / NXCD, r = nwg % NXCD, xcd = wgid % NXCD, off = wgid / NXCD; wgid = (xcd < r ? xcd * (q + 1) : r * (q + 1) + (xcd - r) * q) + off; }
        const int nig = WGM * nN, gid = wgid / nig, fm = gid * WGM, gsz = (nM - fm) < WGM ? (nM - fm) : WGM;
        u.pm = fm + ((wgid % nig) % gsz); u.pn = (wgid % nig) / gsz; return true;
    }
};
__device__ __forceinline__ unsigned cvt_pk_bf16(float lo, float hi) { unsigned r; asm volatile("v_cvt_pk_bf16_f32 %0, %1, %2" : "=v"(r) : "v"(lo), "v"(hi)); return r; }

template <class P, class Epi, class Sched>
__device__ __forceinline__ void gemm_phase(LAS unsigned char* lds, const P& pb, const Sched& S, const Epi& E, int wave_) {
    const int tid_ = wave_ * 64 + lane_id_opaque();
    const int tid = tid_, wid = __builtin_amdgcn_readfirstlane(tid >> 6), lane = tid & 63, wr = wid >> 2, wc = wid & 3, fr = lane & 15, fq = lane >> 4;
    const int nt = pb.nt();
    unsigned voffB[2];
#pragma unroll
    for (int i = 0; i < 2; ++i) { int R, C; stage_rc(tid * 16 + i * 8192, R, C); const int Rb = Epi::PERM ? ((R & ~31) + perm32(R & 31)) : R; voffB[i] = (unsigned)(Rb * pb.ldb() + C) * 2u; }
    const size_t hstepB = (size_t)HALF * pb.ldb() * 2;
    const unsigned ldsw = (unsigned)wid * 1024u;
    const int aoff = lds_byte(wr * 64 + fr, fq * 8), boff = lds_byte(wc * 32 + fr, fq * 8);
#define PG8_SA(b, h) (((b) * 2 + (h)) * HTB)
#define PG8_SB(b, h) ((4 + (b) * 2 + (h)) * HTB)
#define PG8_STAGE(bufoff, gbase, voff) do { _Pragma("unroll") for (int _i = 0; _i < 2; ++_i) \
        __builtin_amdgcn_global_load_lds((const unsigned*)((const char*)(gbase) + (voff)[_i]), (LAS unsigned*)(lds + (bufoff) + ldsw + _i * 8192), 16, 0, 0); } while (0)
#define PG8_LDA(dst, b, h) do { _Pragma("unroll") for (int m = 0; m < 4; ++m) _Pragma("unroll") for (int k = 0; k < 2; ++k) dst[m][k] = *(const LAS bf16x8*)(lds + PG8_SA(b, h) + aoff + m * 2048 + k * 1024); } while (0)
#define PG8_LDB(dst, b, h) do { _Pragma("unroll") for (int n = 0; n < 2; ++n) _Pragma("unroll") for (int k = 0; k < 2; ++k) dst[n][k] = *(const LAS bf16x8*)(lds + PG8_SB(b, h) + boff + n * 2048 + k * 1024); } while (0)
#define PG8_MMA(ai, bj, At, Bt) do { __builtin_amdgcn_s_setprio(1); _Pragma("unroll") for (int m = 0; m < 4; ++m) _Pragma("unroll") for (int n = 0; n < 2; ++n) _Pragma("unroll") for (int k = 0; k < 2; ++k) \
        acc[ai][bj][m][n] = __builtin_amdgcn_mfma_f32_16x16x32_bf16(Bt[n][k], At[m][k], acc[ai][bj][m][n], 0, 0, 0); __builtin_amdgcn_s_setprio(0); } while (0)
#define PG8_WAIT_V(n) asm volatile("s_waitcnt vmcnt(" #n ")" ::: "memory")
#define PG8_WAIT_L(n) asm volatile("s_waitcnt lgkmcnt(" #n ")" ::: "memory")
#define PG8_BAR __builtin_amdgcn_s_barrier()
#define PG8_SCHED __builtin_amdgcn_sched_barrier(0)
#define PG8_AOFF(dst, u) do { int _t = tid; asm volatile("" : "+v"(_t)); _Pragma("unroll") for (int _i = 0; _i < 2; ++_i) { int _R, _C; stage_rc(_t * 16 + _i * 8192, _R, _C); \
        _Pragma("unroll") for (int _h = 0; _h < 2; ++_h) dst[_h][_i] = pb.a_row(u, _h * HALF + _R) + (unsigned)_C * 2u; } } while (0)
    Unit cur, nxt; int ui = 0;
    if (!S.next(0, cur)) return;
    f32x4 acc[2][2][4][2];
#pragma unroll
    for (int a = 0; a < 2; ++a)
#pragma unroll
        for (int b = 0; b < 2; ++b)
#pragma unroll
            for (int m = 0; m < 4; ++m)
#pragma unroll
                for (int n = 0; n < 2; ++n) acc[a][b][m][n] = (f32x4){0.f, 0.f, 0.f, 0.f};
    bf16x8 At[4][2], B0[2][2], B1[2][2];
    unsigned ca[2][2], na[2][2];
    PG8_AOFF(ca, cur);
    const char* Ab = pb.a_base();
    {
        const char* b0 = pb.b_tile(cur, 0); const char* b1 = pb.b_tile(cur, 1);
        PG8_STAGE(PG8_SB(0, 0), b0, voffB); PG8_STAGE(PG8_SB(0, 1), b0 + hstepB, voffB); PG8_STAGE(PG8_SA(0, 0), Ab, ca[0]); PG8_STAGE(PG8_SA(0, 1), Ab, ca[1]);
        if (wr == 1) PG8_BAR;
        PG8_WAIT_V(2); PG8_BAR;
        PG8_STAGE(PG8_SB(1, 0), b1, voffB); PG8_STAGE(PG8_SA(1, 0), Ab + 128, ca[0]); PG8_STAGE(PG8_SB(1, 1), b1 + hstepB, voffB);
        PG8_WAIT_V(6); PG8_BAR;
    }
    for (;;) {
        const bool has_next = S.next(ui + 1, nxt);
        if (!has_next) nxt = cur;
        PG8_AOFF(na, nxt);
#define PG8_KPAIR(A2BASE, OFF2, B2, B3, A1P) do { \
              \
            PG8_LDB(B0, 0, 0); PG8_LDB(B1, 0, 1); PG8_SCHED; PG8_LDA(At, 0, 0); PG8_STAGE(PG8_SA(1, 1), A1P, ca[1]); \
            PG8_WAIT_V(8); PG8_WAIT_L(0); PG8_BAR; PG8_MMA(0, 0, At, B0); PG8_MMA(0, 1, At, B1); PG8_BAR; PG8_SCHED; \
              \
            PG8_LDA(At, 0, 1); PG8_STAGE(PG8_SB(0, 0), B2, voffB); PG8_STAGE(PG8_SB(0, 1), (B2) + hstepB, voffB); PG8_STAGE(PG8_SA(0, 0), A2BASE, OFF2[0]); \
            PG8_WAIT_V(8); PG8_WAIT_L(0); PG8_BAR; PG8_MMA(1, 0, At, B0); PG8_MMA(1, 1, At, B1); PG8_BAR; PG8_SCHED; \
              \
            PG8_LDB(B0, 1, 0); PG8_LDB(B1, 1, 1); PG8_SCHED; PG8_LDA(At, 1, 0); PG8_STAGE(PG8_SA(0, 1), A2BASE, OFF2[1]); \
            PG8_WAIT_V(8); PG8_WAIT_L(0); PG8_BAR; PG8_MMA(0, 0, At, B0); PG8_MMA(0, 1, At, B1); PG8_BAR; PG8_SCHED; \
              \
            PG8_LDA(At, 1, 1); PG8_STAGE(PG8_SB(1, 0), B3, voffB); PG8_STAGE(PG8_SB(1, 1), (B3) + hstepB, voffB); PG8_STAGE(PG8_SA(1, 0), (A2BASE) + 128, OFF2[0]); \
            PG8_WAIT_V(8); PG8_WAIT_L(0); PG8_BAR; PG8_MMA(1, 0, At, B0); PG8_MMA(1, 1, At, B1); PG8_BAR; PG8_SCHED; } while (0)
        for (int t = 0; t < nt - 2; t += 2) {
            const char* b2 = pb.b_tile(cur, t + 2); const char* b3 = pb.b_tile(cur, t + 3);
            const char* a1p = Ab + (size_t)(t + 1) * 128; const char* a2p = Ab + (size_t)(t + 2) * 128;
            PG8_KPAIR(a2p, ca, b2, b3, a1p);
        }
        {
            const char* b2 = pb.b_tile(nxt, 0); const char* b3 = pb.b_tile(nxt, 1);
            const char* a1p = Ab + (size_t)(nt - 1) * 128;
            PG8_KPAIR(Ab, na, b2, b3, a1p);
        }
#undef PG8_KPAIR
        if (wr == 0) PG8_BAR;
        E(acc, cur, wr, wc, fr, fq);
        if (!has_next) break;
#pragma unroll
        for (int a = 0; a < 2; ++a)
#pragma unroll
            for (int b = 0; b < 2; ++b)
#pragma unroll
                for (int m = 0; m < 4; ++m)
#pragma unroll
                    for (int n = 0; n < 2; ++n) acc[a][b][m][n] = (f32x4){0.f, 0.f, 0.f, 0.f};
        cur = nxt;
#pragma unroll
        for (int h = 0; h < 2; ++h)
#pragma unroll
            for (int i = 0; i < 2; ++i) ca[h][i] = na[h][i];
        ++ui;
        if (wr == 1) PG8_BAR;
    }
    PG8_WAIT_V(0);
    PG8_BAR;
#undef PG8_SA
#undef PG8_SB
#undef PG8_STAGE
#undef PG8_LDA
#undef PG8_LDB
#undef PG8_MMA
#undef PG8_WAIT_V
#undef PG8_WAIT_L
#undef PG8_BAR
#undef PG8_SCHED
#undef PG8_AOFF
}
}
using pg8::Unit;

struct ProbDense {
    const char* A; const char* B; int K;
    __device__ __forceinline__ int nt() const { return K / 64; }
    __device__ __forceinline__ int ldb() const { return K; }
    __device__ __forceinline__ const char* a_base() const { return A; }
    __device__ __forceinline__ unsigned a_row(const Unit& u, int r) const { return (unsigned)((u.pm * 256 + r) * K) * 2u; }
    __device__ __forceinline__ const char* b_tile(const Unit& u, int t) const { return B + (size_t)u.pn * 256 * K * 2 + (size_t)t * 128; }
};
__device__ __forceinline__ int bucket_e0(int k) { const int g = k / 6, p = k % 6; return 4 * g + (p < 3 ? 0 : (p < 5 ? 1 : 2)); }
__device__ __forceinline__ int bucket_e1(int k) { const int g = k / 6, p = k % 6; return 4 * g + (p < 3 ? p + 1 : (p < 5 ? p - 1 : 3)); }
struct ProbGU {
    const char* H; const char* W; const int* list; const LAS int* tab;
    __device__ __forceinline__ int nt() const { return 16; }
    __device__ __forceinline__ int ldb() const { return 1024; }
    __device__ __forceinline__ const char* a_base() const { return H; }
    __device__ __forceinline__ unsigned a_row(const Unit& u, int r) const {
        const int k = tab[32 + u.pm], rr = tab[192 + u.pm] + r; int tok = 0; if (rr < tab[k]) tok = list[(size_t)k * T_TOK + rr]; return (unsigned)tok * 2048u; }
    __device__ __forceinline__ const char* b_tile(const Unit& u, int t) const {
        const int k = __builtin_amdgcn_readfirstlane(tab[32 + u.pm]); const int e = (u.pn < 4) ? bucket_e0(k) : bucket_e1(k);
        return W + (size_t)e * (1024 * 1024 * 2) + (size_t)(u.pn & 3) * 256 * 2048 + (size_t)t * 128; }
};
struct ProbDown {
    const char* HE; const char* W; const LAS int* tab;
    __device__ __forceinline__ int nt() const { return 16; }
    __device__ __forceinline__ int ldb() const { return 512; }
    __device__ __forceinline__ const char* a_base() const { return HE; }
    __device__ __forceinline__ unsigned a_row(const Unit& u, int r) const { return (unsigned)(u.pm * 256 + r) * 2048u; }
    __device__ __forceinline__ const char* b_tile(const Unit& u, int t) const {
        const int k = __builtin_amdgcn_readfirstlane(tab[32 + u.pm]); const int e = (t < 8) ? bucket_e0(k) : bucket_e1(k);
        return W + (size_t)e * (1024 * 512 * 2) + (size_t)u.pn * 256 * 1024 + (size_t)(t & 7) * 128; }
};

struct EpiU {
    static constexpr bool PERM = true;
    bf16_t* O;
    __device__ __forceinline__ void operator()(const f32x4 (&acc)[2][2][4][2], const Unit& u, int wr, int wc, int fr, int fq) const {
        const int row0 = u.pm * 256 + wr * 64 + fr, col0 = u.pn * 256 + wc * 32 + 8 * fq;
#pragma unroll
        for (int ai = 0; ai < 2; ++ai)
#pragma unroll
            for (int m = 0; m < 4; ++m) { bf16_t* rowp = O + (size_t)(row0 + ai * 128 + m * 16) * LDU + col0;
#pragma unroll
                for (int bj = 0; bj < 2; ++bj) { const f32x4 v0 = acc[ai][bj][m][0], v1 = acc[ai][bj][m][1];
                    u32x4 w; w.x = pg8::cvt_pk_bf16(v0[0], v0[1]); w.y = pg8::cvt_pk_bf16(v0[2], v0[3]); w.z = pg8::cvt_pk_bf16(v1[0], v1[1]); w.w = pg8::cvt_pk_bf16(v1[2], v1[3]);
                    *(u32x4*)(rowp + bj * 128) = w; } }
    }
};
struct EpiOut {
    static constexpr bool PERM = false;
    const float* xin; float* X; const float* gate;
    __device__ __forceinline__ void operator()(const f32x4 (&acc)[2][2][4][2], const Unit& u, int wr, int wc, int fr, int fq) const {
        const int b = (u.pm * 256) / SEQ; const int col0 = u.pn * 256 + wc * 32 + 4 * fq;
        f32x4 gv[2][2];
#pragma unroll
        for (int bj = 0; bj < 2; ++bj)
#pragma unroll
            for (int n = 0; n < 2; ++n) gv[bj][n] = *(const f32x4*)(gate + (size_t)b * NMOD + col0 + bj * 128 + n * 16);
#pragma unroll
        for (int ai = 0; ai < 2; ++ai)
#pragma unroll
            for (int m = 0; m < 4; ++m) { const size_t off = (size_t)(u.pm * 256 + ai * 128 + wr * 64 + m * 16 + fr) * DM + col0;
#pragma unroll
                for (int bj = 0; bj < 2; ++bj)
#pragma unroll
                    for (int n = 0; n < 2; ++n) { const f32x4 xi = *(const f32x4*)(xin + off + bj * 128 + n * 16); *(f32x4*)(X + off + bj * 128 + n * 16) = xi + gv[bj][n] * acc[ai][bj][m][n]; } }
    }
};
struct EpiGU {
    static constexpr bool PERM = true;
    bf16_t* HE; const int* list; const float* rw; const LAS int* tab;
    __device__ __forceinline__ void operator()(const f32x4 (&acc)[2][2][4][2], const Unit& u, int wr, int wc, int fr, int fq) const {
        const int k = tab[32 + u.pm], r0 = tab[192 + u.pm], cnt = tab[k]; const int part = u.pn >> 2;
        const int hcol0 = part * 512 + ((u.pn & 3) * 256 + wc * 32 + 8 * fq) / 2;
#pragma unroll
        for (int ai = 0; ai < 2; ++ai)
#pragma unroll
            for (int m = 0; m < 4; ++m) { const int r = ai * 128 + wr * 64 + m * 16 + fr; const int rr = r0 + r;
                if (rr < cnt) { const int tok = list[(size_t)k * T_TOK + rr]; const float w = rw[tok * 2 + part];
                    bf16_t* rowp = HE + (size_t)(u.pm * 256 + r) * 1024 + hcol0;
#pragma unroll
                    for (int bj = 0; bj < 2; ++bj) { const f32x4 v0 = acc[ai][bj][m][0], v1 = acc[ai][bj][m][1];
                        const float h0 = v0[0] * sigmoidf_(v0[0]) * v0[1] * w, h1 = v0[2] * sigmoidf_(v0[2]) * v0[3] * w, h2 = v1[0] * sigmoidf_(v1[0]) * v1[1] * w, h3 = v1[2] * sigmoidf_(v1[2]) * v1[3] * w;
                        u32x2 o; o.x = pg8::cvt_pk_bf16(h0, h1); o.y = pg8::cvt_pk_bf16(h2, h3);
                        *(u32x2*)(rowp + bj * 64) = o; } } }
    }
};
struct EpiDown {
    static constexpr bool PERM = false;
    float* X; const int* list; const float* gate; const LAS int* tab;
    __device__ __forceinline__ void operator()(const f32x4 (&acc)[2][2][4][2], const Unit& u, int wr, int wc, int fr, int fq) const {
        const int k = tab[32 + u.pm], r0 = tab[192 + u.pm], cnt = tab[k]; const int col0 = u.pn * 256 + wc * 32 + 4 * fq;
        int tok[2][4];
#pragma unroll
        for (int ai = 0; ai < 2; ++ai)
#pragma unroll
            for (int m = 0; m < 4; ++m) { const int rr = r0 + ai * 128 + wr * 64 + m * 16 + fr; tok[ai][m] = (rr < cnt) ? list[(size_t)k * T_TOK + rr] : -1; }
#pragma unroll
        for (int ai = 0; ai < 2; ++ai)
#pragma unroll
            for (int mp = 0; mp < 4; mp += 2) {
                f32x4 xi[2][2][2], gv[2][2][2];
#pragma unroll
                for (int mm = 0; mm < 2; ++mm) { const int tk = tok[ai][mp + mm]; const int tks = tk < 0 ? 0 : tk; const float* xr = X + (size_t)tks * DM + col0; const float* gr = gate + (size_t)(tks / SEQ) * NMOD + col0;
#pragma unroll
                    for (int bj = 0; bj < 2; ++bj)
#pragma unroll
                        for (int n = 0; n < 2; ++n) { xi[mm][bj][n] = *(const f32x4*)(xr + bj * 128 + n * 16); gv[mm][bj][n] = *(const f32x4*)(gr + bj * 128 + n * 16); } }
#pragma unroll
                for (int mm = 0; mm < 2; ++mm) { const int tk = tok[ai][mp + mm];
                    if (tk >= 0) { float* xr = X + (size_t)tk * DM + col0;
#pragma unroll
                        for (int bj = 0; bj < 2; ++bj)
#pragma unroll
                            for (int n = 0; n < 2; ++n) *(f32x4*)(xr + bj * 128 + n * 16) = xi[mm][bj][n] + gv[mm][bj][n] * acc[ai][bj][mp + mm][n]; } }
            }
    }
};

#define XB_TMO      128
#define XB_XCNT(j)  (256  + 64 * (j))
#define XB_XSUB(j)  (1280 + 64 * (j))
#define XB_XGEN(j)  (2304 + 64 * (j))
#define XB_TOP      3328
#define XB_TOPGEN   3392
#define XCD_BAR_WORDS 3456
#define XB_SPIN_CAP (1u << 18)
__device__ __forceinline__ unsigned xb_ld(unsigned* p)              { return __hip_atomic_load(p, __ATOMIC_RELAXED, __HIP_MEMORY_SCOPE_AGENT); }
__device__ __forceinline__ unsigned xb_add(unsigned* p, unsigned v) { return __hip_atomic_fetch_add(p, v, __ATOMIC_RELAXED, __HIP_MEMORY_SCOPE_AGENT); }
__device__ __forceinline__ unsigned xb_xcc_id() { return (unsigned)__builtin_amdgcn_s_getreg((3 << 11) | 20) & 0xFu; }
#define XB_SPIN(cond, bar) do { unsigned _sp = 0; while (cond) { __builtin_amdgcn_s_sleep(1); \
    if ((++_sp & 255u) == 0u) { if (xb_ld(&(bar)[XB_TMO])) break; if (_sp > XB_SPIN_CAP) { atomicAdd(&(bar)[XB_TMO], 1u); break; } } } } while (0)
struct XcdBarrier { unsigned* bar; unsigned x; volatile LAS unsigned* st; };
__device__ __forceinline__ XcdBarrier xcd_barrier_post(unsigned* bar, volatile LAS unsigned* st, bool leader) {
    XcdBarrier b; b.bar = bar; b.x = xb_xcc_id(); b.st = st;
    if (leader) (void)xb_add(&bar[XB_XCNT(b.x)], 1u);
    return b;
}
__device__ __forceinline__ void xcd_barrier_complete(unsigned* bar, unsigned x, unsigned& nloc, unsigned& nx) {
    const unsigned G = gridDim.x * gridDim.y * gridDim.z;
    unsigned sum, cnt, mine, sp = 0u;
    for (;;) {
        sum = 0u; cnt = 0u; mine = 0u;
#pragma unroll
        for (unsigned j = 0; j < 16; ++j) { const unsigned c = xb_ld(&bar[XB_XCNT(j)]); sum += c; cnt += (c > 0u) ? 1u : 0u; mine = (j == x) ? c : mine; }
        if (sum == G) break;
        __builtin_amdgcn_s_sleep(1);
        if ((++sp & 255u) == 0u) { if (xb_ld(&bar[XB_TMO])) break; if (sp > XB_SPIN_CAP) { atomicAdd(&bar[XB_TMO], 1u); break; } }
    }
    nloc = mine > 0u ? mine : 1u; nx = cnt > 0u ? cnt : 1u;
}
__device__ __forceinline__ void xcd_barrier(const XcdBarrier& b, int wave_) {
    asm volatile("s_waitcnt vmcnt(0)" ::: "memory");
    __syncthreads();
    if (wave_ == 0 && lane_id_opaque() == 0) {
        unsigned* bar = b.bar; asm volatile("" : "+s"(bar));
        __builtin_amdgcn_s_waitcnt(0);
        unsigned nloc = b.st[0], nx = b.st[1];
        if (nloc == 0u) { xcd_barrier_complete(bar, b.x, nloc, nx); b.st[0] = nloc; b.st[1] = nx; }
        const unsigned old = xb_add(&bar[XB_XSUB(b.x)], 1u);
        const unsigned gen = old / nloc;
        if (old + 1u == (gen + 1u) * nloc) {
            __builtin_amdgcn_fence(__ATOMIC_RELEASE, "agent");
            asm volatile("s_waitcnt vmcnt(0)" ::: "memory");
            const unsigned og = xb_add(&bar[XB_TOP], 1u);
            const unsigned tg = og / nx;
            if (og + 1u == (tg + 1u) * nx) xb_add(&bar[XB_TOPGEN], 1u);
            else XB_SPIN(xb_ld(&bar[XB_TOPGEN]) == tg, bar);
            __builtin_amdgcn_fence(__ATOMIC_ACQUIRE, "agent");
            xb_add(&bar[XB_XGEN(b.x)], 1u);
            asm volatile("s_waitcnt vmcnt(0)" ::: "memory");
        } else {
            XB_SPIN(xb_ld(&bar[XB_XGEN(b.x)]) == gen, bar);
            __builtin_amdgcn_fence(__ATOMIC_ACQUIRE, "agent");
            asm volatile("s_waitcnt vmcnt(0)" ::: "memory");
        }
    }
    __syncthreads();
}

constexpr int NWAVES = 8;
constexpr int RING_BYTES = 131072;
constexpr int TAB_OFF = RING_BYTES;
constexpr int MISC_OFF = TAB_OFF + 2048;
constexpr int LDS_BYTES = 147456;

struct Args {
    const float* x; const float* c; const float* w_in; const float* conv_w; const float* conv_b; const float* w_mq; const float* w_mk; const float* w_mv;
    const float* gate_bias; const float* g_head; const float* w_out; const float* w_ada; const float* b_ada; const float* w_router; const float* router_bias;
    const float* w_gate_e; const float* w_up_e; const float* w_down_e; const float* g_final;
    float* out; unsigned char* ws; int ph_lo, ph_hi;
};

template <class SrcF>
__device__ __forceinline__ void transpose_item(const SrcF& src, bf16_t* WT, int Kd, int k0, int n0, LAS float* scr, int lane) {
#pragma unroll 8
    for (int i = 0; i < 32; ++i) { const int kk = 2 * i + (lane >> 5); scr[kk * 33 + (lane & 31)] = src(k0 + kk, n0 + (lane & 31)); }
    asm volatile("s_waitcnt lgkmcnt(0)" ::: "memory");
    const int c = lane & 7;
#pragma unroll
    for (int j = 0; j < 4; ++j) { const int n = (lane >> 3) + 8 * j; const LAS float* s = scr + (8 * c) * 33 + n;
        u32x4 o; o.x = pk2(s[0 * 33], s[1 * 33]); o.y = pk2(s[2 * 33], s[3 * 33]); o.z = pk2(s[4 * 33], s[5 * 33]); o.w = pk2(s[6 * 33], s[7 * 33]);
        *(u32x4*)(WT + (size_t)(n0 + n) * Kd + k0 + 8 * c) = o; }
    asm volatile("s_waitcnt lgkmcnt(0)" ::: "memory");
}

__device__ __forceinline__ void phase_prologue(const Args& a, LAS unsigned char* lds, int gw, int ngw, int wave_) {
    const int lane = lane_id_opaque(), tid = wave_ * 64 + lane;
    LAS float* cact = (LAS float*)(lds + 98304);
    for (int i = tid; i < 8192; i += NWAVES * 64) { const float cv = a.c[i]; cact[i] = cv * sigmoidf_(cv); }
    __syncthreads();
    float* mod = (float*)(a.ws + WS_MOD);
    for (int it = gw; it < 2 * 96; it += ngw) {
        const int l = it / 96, j = (it % 96) * 64 + lane;
        const float* w = a.w_ada + (size_t)l * 1024 * NMOD + j;
        float acc[8];
#pragma unroll
        for (int b = 0; b < 8; ++b) acc[b] = a.b_ada[l * NMOD + j];
        for (int k = 0; k < 1024; k += 8) {
            float wv[8];
#pragma unroll
            for (int kk = 0; kk < 8; ++kk) wv[kk] = w[(size_t)(k + kk) * NMOD];
#pragma unroll
            for (int kk = 0; kk < 8; ++kk)
#pragma unroll
                for (int b = 0; b < 8; ++b) acc[b] += cact[b * 1024 + k + kk] * wv[kk];
        }
#pragma unroll
        for (int b = 0; b < 8; ++b) mod[((size_t)l * 8 + b) * NMOD + j] = acc[b];
    }
    { bf16_t* WT = (bf16_t*)(a.ws + WS_MLS + MLS_WT);
      for (int i = gw * 64 + lane; i < 2 * 3 * 4 * 4096; i += ngw * 64) {
          const int d = i & 63, e = (i >> 6) & 63, h = (i >> 12) & 3, w = (i >> 14) % 3, l = i / (3 * 4 * 4096);
          const float* src = (w == 0) ? a.w_mq : (w == 1 ? a.w_mk : a.w_mv);
          const float v = src[((size_t)(l * 4 + h) * 64 + d) * 64 + e];
          WT[i] = f2bf(w == 1 ? v * 0.125f : v); } }
    LAS float* scr = (LAS float*)(lds + (tid >> 6) * 8704);
    constexpr int I_IN = 16 * 88, I_OUT = 16 * 32, I_GU = 16 * 16 * 32, I_D = 16 * 8 * 32, I_L = I_IN + I_OUT + I_GU + I_D;
    for (int it = gw; it < 2 * I_L; it += ngw) {
        const int l = it / I_L; int r = it % I_L;
        if (r < I_IN) { const int kb = r / 88, nb = r % 88; const float* W = a.w_in + (size_t)l * 1024 * DIN;
            transpose_item([&](int k, int n) { return W[(size_t)k * DIN + (n < 512 ? n : n + 8)]; }, (bf16_t*)(a.ws + WS_WIN) + (size_t)l * LDU * 1024, 1024, kb * 64, nb * 32, scr, lane); continue; }
        r -= I_IN;
        if (r < I_OUT) { const int kb = r / 32, nb = r % 32; const float* W = a.w_out + (size_t)l * 1024 * 1024;
            transpose_item([&](int k, int n) { return W[(size_t)k * 1024 + n]; }, (bf16_t*)(a.ws + WS_WOUT) + (size_t)l * 1024 * 1024, 1024, kb * 64, nb * 32, scr, lane); continue; }
        r -= I_OUT;
        if (r < I_GU) { const int e = r / 512, rr = r % 512, kb = rr / 32, nb = rr % 32;
            const float* Wg = a.w_gate_e + ((size_t)l * 16 + e) * 1024 * 512; const float* Wu = a.w_up_e + ((size_t)l * 16 + e) * 1024 * 512;
            transpose_item([&](int k, int n) { return (n & 1) ? Wu[(size_t)k * 512 + (n >> 1)] : Wg[(size_t)k * 512 + (n >> 1)]; }, (bf16_t*)(a.ws + WS_WGU) + ((size_t)l * 16 + e) * 1024 * 1024, 1024, kb * 64, nb * 32, scr, lane); continue; }
        r -= I_GU;
        { const int e = r / 256, rr = r % 256, kb = rr / 32, nb = rr % 32; const float* W = a.w_down_e + ((size_t)l * 16 + e) * 512 * 1024;
            transpose_item([&](int k, int n) { return W[(size_t)k * 1024 + n]; }, (bf16_t*)(a.ws + WS_WD) + ((size_t)l * 16 + e) * 1024 * 512, 512, kb * 64, nb * 32, scr, lane); }
    }
}

template <int HALF, int OFF, int N> __device__ __forceinline__ void reduce_tr_step(float (&v)[N], int lane) {
    const bool up = (lane & OFF) != 0;
#pragma unroll
    for (int i = 0; i < HALF; ++i) { const float snd = up ? v[i] : v[i + HALF], kep = up ? v[i + HALF] : v[i]; v[i] = kep + bperm_f(snd, lane ^ OFF); }
}
template <int N> __device__ __forceinline__ float reduce_tr(float (&v)[N], int lane);
template <> __device__ __forceinline__ float reduce_tr<16>(float (&v)[16], int lane) {
    reduce_tr_step<8, 32>(v, lane); reduce_tr_step<4, 16>(v, lane); reduce_tr_step<2, 8>(v, lane); reduce_tr_step<1, 4>(v, lane);
    float r = v[0]; r += bperm_f(r, lane ^ 2); r += bperm_f(r, lane ^ 1); return r; }
template <> __device__ __forceinline__ float reduce_tr<8>(float (&v)[8], int lane) {
    reduce_tr_step<4, 32>(v, lane); reduce_tr_step<2, 16>(v, lane); reduce_tr_step<1, 8>(v, lane);
    float r = v[0]; r += bperm_f(r, lane ^ 4); r += bperm_f(r, lane ^ 2); r += bperm_f(r, lane ^ 1); return r; }
template <int MODE>
__device__ __forceinline__ void phase_norm(const Args& a, int l, const float* xin, LAS unsigned char* lds, int gw, int ngw, int wave_) {
    const int lane = lane_id_opaque(), tid = wave_ * 64 + lane;
    constexpr int NC = (MODE == 1) ? 8 : 16;
    LAS float* wl = (LAS float*)lds;
    LAS int* hist = (LAS int*)(lds + 65536); LAS int* basek = hist + 32; LAS int* rowinfo = hist + 64;
    const int lc = l; l &= 1;
    const float* modl = (const float*)(a.ws + WS_MOD) + (size_t)l * 8 * NMOD;
    const int shift_off = (MODE == 1) ? 0 : 3072, scale_off = (MODE == 1) ? 1024 : 4096;
    if (MODE == 1) { const float* W = a.w_in + (size_t)l * 1024 * DIN + 512; for (int i = tid; i < 1024 * 8; i += NWAVES * 64) wl[(i & 7) * 1024 + (i >> 3)] = W[(size_t)(i >> 3) * DIN + (i & 7)]; }
    else { for (int i = tid; i < 1024 * 16; i += NWAVES * 64) wl[(i & 15) * 1024 + (i >> 4)] = a.w_router[i]; if (tid < 32) hist[tid] = 0; }
    __syncthreads();
    bf16_t* H = (bf16_t*)(a.ws + WS_H);
    float* gate = (float*)(a.ws + WS_GATE); float* rw = (float*)(a.ws + WS_RW); int* list = (int*)(a.ws + WS_LIST);
    int* cnt = (int*)(a.ws + WS_CTL) + CW_CNT + lc * 32;
    const int rows_per = (T_TOK + ngw - 1) / ngw;
    const int row0 = gw * rows_per;
#pragma unroll 1
    for (int i = 0; i < rows_per; i += 2) {
        const int lane = lane_id_opaque();
        const int t0 = row0 + i; if (t0 >= T_TOK) break;
        constexpr bool has1 = true; const int t1 = t0 + 1;
        const int b = t0 / SEQ;
        const f32x4* xr0 = (const f32x4*)(xin + (size_t)t0 * DM) + lane; const f32x4* xr1 = (const f32x4*)(xin + (size_t)t1 * DM) + lane;
        f32x4 v0[4], v1[4]; float ss0 = 0.f, ss1 = 0.f;
#pragma unroll
        for (int j = 0; j < 4; ++j) { v0[j] = xr0[64 * j]; v1[j] = xr1[64 * j]; }
#pragma unroll
        for (int j = 0; j < 4; ++j) { ss0 += (v0[j][0] * v0[j][0] + v0[j][1] * v0[j][1]) + (v0[j][2] * v0[j][2] + v0[j][3] * v0[j][3]); ss1 += (v1[j][0] * v1[j][0] + v1[j][1] * v1[j][1]) + (v1[j][2] * v1[j][2] + v1[j][3] * v1[j][3]); }
#pragma unroll
        for (int o = 32; o > 0; o >>= 1) { ss0 += bperm_f(ss0, lane ^ o); ss1 += bperm_f(ss1, lane ^ o); }
        const float rs0 = rsqrtf(ss0 * (1.f / 1024.f) + EPS), rs1 = rsqrtf(ss1 * (1.f / 1024.f) + EPS);
        float lg0[NC], lg1[NC];
#pragma unroll
        for (int e = 0; e < NC; ++e) { lg0[e] = 0.f; lg1[e] = 0.f; }
#pragma unroll
        for (int j = 0; j < 4; ++j) {
            const int k0 = 4 * lane + 256 * j;
            const f32x4 sc = *(const f32x4*)(modl + (size_t)b * NMOD + scale_off + k0), sh = *(const f32x4*)(modl + (size_t)b * NMOD + shift_off + k0);
            f32x4 h0, h1;
#pragma unroll
            for (int q = 0; q < 4; ++q) { h0[q] = v0[j][q] * rs0 * (1.f + sc[q]) + sh[q]; h1[q] = v1[j][q] * rs1 * (1.f + sc[q]) + sh[q]; }
            u32x2 o0; o0.x = pk2(h0[0], h0[1]); o0.y = pk2(h0[2], h0[3]); *(u32x2*)(H + (size_t)t0 * DM + k0) = o0;
            if (has1) { u32x2 o1; o1.x = pk2(h1[0], h1[1]); o1.y = pk2(h1[2], h1[3]); *(u32x2*)(H + (size_t)t1 * DM + k0) = o1; }
#pragma unroll
            for (int e8 = 0; e8 < NC; e8 += 8) {
#pragma unroll
                for (int e = e8; e < e8 + 8; ++e) { const f32x4 w = *(const LAS f32x4*)(wl + e * 1024 + k0);
                    lg0[e] += (h0[0] * w[0] + h0[1] * w[1]) + (h0[2] * w[2] + h0[3] * w[3]); lg1[e] += (h1[0] * w[0] + h1[1] * w[1]) + (h1[2] * w[2] + h1[3] * w[3]); }
                __builtin_amdgcn_sched_barrier(0);
            }
        }
        const float r0 = reduce_tr<NC>(lg0, lane), r1 = reduce_tr<NC>(lg1, lane);
        if (MODE == 1) {
            if ((lane & 7) == 0) { gate[(size_t)t0 * 8 + (lane >> 3)] = r0; if (has1) gate[(size_t)t1 * 8 + (lane >> 3)] = r1; }
        } else {
#pragma unroll
            for (int rr = 0; rr < 2; ++rr) {
                if (rr == 1 && !has1) break;
                const float rv = rr ? r1 : r0; const int t = rr ? t1 : t0;
                float sc[16], bs[16];
#pragma unroll
                for (int e = 0; e < 16; ++e) { const float lgt = __int_as_float(__builtin_amdgcn_readlane(__float_as_int(rv), 4 * e)); sc[e] = sigmoidf_(lgt); bs[e] = sc[e] + a.router_bias[e]; }
                float best_gs = -1e30f; int bk = 0; float bw0 = 0.f, bw1 = 0.f;
#pragma unroll
                for (int g = 0; g < 4; ++g) {
                    int i0 = 0; float q0 = bs[4 * g]; float s0 = sc[4 * g];
#pragma unroll
                    for (int j = 1; j < 4; ++j) if (bs[4 * g + j] > q0) { q0 = bs[4 * g + j]; i0 = j; s0 = sc[4 * g + j]; }
                    int i1 = -1; float q1 = -1e30f; float s1 = 0.f;
#pragma unroll
                    for (int j = 0; j < 4; ++j) if (j != i0 && bs[4 * g + j] > q1) { q1 = bs[4 * g + j]; i1 = j; s1 = sc[4 * g + j]; }
                    const float gs = q0 + q1;
                    if (gs > best_gs) { best_gs = gs;
                        const int lo = i0 < i1 ? i0 : i1, hi = i0 < i1 ? i1 : i0; const float wlo = i0 < i1 ? s0 : s1, whi = i0 < i1 ? s1 : s0;
                        const int pq = (lo == 0) ? (hi - 1) : (lo == 1 ? hi + 1 : 5);
                        bk = 6 * g + pq; bw0 = wlo; bw1 = whi; }
                }
                if (lane == 0) {
                    const float inv = 1.f / (bw0 + bw1);
                    *(f32x2*)(rw + (size_t)t * 2) = (f32x2){bw0 * inv, bw1 * inv};
                    const int pos = __hip_atomic_fetch_add(&hist[bk], 1, __ATOMIC_RELAXED, __HIP_MEMORY_SCOPE_WORKGROUP);
                    rowinfo[t - (int)blockIdx.x * (NWAVES * rows_per)] = bk | (pos << 8);
                }
            }
        }
    }
    if (MODE == 2) {
        __syncthreads();
        if (tid < NBUCK) { const int n = hist[tid]; basek[tid] = n ? atomicAdd(&cnt[tid], n) : 0; }
        __syncthreads();
        const int nrows = NWAVES * rows_per, brow0 = (int)blockIdx.x * nrows;
        for (int i = tid; i < nrows; i += NWAVES * 64) { const int t = brow0 + i; if (t < T_TOK) { const int ri = rowinfo[i]; const int k = ri & 255; list[(size_t)k * T_TOK + basek[k] + (ri >> 8)] = t; } }
    }
}

__device__ __forceinline__ void build_moe_tab(const Args& a, int l, LAS int* tab, int wave_) {
    const int tid = wave_ * 64 + lane_id_opaque();
    const int* cnt = (const int*)(a.ws + WS_CTL) + CW_CNT + l * 32;
    if (tid < 32) tab[tid] = (tid < NBUCK) ? cnt[tid] : 0;
    __syncthreads();
    if (tid < NBUCK) {
        int base = 0;
#pragma unroll 1
        for (int j = 0; j < tid; ++j) base += (tab[j] + 255) >> 8;
        const int mine = (tab[tid] + 255) >> 8;
#pragma unroll 1
        for (int i = 0; i < mine; ++i) { tab[32 + base + i] = tid; tab[192 + base + i] = i * 256; }
        if (tid == NBUCK - 1) tab[352] = base + mine;
    }
    __syncthreads();
}

__device__ __forceinline__ void phase_final(const Args& a, int gw, int ngw) {
    const int lane = lane_id_opaque();
    for (int t = gw; t < T_TOK; t += ngw) {
        f32x4* xr = (f32x4*)(a.out + (size_t)t * DM) + lane; f32x4 v[4]; float ss = 0.f;
#pragma unroll
        for (int j = 0; j < 4; ++j) { v[j] = xr[64 * j]; ss += (v[j][0] * v[j][0] + v[j][1] * v[j][1]) + (v[j][2] * v[j][2] + v[j][3] * v[j][3]); }
        ss = wave_sum_l(ss, lane);
        const float rstd = rsqrtf(ss * (1.f / 1024.f) + EPS);
#pragma unroll
        for (int j = 0; j < 4; ++j) { const f32x4 g = *((const f32x4*)a.g_final + lane + 64 * j); xr[64 * j] = v[j] * rstd * g; }
    }
}


typedef float f32x16 __attribute__((ext_vector_type(16)));
typedef short s16x4 __attribute__((ext_vector_type(4)));
typedef short v4i16_t __attribute__((ext_vector_type(4)));
#define MFMA32(a, b, c) __builtin_amdgcn_mfma_f32_32x32x16_bf16((a), (b), (c), 0, 0, 0)
__device__ __forceinline__ int crow(int i, int h) { return (i & 3) + 8 * (i >> 2) + 4 * h; }
__device__ __forceinline__ unsigned cvtpk(float lo, float hi) { typedef float f2_t __attribute__((ext_vector_type(2))); typedef __bf16 b2_t __attribute__((ext_vector_type(2)));
    f2_t v = {lo, hi}; b2_t b = __builtin_convertvector(v, b2_t); return __builtin_bit_cast(unsigned, b); }
__device__ __forceinline__ bf16x8 pack8(const f32x16& x, int s) { u32x4 p; p.x = cvtpk(x[8 * s], x[8 * s + 1]); p.y = cvtpk(x[8 * s + 2], x[8 * s + 3]); p.z = cvtpk(x[8 * s + 4], x[8 * s + 5]); p.w = cvtpk(x[8 * s + 6], x[8 * s + 7]); return __builtin_bit_cast(bf16x8, p); }
__device__ __forceinline__ void halves(float v, float& v0, float& v1) { auto rr = __builtin_amdgcn_permlane32_swap(__float_as_uint(v), __float_as_uint(v), false, false); v0 = __uint_as_float(rr[0]); v1 = __uint_as_float(rr[1]); }
__device__ __forceinline__ s16x4 vtr(const LAS unsigned char* p) { return __builtin_bit_cast(s16x4, __builtin_amdgcn_ds_read_tr16_b64_v4i16((LAS v4i16_t*)p)); }
__device__ __forceinline__ bf16x8 vt_frag(const LAS unsigned char* vl, int vtr0, int s, int db) {
    const s16x4 lo = vtr(vl + vtr0 + s * 2048 + db * 64), hi = vtr(vl + vtr0 + s * 2048 + 1024 + db * 64);
    return __builtin_shufflevector(lo, hi, 0, 1, 2, 3, 4, 5, 6, 7); }

#define KT_WRITE(KL, KV) do { _Pragma("unroll") for (int i = 0; i < 4; ++i) *(LAS u32x4*)((KL) + (vrow + 8 * i) * 144 + vseg * 16) = KV[i]; } while (0)
#define KT_FRAG(KL, D0) (*(const LAS bf16x8*)((KL) + r * 144 + 32 * (D0) + 16 * hh))
#ifndef SB_EARLY_EXIT
#define SB_EARLY_EXIT 1
#endif
__device__ __forceinline__ void sb_item(const bf16_t* U, const float* gh  , bf16_t* Y, LAS unsigned char* vl, int b, int h, int qt, int lane) {
    const int r = lane & 31, hh = lane >> 5;
    const size_t rowb = (size_t)b * SEQ;
    const bf16_t* Qp = U + (rowb + 32 * qt + r) * LDU + OFF_SB + h * 64 + 8 * hh;
    bf16x8 qf[4];
#pragma unroll
    for (int d0 = 0; d0 < 4; ++d0) qf[d0] = *(const bf16x8*)(Qp + 16 * d0);
    f32x16 o0, o1;
#pragma unroll
    for (int i = 0; i < 16; ++i) { o0[i] = 0.f; o1[i] = 0.f; }
    float carry = 1.f;
    const bf16_t* Kb = U + rowb * LDU + OFF_SB + 384 + h * 64; const bf16_t* Vb = Kb + 384;
    const int vrow = lane >> 3, vseg = lane & 7;
    const int i16 = lane & 15, q4 = i16 >> 2, p4 = i16 & 3, blk = (lane >> 4) & 1;
    const int vtr0 = (4 * hh + q4) * 128 + (16 * blk + 4 * p4) * 2;
#define SB_LOAD(KT, KF, VV) do { \
        _Pragma("unroll") for (int i = 0; i < 4; ++i) { KF[i] = *(const u32x4*)(Kb + (size_t)(32 * (KT) + vrow + 8 * i) * LDU + 8 * vseg); VV[i] = *(const u32x4*)(Vb + (size_t)(32 * (KT) + vrow + 8 * i) * LDU + 8 * vseg); } } while (0)
#define SB_TILE(KT, KF, VV) do { \
        KT_WRITE(kl, KF); \
        _Pragma("unroll") for (int i = 0; i < 4; ++i) *(LAS u32x4*)(vl + (vrow + 8 * i) * 128 + vseg * 16) = VV[i]; \
        f32x16 sc; \
        _Pragma("unroll") for (int i = 0; i < 16; ++i) sc[i] = 0.f; \
        _Pragma("unroll") for (int d0 = 0; d0 < 4; ++d0) sc = MFMA32(KT_FRAG(kl, d0), qf[d0], sc); \
        float sg[16], kp[16]; \
        _Pragma("unroll") for (int i = 0; i < 16; ++i) { \
            const float z = fmaxf(sc[i] * 0.125f, -80.f); \
            const float e = __expf(-z); float sig = __builtin_amdgcn_rcpf(1.f + e); float keep = e * sig; \
            if ((KT) == qt) { const bool valid = crow(i, hh) < r; sig = valid ? sig : 0.f; keep = valid ? keep : 1.f; } \
            sg[i] = sig; kp[i] = keep; } \
        float G0[4], G1[4], PP[4]; \
        _Pragma("unroll") for (int g = 0; g < 4; ++g) { const float G = (kp[4 * g] * kp[4 * g + 1]) * (kp[4 * g + 2] * kp[4 * g + 3]); halves(G, G0[g], G1[g]); PP[g] = G0[g] * G1[g]; } \
        float SP[4]; SP[3] = 1.f; SP[2] = PP[3]; SP[1] = PP[3] * PP[2]; SP[0] = SP[1] * PP[1]; \
        const float total = SP[0] * PP[0]; \
        _Pragma("unroll") for (int g = 0; g < 4; ++g) { \
            const float r3 = carry * SP[g] * (hh ? 1.f : G1[g]); \
            const float r2 = r3 * kp[4 * g + 3], r1 = r2 * kp[4 * g + 2], r0 = r1 * kp[4 * g + 1]; \
            sc[4 * g + 3] = sg[4 * g + 3] * r3; sc[4 * g + 2] = sg[4 * g + 2] * r2; sc[4 * g + 1] = sg[4 * g + 1] * r1; sc[4 * g] = sg[4 * g] * r0; } \
        carry *= total; \
        const bf16x8 pb0 = pack8(sc, 0), pb1 = pack8(sc, 1); \
        o0 = MFMA32(vt_frag(vl, vtr0, 0, 0), pb0, o0); o0 = MFMA32(vt_frag(vl, vtr0, 1, 0), pb1, o0); \
        o1 = MFMA32(vt_frag(vl, vtr0, 0, 1), pb0, o1); o1 = MFMA32(vt_frag(vl, vtr0, 1, 1), pb1, o1); } while (0)
#define SB_DONE() (SB_EARLY_EXIT && __builtin_amdgcn_ballot_w64(carry >= 1e-37f) == 0ull)
    {
        u32x4 kA[4], kB[4], vA[4], vB[4];
        LAS unsigned char* kl = vl + 4096;
        int kt = qt;
        SB_LOAD(kt, kA, vA);
#pragma unroll 1
        for (;;) {
            if (kt > 0) SB_LOAD(kt - 1, kB, vB);
            SB_TILE(kt, kA, vA);
            if (kt == 0 || SB_DONE()) break;
            --kt;
            if (kt > 0) SB_LOAD(kt - 1, kA, vA);
            SB_TILE(kt, kB, vB);
            if (kt == 0 || SB_DONE()) break;
            --kt;
        }
    }
#undef SB_LOAD
#undef SB_TILE
#undef SB_DONE
    float ss = 0.f;
#pragma unroll
    for (int i = 0; i < 16; ++i) ss += o0[i] * o0[i] + o1[i] * o1[i];
    float s0, s1; halves(ss, s0, s1);
    const float rs = rsqrtf((s0 + s1) * (1.f / 64.f) + EPS);
    bf16_t* yr = Y + (rowb + 32 * qt + r) * 1024 + (10 + h) * 64;
#pragma unroll
    for (int g = 0; g < 4; ++g) {
        const int d0 = 8 * g + 4 * hh;
        const f32x4 ga = *(const f32x4*)(gh + d0), gb = *(const f32x4*)(gh + 32 + d0);
        u32x2 wa, wb; wa.x = cvtpk(o0[4 * g] * rs * ga[0], o0[4 * g + 1] * rs * ga[1]); wa.y = cvtpk(o0[4 * g + 2] * rs * ga[2], o0[4 * g + 3] * rs * ga[3]);
        wb.x = cvtpk(o1[4 * g] * rs * gb[0], o1[4 * g + 1] * rs * gb[1]); wb.y = cvtpk(o1[4 * g + 2] * rs * gb[2], o1[4 * g + 3] * rs * gb[3]);
        *(u32x2*)(yr + d0) = wa; *(u32x2*)(yr + 32 + d0) = wb;
    }
}
__device__ __forceinline__ void phase_sb(const Args& a, int l, LAS unsigned char* lds, int gw, int ngw, int wave_) {
    const int lane = lane_id_opaque();
    LAS unsigned char* vl = lds + wave_ * 16384;
    const bf16_t* U = (const bf16_t*)(a.ws + WS_U); bf16_t* Y = (bf16_t*)(a.ws + WS_Y);
    for (int it = gw; it < NB * 6 * 128; it += ngw) {
        const int qt = 127 - (it % 128), h = (it / 128) % 6, b = it / 768;
        sb_item(U, a.g_head + l * 1024 + (10 + h) * 64, Y, vl, b, h, qt, lane);
    }
}


__device__ __forceinline__ void dil_item(const bf16_t* U, bf16_t* OP, float* LSE, LAS unsigned char* vl, int b, int h, int p, int qi, int lane) {
    const int r = lane & 31, hh = lane >> 5;
    const int sh = 2 * p, d = 1 << sh, nblk = (SEQ >> sh) / 32, c = qi / nblk, m0 = 32 * (qi % nblk);
    const size_t rowb = (size_t)b * SEQ;
    const int tq = ((m0 + r) << sh) + c;
    const bf16_t* Qp = U + (rowb + tq) * LDU + OFF_DIL + h * 64 + 8 * hh;
    bf16x8 qf[4];
#pragma unroll
    for (int d0 = 0; d0 < 4; ++d0) qf[d0] = *(const bf16x8*)(Qp + 16 * d0);
    const float sb = exp2f(-8.f * (float)(h + 1) / 6.f) * (float)d;
    f32x16 o0, o1;
#pragma unroll
    for (int i = 0; i < 16; ++i) { o0[i] = 0.f; o1[i] = 0.f; }
    float m_run = -1e30f, l_run = 0.f;
    const bf16_t* Kb = U + rowb * LDU + OFF_DIL + 384 + h * 64; const bf16_t* Vb = Kb + 384;
    const int vrow = lane >> 3, vseg = lane & 7;
    const int i16 = lane & 15, q4 = i16 >> 2, p4 = i16 & 3, blk = (lane >> 4) & 1;
    const int vtr0 = (4 * hh + q4) * 128 + (16 * blk + 4 * p4) * 2;
#define DL_LOAD(J, KF, VV) do { const int mk0_ = m0 - 128 + 32 * (J); \
        _Pragma("unroll") for (int i = 0; i < 4; ++i) { const size_t ro_ = (size_t)(((mk0_ + vrow + 8 * i) << sh) + c) * LDU + 8 * vseg; KF[i] = *(const u32x4*)(Kb + ro_); VV[i] = *(const u32x4*)(Vb + ro_); } } while (0)
#define DL_TILE(J, KF, VV) do { \
        KT_WRITE(kl, KF); \
        _Pragma("unroll") for (int i = 0; i < 4; ++i) *(LAS u32x4*)(vl + (vrow + 8 * i) * 128 + vseg * 16) = VV[i]; \
        f32x16 sc; \
        _Pragma("unroll") for (int i = 0; i < 16; ++i) sc[i] = 0.f; \
        _Pragma("unroll") for (int d0 = 0; d0 < 4; ++d0) sc = MFMA32(KT_FRAG(kl, d0), qf[d0], sc); \
        float mx = -1e30f; \
        const float base2 = -sb * (float)(r + 128 - 32 * (J) - 4 * hh); \
        _Pragma("unroll") for (int i = 0; i < 16; ++i) { \
            const int cr = crow(i, hh); \
            float v = fmaf(sb, (float)((i & 3) + 8 * (i >> 2)), fmaf(sc[i], 0.125f, base2)); \
            const bool valid = ((J) == 4) ? (cr <= r) : (((J) == 0) ? (cr >= r) : true); \
            v = valid ? v : -1e30f; \
            sc[i] = v; mx = fmaxf(mx, v); } \
        float mx0, mx1; halves(mx, mx0, mx1); \
        const float m_new = fmaxf(m_run, fmaxf(mx0, mx1)); \
        const float corr = __expf(m_run - m_new); \
        float ps = 0.f; \
        _Pragma("unroll") for (int i = 0; i < 16; ++i) { const float pe = __expf(sc[i] - m_new); sc[i] = pe; ps += pe; } \
        float ps0, ps1; halves(ps, ps0, ps1); \
        l_run = l_run * corr + (ps0 + ps1); \
        m_run = m_new; \
        _Pragma("unroll") for (int i = 0; i < 16; ++i) { o0[i] *= corr; o1[i] *= corr; } \
        const bf16x8 pb0 = pack8(sc, 0), pb1 = pack8(sc, 1); \
        o0 = MFMA32(vt_frag(vl, vtr0, 0, 0), pb0, o0); o0 = MFMA32(vt_frag(vl, vtr0, 1, 0), pb1, o0); \
        o1 = MFMA32(vt_frag(vl, vtr0, 0, 1), pb0, o1); o1 = MFMA32(vt_frag(vl, vtr0, 1, 1), pb1, o1); } while (0)
    {
        const int jmin = (m0 >= 128) ? 0 : (4 - m0 / 32);
        u32x4 kA[4], kB[4], vA[4], vB[4];
        LAS unsigned char* kl = vl + 4096;
        int j = 4;
        DL_LOAD(j, kA, vA);
#pragma unroll 1
        for (;;) {
            if (j > jmin) DL_LOAD(j - 1, kB, vB);
            DL_TILE(j, kA, vA);
            if (j == jmin) break;
            --j;
            if (j > jmin) DL_LOAD(j - 1, kA, vA);
            DL_TILE(j, kB, vB);
            if (j == jmin) break;
            --j;
        }
    }
#undef DL_LOAD
#undef DL_TILE
    const float inv = 1.f / l_run;
    bf16_t* orow = OP + (rowb + tq) * 384 + h * 64;
#pragma unroll
    for (int g = 0; g < 4; ++g) {
        const int d0 = 8 * g + 4 * hh;
        u32x2 wa, wb; wa.x = cvtpk(o0[4 * g] * inv, o0[4 * g + 1] * inv); wa.y = cvtpk(o0[4 * g + 2] * inv, o0[4 * g + 3] * inv);
        wb.x = cvtpk(o1[4 * g] * inv, o1[4 * g + 1] * inv); wb.y = cvtpk(o1[4 * g + 2] * inv, o1[4 * g + 3] * inv);
        *(u32x2*)(orow + d0) = wa; *(u32x2*)(orow + 32 + d0) = wb;
    }
    if (hh == 0) LSE[(rowb + tq) * 6 + h] = m_run + __logf(l_run);
}
__device__ __forceinline__ bf16_t* dil_op(unsigned char* ws, int p) { return (p < 2) ? (bf16_t*)(ws + WS_OP01) + (size_t)p * T_TOK * 384 : (bf16_t*)(ws + WS_OP2); }
__device__ __forceinline__ void phase_dil(const Args& a, int l, LAS unsigned char* lds, int gw, int ngw, int wave_) {
    const int lane = lane_id_opaque();
    LAS unsigned char* vl = lds + wave_ * 16384;
    const bf16_t* U = (const bf16_t*)(a.ws + WS_U);
    for (int it = gw; it < 3 * NB * 6 * 128; it += ngw) {
        const int qi = it % 128, h = (it / 128) % 6, b = (it / 768) % NB, p = it / (768 * NB);
        dil_item(U, dil_op(a.ws, p), (float*)(a.ws + WS_LSE) + (size_t)p * T_TOK * 6, vl, b, h, p, qi, lane);
    }
}
__device__ __forceinline__ void phase_dil_merge(const Args& a, int l, int gw, int ngw) {
    const int lane = lane_id_opaque(); const int pr = lane >> 3, ch = lane & 7;
    const bf16_t* O0 = dil_op(a.ws, 0); const bf16_t* O1 = dil_op(a.ws, 1); const bf16_t* O2 = dil_op(a.ws, 2);
    const float* L0 = (const float*)(a.ws + WS_LSE); const float* L1 = L0 + (size_t)T_TOK * 6; const float* L2 = L1 + (size_t)T_TOK * 6;
    bf16_t* Y = (bf16_t*)(a.ws + WS_Y);
    for (int it = gw; it < T_TOK * 6 / 8; it += ngw) {
        const int pi = it * 8 + pr; const int t = pi / 6, hd = pi - 6 * t;
        const float l0 = L0[pi], l1 = L1[pi], l2 = L2[pi];
        const size_t o = (size_t)t * 384 + hd * 64 + ch * 8;
        const u32x4 a0 = *(const u32x4*)(O0 + o), a1 = *(const u32x4*)(O1 + o), a2 = *(const u32x4*)(O2 + o);
        const float mx = fmaxf(l0, fmaxf(l1, l2));
        float w0 = __expf(l0 - mx), w1 = __expf(l1 - mx), w2 = __expf(l2 - mx); const float inv = 1.f / (w0 + w1 + w2); w0 *= inv; w1 *= inv; w2 *= inv;
        float v[8]; float ss = 0.f;
#pragma unroll
        for (int q = 0; q < 4; ++q) {
            v[2 * q]     = w0 * __uint_as_float(a0[q] << 16) + w1 * __uint_as_float(a1[q] << 16) + w2 * __uint_as_float(a2[q] << 16);
            v[2 * q + 1] = w0 * __uint_as_float(a0[q] & 0xffff0000u) + w1 * __uint_as_float(a1[q] & 0xffff0000u) + w2 * __uint_as_float(a2[q] & 0xffff0000u);
            ss += v[2 * q] * v[2 * q] + v[2 * q + 1] * v[2 * q + 1];
        }
#pragma unroll
        for (int of = 1; of < 8; of <<= 1) ss += bperm_f(ss, lane ^ of);
        const float rs = rsqrtf(ss * (1.f / 64.f) + EPS);
        const float* gh = a.g_head + l * 1024 + (4 + hd) * 64 + ch * 8;
        const f32x4 ga = *(const f32x4*)gh, gb = *(const f32x4*)(gh + 4);
        u32x4 w; w.x = cvtpk(v[0] * rs * ga[0], v[1] * rs * ga[1]); w.y = cvtpk(v[2] * rs * ga[2], v[3] * rs * ga[3]); w.z = cvtpk(v[4] * rs * gb[0], v[5] * rs * gb[1]); w.w = cvtpk(v[6] * rs * gb[2], v[7] * rs * gb[3]);
        *(u32x4*)(Y + (size_t)t * 1024 + (4 + hd) * 64 + ch * 8) = w;
    }
}

__device__ __forceinline__ float scan_add64(float v, int lane) {
#pragma unroll
    for (int o = 1; o < 64; o <<= 1) { const float t = bperm_f(v, lane - o); v = (lane >= o) ? v + t : v; }
    return v; }
__device__ __forceinline__ float scan_max64(float v, int lane) {
#pragma unroll
    for (int o = 1; o < 64; o <<= 1) { const float t = bperm_f(v, lane - o); v = (lane >= o) ? fmaxf(v, t) : v; }
    return v; }
__device__ __forceinline__ float bcast63(float v) { return __int_as_float(__builtin_amdgcn_readlane(__float_as_int(v), 63)); }

__device__ __forceinline__ void ml_b1_item(const Args& a, int l, LAS unsigned char* wl  , int b, int h, int c) {
    const int bh = b * 4 + h;
    const size_t rowb = (size_t)b * SEQ + 128 * c;
    unsigned char* mls = a.ws + WS_MLS;
    LAS float* cw = (LAS float*)(wl + 8192);
    float w0, w1;
    const bf16_t* U = (const bf16_t*)(a.ws + WS_U);
    bf16_t* Qm = (bf16_t*)(a.ws + WS_QKV); bf16_t* Km = Qm + (size_t)T_TOK * 256; bf16_t* Vm = Km + (size_t)T_TOK * 256;
    { const int lane = lane_id_opaque();
    const float* GATE = (const float*)(a.ws + WS_GATE);
    const float gbi = a.gate_bias[l * 8 + h], gbf = a.gate_bias[l * 8 + 4 + h];
    const size_t t0 = rowb + lane, t1 = t0 + 64;
    const float ig0 = GATE[t0 * 8 + h] + gbi, ig1 = GATE[t1 * 8 + h] + gbi;
    const float lf0 = -softplusf_(-(GATE[t0 * 8 + 4 + h] + gbf)), lf1 = -softplusf_(-(GATE[t1 * 8 + 4 + h] + gbf));
    const float c0 = scan_add64(lf0, lane); const float c1 = scan_add64(lf1, lane) + bcast63(c0);
    const float a0 = ig0 - c0, a1 = ig1 - c1;
    const float p0 = scan_max64(a0, lane); const float p1 = fmaxf(scan_max64(a1, lane), bcast63(p0));
    const float Amax = bcast63(p1), Lsum = bcast63(c1);
    ((float*)(mls + MLS_CUM))[t0 * 4 + h] = c0; ((float*)(mls + MLS_CUM))[t1 * 4 + h] = c1;
    ((float*)(mls + MLS_AA))[t0 * 4 + h] = a0;  ((float*)(mls + MLS_AA))[t1 * 4 + h] = a1;
    ((float*)(mls + MLS_PM))[t0 * 4 + h] = p0;  ((float*)(mls + MLS_PM))[t1 * 4 + h] = p1;
    if (lane == 0) { ((float*)(mls + MLS_AMAX))[bh * 32 + c] = Amax; ((float*)(mls + MLS_LSUM))[bh * 32 + c] = Lsum; }
    w0 = __expf(a0 - Amax); w1 = __expf(a1 - Amax);
#pragma unroll
    for (int j = 0; j < 4; ++j) cw[j * 64 + lane] = a.conv_w[(l * 4 + j) * 256 + h * 64 + lane];
    cw[256 + lane] = a.conv_b[l * 256 + h * 64 + lane];
    }
    const bf16_t* WT = (const bf16_t*)(mls + MLS_WT) + (size_t)(l * 3 * 4 + h) * 4096;
    LAS unsigned char* vt = wl; LAS unsigned char* kt = wl + 4096;
    f32x16 acc[2][2], nacc[2];
#pragma unroll
    for (int i = 0; i < 16; ++i) { acc[0][0][i] = 0.f; acc[0][1][i] = 0.f; acc[1][0][i] = 0.f; acc[1][1][i] = 0.f; nacc[0][i] = 0.f; nacc[1][i] = 0.f; }
    bf16x8 ones;
#pragma unroll
    for (int j = 0; j < 8; ++j) ones[j] = (short)0x3F80;
#pragma unroll 1
    for (int st = 0; st < 4; ++st) {
        const int lane = lane_id_opaque(); const int r = lane & 31, hh = lane >> 5;
        const int i16 = lane & 15, q4 = i16 >> 2, p4 = i16 & 3, blk = (lane >> 4) & 1;
        const int vtr0 = (4 * hh + q4) * 128 + (16 * blk + 4 * p4) * 2;
        const size_t row = rowb + 32 * st + r; const int tt = 128 * c + 32 * st + r;
        const float wt = bperm_f((st < 2) ? w0 : w1, 32 * (st & 1) + r);
        bf16x8 xcf[4], xmf[4];
#pragma unroll
        for (int d0 = 0; d0 < 4; ++d0) {
            const int ch = 16 * d0 + 8 * hh;
            bf16x8 x[4];
#pragma unroll
            for (int j = 0; j < 4; ++j) { const bool ok = (tt - 3 + j >= 0); const bf16x8 ld = *(const bf16x8*)(U + (ok ? row - 3 + j : row) * LDU + OFF_ML_X + h * 64 + ch);
                const u32x4 lu = __builtin_bit_cast(u32x4, ld); u32x4 z; z.x = ok ? lu.x : 0u; z.y = ok ? lu.y : 0u; z.z = ok ? lu.z : 0u; z.w = ok ? lu.w : 0u; x[j] = __builtin_bit_cast(bf16x8, z); }
            xmf[d0] = x[3];
            float xv[8];
            { const f32x4 ba = *(const LAS f32x4*)(cw + 256 + ch), bb = *(const LAS f32x4*)(cw + 256 + ch + 4);
              xv[0] = ba[0]; xv[1] = ba[1]; xv[2] = ba[2]; xv[3] = ba[3]; xv[4] = bb[0]; xv[5] = bb[1]; xv[6] = bb[2]; xv[7] = bb[3]; }
#pragma unroll
            for (int j = 0; j < 4; ++j) { const f32x4 wa = *(const LAS f32x4*)(cw + j * 64 + ch), wb = *(const LAS f32x4*)(cw + j * 64 + ch + 4);
#pragma unroll
                for (int e = 0; e < 4; ++e) { xv[e] += wa[e] * bf2f((bf16_t)x[j][e]); xv[4 + e] += wb[e] * bf2f((bf16_t)x[j][4 + e]); } }
            u32x4 pk;
            pk.x = cvtpk(xv[0] * sigmoidf_(xv[0]), xv[1] * sigmoidf_(xv[1])); pk.y = cvtpk(xv[2] * sigmoidf_(xv[2]), xv[3] * sigmoidf_(xv[3]));
            pk.z = cvtpk(xv[4] * sigmoidf_(xv[4]), xv[5] * sigmoidf_(xv[5])); pk.w = cvtpk(xv[6] * sigmoidf_(xv[6]), xv[7] * sigmoidf_(xv[7]));
            xcf[d0] = __builtin_bit_cast(bf16x8, pk);
            __builtin_amdgcn_sched_barrier(0);
        }
#pragma unroll
        for (int w = 0; w < 3; ++w) {
#pragma unroll
            for (int eb = 0; eb < 2; ++eb) {
                f32x16 pr;
#pragma unroll
                for (int i = 0; i < 16; ++i) pr[i] = 0.f;
#pragma unroll
                for (int d0 = 0; d0 < 4; ++d0) { const bf16x8 wf = *(const bf16x8*)(WT + (size_t)w * 4 * 4096 + (32 * eb + r) * 64 + 16 * d0 + 8 * hh); pr = MFMA32(wf, (w == 2) ? xmf[d0] : xcf[d0], pr); }
                bf16_t* dst = ((w == 0) ? Qm : (w == 1 ? Km : Vm)) + row * 256 + h * 64 + 32 * eb;
#pragma unroll
                for (int g = 0; g < 4; ++g) {
                    const int e0 = 8 * g + 4 * hh;
                    u32x2 o; o.x = cvtpk(pr[4 * g], pr[4 * g + 1]); o.y = cvtpk(pr[4 * g + 2], pr[4 * g + 3]);
                    *(u32x2*)(dst + e0) = o;
                    if (w == 1) { u32x2 k2; k2.x = cvtpk(pr[4 * g] * wt, pr[4 * g + 1] * wt); k2.y = cvtpk(pr[4 * g + 2] * wt, pr[4 * g + 3] * wt); *(LAS u32x2*)(kt + r * 128 + (32 * eb + e0) * 2) = k2; }
                    if (w == 2) *(LAS u32x2*)(vt + r * 128 + (32 * eb + e0) * 2) = o;
                }
                __builtin_amdgcn_sched_barrier(0);
            }
        }
#pragma unroll
        for (int sk = 0; sk < 2; ++sk) {
            const bf16x8 kb0 = vt_frag(kt, vtr0, sk, 0), kb1 = vt_frag(kt, vtr0, sk, 1), va0 = vt_frag(vt, vtr0, sk, 0), va1 = vt_frag(vt, vtr0, sk, 1);
            acc[0][0] = MFMA32(va0, kb0, acc[0][0]); acc[0][1] = MFMA32(va0, kb1, acc[0][1]);
            acc[1][0] = MFMA32(va1, kb0, acc[1][0]); acc[1][1] = MFMA32(va1, kb1, acc[1][1]);
            nacc[0] = MFMA32(ones, kb0, nacc[0]); nacc[1] = MFMA32(ones, kb1, nacc[1]);
        }
    }
    const int lane = lane_id_opaque(); const int r = lane & 31, hh = lane >> 5;
    float* CL = (float*)(a.ws + WS_CLOC) + (size_t)(bh * 32 + c) * 4096;
#pragma unroll
    for (int eb = 0; eb < 2; ++eb)
#pragma unroll
        for (int db = 0; db < 2; ++db)
#pragma unroll
            for (int i = 0; i < 16; ++i) CL[(32 * eb + crow(i, hh)) * 64 + 32 * db + r] = acc[eb][db][i];
    if (hh == 0) { float* NL = (float*)(mls + MLS_NLOC) + (size_t)(bh * 32 + c) * 64; NL[r] = nacc[0][0]; NL[32 + r] = nacc[1][0]; }
}

__device__ __forceinline__ void phase_ml_b2(const Args& a, int gthread, int nthreads) {
    unsigned char* mls = a.ws + WS_MLS;
    const float* AM = (const float*)(mls + MLS_AMAX); const float* LS = (const float*)(mls + MLS_LSUM);
    for (int idx = gthread; idx < 32 * 4096; idx += nthreads) {
        const int bh = idx >> 12, ed = idx & 4095;
        const float* CL = (const float*)(a.ws + WS_CLOC) + (size_t)bh * 32 * 4096 + ed;
        bf16_t* CT = (bf16_t*)(a.ws + WS_CT) + (size_t)bh * 32 * 4096 + ed;
        const bool isn = ed < 64;
        const float* NL = (const float*)(mls + MLS_NLOC) + (size_t)bh * 32 * 64 + (ed & 63);
        float* NCp = (float*)(mls + MLS_NC) + (size_t)bh * 32 * 64 + (ed & 63);
        float C = 0.f, n = 0.f, m = 0.f;
        float cl[32];
#pragma unroll
        for (int c = 0; c < 32; ++c) cl[c] = CL[(size_t)c * 4096];
#pragma unroll
        for (int c = 0; c < 32; ++c) {
            CT[(size_t)c * 4096] = f2bf(C);
            if (isn) NCp[c * 64] = n;
            if (ed == 0) ((float*)(mls + MLS_MC))[bh * 32 + c] = m;
            const float A = AM[bh * 32 + c], L = LS[bh * 32 + c];
            const float M = fmaxf(m, A); const float dec = __expf(m - M), sc = __expf(A - M);
            C = dec * C + sc * cl[c];
            if (isn) n = dec * n + sc * NL[c * 64];
            m = L + M;
        }
    }
}

__device__ __forceinline__ void ml_b3_item(const Args& a, int l, LAS unsigned char* wl, int b, int h, int c, int qt, int lane) {
    const int r = lane & 31, hh = lane >> 5, bh = b * 4 + h;
    const size_t rowc = (size_t)b * SEQ + 128 * c, rowq = rowc + 32 * qt + r;
    unsigned char* mls = a.ws + WS_MLS;
    const bf16_t* Qm = (const bf16_t*)(a.ws + WS_QKV); const bf16_t* Km = Qm + (size_t)T_TOK * 256; const bf16_t* Vm = Km + (size_t)T_TOK * 256;
    LAS float* atab = (LAS float*)(wl + 4096);
    atab[lane] = ((const float*)(mls + MLS_AA))[(rowc + lane) * 4 + h]; atab[64 + lane] = ((const float*)(mls + MLS_AA))[(rowc + 64 + lane) * 4 + h];
    const float cum_t = ((const float*)(mls + MLS_CUM))[rowq * 4 + h], pm_t = ((const float*)(mls + MLS_PM))[rowq * 4 + h];
    const float m_c = ((const float*)(mls + MLS_MC))[bh * 32 + c];
    const float M_t = fmaxf(m_c, pm_t), inter = __expf(m_c - M_t), m_t = cum_t + M_t;
    bf16x8 qf[4];
#pragma unroll
    for (int d0 = 0; d0 < 4; ++d0) qf[d0] = *(const bf16x8*)(Qm + rowq * 256 + h * 64 + 16 * d0 + 8 * hh);
    const bf16_t* CT = (const bf16_t*)(a.ws + WS_CT) + (size_t)(bh * 32 + c) * 4096;
    f32x16 n0, n1;
#pragma unroll
    for (int i = 0; i < 16; ++i) { n0[i] = 0.f; n1[i] = 0.f; }
#pragma unroll
    for (int d0 = 0; d0 < 4; ++d0) { n0 = MFMA32(*(const bf16x8*)(CT + (size_t)r * 64 + 16 * d0 + 8 * hh), qf[d0], n0); n1 = MFMA32(*(const bf16x8*)(CT + (size_t)(32 + r) * 64 + 16 * d0 + 8 * hh), qf[d0], n1); }
    const float* NCp = (const float*)(mls + MLS_NC) + (size_t)(bh * 32 + c) * 64;
    float qn = 0.f;
#pragma unroll
    for (int d0 = 0; d0 < 4; ++d0) { const f32x4 na = *(const f32x4*)(NCp + 16 * d0 + 8 * hh), nb = *(const f32x4*)(NCp + 16 * d0 + 8 * hh + 4);
#pragma unroll
        for (int e = 0; e < 4; ++e) { qn += bf2f((bf16_t)qf[d0][e]) * na[e]; qn += bf2f((bf16_t)qf[d0][4 + e]) * nb[e]; } }
    float qn0, qn1; halves(qn, qn0, qn1); qn = qn0 + qn1;
#pragma unroll
    for (int i = 0; i < 16; ++i) { n0[i] *= inter; n1[i] *= inter; }
    float dsum = 0.f;
    const int vrow = lane >> 3, vseg = lane & 7;
    const int i16 = lane & 15, q4 = i16 >> 2, p4 = i16 & 3, blk = (lane >> 4) & 1;
    const int vtr0 = (4 * hh + q4) * 128 + (16 * blk + 4 * p4) * 2;
    LAS unsigned char* vl = wl;
#define B3_LOAD(KT, KF, VV) do { \
        _Pragma("unroll") for (int i = 0; i < 4; ++i) { const size_t ro_ = (rowc + 32 * (KT) + vrow + 8 * i) * 256 + h * 64 + 8 * vseg; KF[i] = *(const u32x4*)(Km + ro_); VV[i] = *(const u32x4*)(Vm + ro_); } } while (0)
#define B3_TILE(KT, KF, VV) do { \
        KT_WRITE(kl, KF); \
        _Pragma("unroll") for (int i = 0; i < 4; ++i) *(LAS u32x4*)(vl + (vrow + 8 * i) * 128 + vseg * 16) = VV[i]; \
        f32x16 sc; \
        _Pragma("unroll") for (int i = 0; i < 16; ++i) sc[i] = 0.f; \
        _Pragma("unroll") for (int d0 = 0; d0 < 4; ++d0) sc = MFMA32(KT_FRAG(kl, d0), qf[d0], sc); \
        _Pragma("unroll") for (int g = 0; g < 4; ++g) { \
            const f32x4 av = *(const LAS f32x4*)(atab + 32 * (KT) + 8 * g + 4 * hh); \
            _Pragma("unroll") for (int e = 0; e < 4; ++e) { const int i = 4 * g + e; float dm = __expf(av[e] - M_t); if ((KT) == qt && crow(i, hh) > r) dm = 0.f; const float pv = sc[i] * dm; sc[i] = pv; dsum += pv; } } \
        const bf16x8 pb0 = pack8(sc, 0), pb1 = pack8(sc, 1); \
        n0 = MFMA32(vt_frag(vl, vtr0, 0, 0), pb0, n0); n0 = MFMA32(vt_frag(vl, vtr0, 1, 0), pb1, n0); \
        n1 = MFMA32(vt_frag(vl, vtr0, 0, 1), pb0, n1); n1 = MFMA32(vt_frag(vl, vtr0, 1, 1), pb1, n1); } while (0)
    {
        u32x4 kA[4], kB[4], vA[4], vB[4];
        LAS unsigned char* kl = wl + 8192;
        int kt = 0;
        B3_LOAD(kt, kA, vA);
#pragma unroll 1
        for (;;) {
            if (kt < qt) B3_LOAD(kt + 1, kB, vB);
            B3_TILE(kt, kA, vA);
            if (kt == qt) break;
            ++kt;
            if (kt < qt) B3_LOAD(kt + 1, kA, vA);
            B3_TILE(kt, kB, vB);
            if (kt == qt) break;
            ++kt;
        }
    }
#undef B3_LOAD
#undef B3_TILE
    float ds0, ds1; halves(dsum, ds0, ds1);
    const float den = inter * qn + (ds0 + ds1);
    const float hinv = 1.f / fmaxf(fabsf(den), __expf(-m_t));
    const bf16_t* U = (const bf16_t*)(a.ws + WS_U);
    const bf16_t* og = U + rowq * LDU + OFF_ML_O + h * 64;
    float ss = 0.f;
#pragma unroll
    for (int g = 0; g < 4; ++g) {
        const int d0 = 8 * g + 4 * hh;
        const u32x2 ga = *(const u32x2*)(og + d0), gb = *(const u32x2*)(og + 32 + d0);
        const float oa[4] = {__uint_as_float(ga.x << 16), __uint_as_float(ga.x & 0xffff0000u), __uint_as_float(ga.y << 16), __uint_as_float(ga.y & 0xffff0000u)};
        const float ob[4] = {__uint_as_float(gb.x << 16), __uint_as_float(gb.x & 0xffff0000u), __uint_as_float(gb.y << 16), __uint_as_float(gb.y & 0xffff0000u)};
#pragma unroll
        for (int e = 0; e < 4; ++e) { const float va = sigmoidf_(oa[e]) * n0[4 * g + e] * hinv, vb = sigmoidf_(ob[e]) * n1[4 * g + e] * hinv; n0[4 * g + e] = va; n1[4 * g + e] = vb; ss += va * va + vb * vb; }
    }
    float s0, s1; halves(ss, s0, s1);
    const float rs = rsqrtf((s0 + s1) * (1.f / 64.f) + EPS);
    const float* gh = a.g_head + l * 1024 + h * 64;
    bf16_t* yr = (bf16_t*)(a.ws + WS_Y) + rowq * 1024 + h * 64;
#pragma unroll
    for (int g = 0; g < 4; ++g) {
        const int d0 = 8 * g + 4 * hh;
        const f32x4 ga = *(const f32x4*)(gh + d0), gb = *(const f32x4*)(gh + 32 + d0);
        u32x2 wa, wb; wa.x = cvtpk(n0[4 * g] * rs * ga[0], n0[4 * g + 1] * rs * ga[1]); wa.y = cvtpk(n0[4 * g + 2] * rs * ga[2], n0[4 * g + 3] * rs * ga[3]);
        wb.x = cvtpk(n1[4 * g] * rs * gb[0], n1[4 * g + 1] * rs * gb[1]); wb.y = cvtpk(n1[4 * g + 2] * rs * gb[2], n1[4 * g + 3] * rs * gb[3]);
        *(u32x2*)(yr + d0) = wa; *(u32x2*)(yr + 32 + d0) = wb;
    }
}
__device__ __forceinline__ void phase_ml_b1(const Args& a, int l, LAS unsigned char* lds, int gw, int ngw, int wave_) {
    for (int it = gw; it < NB * 4 * 32; it += ngw) ml_b1_item(a, l, lds + wave_ * 16384, it / 128, (it / 32) & 3, it & 31);
}
__device__ __forceinline__ void phase_ml_b3(const Args& a, int l, LAS unsigned char* lds, int gw, int ngw, int wave_) {
    const int lane = lane_id_opaque();
    for (int it = gw; it < NB * 4 * 32 * 4; it += ngw) ml_b3_item(a, l, lds + wave_ * 16384, it / 512, (it / 128) & 3, (it >> 2) & 31, 3 - (it & 3), lane);
}

__device__ __forceinline__ Args load_args() {
#if defined(__HIP_DEVICE_COMPILE__)
    typedef const __attribute__((address_space(4))) Args* KArgs;
    KArgs p_ = (KArgs)__builtin_amdgcn_kernarg_segment_ptr(); asm volatile("" : "+s"(p_)); return *p_;
#else
    return Args{};
#endif
}
#define KA() load_args()
__global__ void __launch_bounds__(NWAVES * 64, 2) fwd(Args a_unused) {
    extern __shared__ __attribute__((aligned(16))) unsigned char lds_raw[];
    LAS unsigned char* lds = (LAS unsigned char*)lds_raw;
    const int wave = __builtin_amdgcn_readfirstlane((int)threadIdx.x >> 6);
    const int G = gridDim.x, gw = blockIdx.x * NWAVES + wave, ngw = G * NWAVES;
    volatile LAS unsigned* MISC = (volatile LAS unsigned*)(lds + MISC_OFF);
    { const int t0 = wave * 64 + lane_id_opaque(); if (t0 < 32) MISC[t0] = 0u; }
    __syncthreads();
    int lo, hi; unsigned* ctl; { const Args a = KA(); ctl = (unsigned*)(a.ws + WS_CTL); lo = a.ph_lo; hi = a.ph_hi; }
    XcdBarrier bar; bar.bar = ctl + CW_BAR; bar.x = 0; bar.st = nullptr;
    if (hi - lo > 1) bar = xcd_barrier_post(ctl + CW_BAR, MISC + 8, wave == 0 && lane_id_opaque() == 0);
#define IN(k) (lo <= (k) && (k) < hi)
#ifndef DISMASK
#define DISMASK 0
#endif
#define DIS(k) ((DISMASK >> (k)) & 1)
#ifndef REPMASK
#define REPMASK 0
#endif
#define NREP(k) ((((REPMASK) >> (k)) & 1) ? 2 : 1)
#define REPSYNC(k) do { if (rep_ + 1 < NREP(k)) xcd_barrier(bar, wave); } while (0)
#define SEAM(k) do { if (IN(k) && IN((k) + 1)) xcd_barrier(bar, wave); } while (0)
    if (IN(0) && !DIS(0)) for (int rep_ = 0; rep_ < NREP(0); ++rep_) { const Args a = KA(); phase_prologue(a, lds, gw, ngw, wave); REPSYNC(0); }
    SEAM(0);
    for (int l = 0; l < 2; ++l) {
        const int pb = 1 + 10 * l;
        if (IN(pb + 0) && !DIS(1)) for (int rep_ = 0; rep_ < NREP(1); ++rep_) { const Args a = KA(); const float* xin = (l == 0) ? a.x : a.out; phase_norm<1>(a, l, xin, lds, gw, ngw, wave); __syncthreads(); REPSYNC(1); }
        SEAM(pb + 0);
        if (IN(pb + 1) && !DIS(2)) for (int rep_ = 0; rep_ < NREP(2); ++rep_) { const Args a = KA();
            ProbDense P{(const char*)(a.ws + WS_H), (const char*)(a.ws + WS_WIN) + (size_t)l * LDU * 1024 * 2, 1024};
            pg8::StaticOrder S; S.init(T_TOK / 256, LDU / 256, G, (int)blockIdx.x);
            EpiU E{(bf16_t*)(a.ws + WS_U)};
            pg8::gemm_phase(lds, P, S, E, wave);
            REPSYNC(2);
        }
        SEAM(pb + 1);
        if (IN(pb + 2) && !DIS(8)) { const Args a = KA();
            for (int rep_ = 0; rep_ < NREP(11); ++rep_) { phase_ml_b1(a, l, lds, gw, ngw, wave); REPSYNC(11); }
            for (int rep_ = 0; rep_ < NREP(12); ++rep_) { phase_sb(a, l, lds, gw, ngw, wave); REPSYNC(12); } }
        SEAM(pb + 2);
        if (IN(pb + 3) && !DIS(9)) { const Args a = KA();
            for (int rep_ = 0; rep_ < NREP(13); ++rep_) { phase_ml_b2(a, (int)blockIdx.x * (NWAVES * 64) + wave * 64 + lane_id_opaque(), G * NWAVES * 64); REPSYNC(13); }
            for (int rep_ = 0; rep_ < NREP(14); ++rep_) { phase_dil(a, l, lds, gw, ngw, wave); REPSYNC(14); } }
        SEAM(pb + 3);
        if (IN(pb + 4) && !DIS(10)) { const Args a = KA();
            for (int rep_ = 0; rep_ < NREP(15); ++rep_) { phase_ml_b3(a, l, lds, gw, ngw, wave); REPSYNC(15); }
            for (int rep_ = 0; rep_ < NREP(16); ++rep_) { phase_dil_merge(a, l, gw, ngw); REPSYNC(16); } }
        SEAM(pb + 4);
        if (IN(pb + 5) && !DIS(3)) for (int rep_ = 0; rep_ < ((l == 0) ? NREP(3) : 1); ++rep_) { const Args a = KA(); const float* xin = (l == 0) ? a.x : a.out; const float* modl = (const float*)(a.ws + WS_MOD) + (size_t)l * 8 * NMOD;
            ProbDense P{(const char*)(a.ws + WS_Y), (const char*)(a.ws + WS_WOUT) + (size_t)l * 1024 * 1024 * 2, 1024};
            pg8::StaticOrder S; S.init(T_TOK / 256, 4, G, (int)blockIdx.x);
            EpiOut E{xin, a.out, modl + 2048};
            pg8::gemm_phase(lds, P, S, E, wave);
            if (l == 0) REPSYNC(3);
        }
        SEAM(pb + 5);
        if (IN(pb + 6) && !DIS(4)) for (int rep_ = 0; rep_ < NREP(4); ++rep_) { const Args a = KA(); phase_norm<2>(a, (rep_ + 1 < NREP(4)) ? l + 2 : l, a.out, lds, gw, ngw, wave); __syncthreads(); REPSYNC(4); }
        SEAM(pb + 6);
        if (IN(pb + 7) && !DIS(5)) for (int rep_ = 0; rep_ < NREP(5); ++rep_) { const Args a = KA();
            LAS int* tab = (LAS int*)(lds + TAB_OFF); build_moe_tab(a, l, tab, wave);
            const int nMt = tab[352];
            ProbGU P{(const char*)(a.ws + WS_H), (const char*)(a.ws + WS_WGU) + (size_t)l * 16 * 1024 * 1024 * 2, (const int*)(a.ws + WS_LIST), tab};
            pg8::StaticOrder S; S.init(nMt, 8, G, (int)blockIdx.x);
            EpiGU E{(bf16_t*)(a.ws + WS_U), (const int*)(a.ws + WS_LIST), (const float*)(a.ws + WS_RW), tab};
            pg8::gemm_phase(lds, P, S, E, wave);
            REPSYNC(5);
        }
        SEAM(pb + 7);
        if (IN(pb + 8) && !DIS(6)) for (int rep_ = 0; rep_ < NREP(6); ++rep_) { const Args a = KA(); const float* modl = (const float*)(a.ws + WS_MOD) + (size_t)l * 8 * NMOD;
            LAS int* tab = (LAS int*)(lds + TAB_OFF); build_moe_tab(a, l, tab, wave);
            const int nMt = tab[352];
            ProbDown P{(const char*)(a.ws + WS_U), (const char*)(a.ws + WS_WD) + (size_t)l * 16 * 1024 * 512 * 2, tab};
            pg8::StaticOrder S; S.init(nMt, 4, G, (int)blockIdx.x);
            EpiDown E{(rep_ + 1 < NREP(6)) ? (float*)(a.ws + WS_Y) : a.out, (const int*)(a.ws + WS_LIST), modl + 5120, tab};
            pg8::gemm_phase(lds, P, S, E, wave);
            REPSYNC(6);
        }
        SEAM(pb + 8);
    }
    if (IN(21) && !DIS(7)) { const Args a = KA(); phase_final(a, gw, ngw); }
#undef IN
#undef SEAM
}

__global__ void __launch_bounds__(256) k_qkvm(const bf16_t* __restrict__ U, const float* __restrict__ conv_w, const float* __restrict__ conv_b,
                                              const float* __restrict__ wq, const float* __restrict__ wk, const float* __restrict__ wv, bf16_t* __restrict__ Q, bf16_t* __restrict__ K, bf16_t* __restrict__ V) {
    __shared__ float xc[4][64], xm[4][64];
    const int tid = threadIdx.x, ti = tid >> 6, e = tid & 63;
    const int nitem = (T_TOK / 4) * 4;
    for (int item = blockIdx.x; item < nitem; item += gridDim.x) {
        const int h = item & 3, t = (item >> 2) * 4 + ti;
        const int ts = t % SEQ; const int ch = h * 64 + e;
        float a = conv_b[ch];
#pragma unroll
        for (int j = 0; j < 4; ++j) { const int tt = ts - 3 + j; if (tt >= 0) a += conv_w[j * 256 + ch] * bf2f(U[(size_t)(t - 3 + j) * LDU + OFF_ML_X + ch]); }
        __syncthreads();
        xc[ti][e] = a * sigmoidf_(a);
        xm[ti][e] = bf2f(U[(size_t)t * LDU + OFF_ML_X + ch]);
        __syncthreads();
        float q = 0.f, k = 0.f, v = 0.f;
        for (int d = 0; d < 64; ++d) { const float c = xc[ti][d]; q += c * wq[(h * 64 + d) * 64 + e]; k += c * wk[(h * 64 + d) * 64 + e]; v += xm[ti][d] * wv[(h * 64 + d) * 64 + e]; }
        Q[(size_t)t * 256 + ch] = f2bf(q); K[(size_t)t * 256 + ch] = f2bf(k * 0.125f); V[(size_t)t * 256 + ch] = f2bf(v);
    }
}
__global__ void __launch_bounds__(256) k_mlstm_seq(const bf16_t* __restrict__ Q, const bf16_t* __restrict__ K, const bf16_t* __restrict__ V, const float* __restrict__ gate, const float* __restrict__ gate_bias,
                                                   const bf16_t* __restrict__ U, const float* __restrict__ g_head, bf16_t* __restrict__ Y) {
    __shared__ float sq[32][64], sk[32][64], sv[32][64], sig[32], slf[32];
    __shared__ float red[2][4][64]; __shared__ float sden[2];
    const int tid = threadIdx.x, e = tid & 63, dg = tid >> 6;
    const int b = blockIdx.x >> 2, h = blockIdx.x & 3;
    float C[16];
#pragma unroll
    for (int i = 0; i < 16; ++i) C[i] = 0.f;
    float nst = 0.f, m = 0.f;
    const float bi = gate_bias[h], bff = gate_bias[4 + h];
    for (int t0 = 0; t0 < SEQ; t0 += 32) {
        __syncthreads();
        for (int i = tid; i < 32 * 64; i += 256) { const int tt = i >> 6, d = i & 63; const size_t r = (size_t)(b * SEQ + t0 + tt) * 256 + h * 64 + d; sq[tt][d] = bf2f(Q[r]); sk[tt][d] = bf2f(K[r]); sv[tt][d] = bf2f(V[r]); }
        if (tid < 32) { const size_t r = (size_t)(b * SEQ + t0 + tid) * 8; sig[tid] = gate[r + h] + bi; const float fp = gate[r + 4 + h] + bff; slf[tid] = -softplusf_(-fp); }
        __syncthreads();
        for (int tt = 0; tt < 32; ++tt) {
            const int pb = tt & 1;
            const float ig = sig[tt], lf = slf[tt];
            const float mn = fmaxf(lf + m, ig);
            const float a = __expf(lf + m - mn), bc = __expf(ig - mn);
            m = mn;
            const float ve = sv[tt][e];
            float part = 0.f;
#pragma unroll
            for (int i = 0; i < 16; ++i) { const int d = dg * 16 + i; C[i] = a * C[i] + bc * sk[tt][d] * ve; part += sq[tt][d] * C[i]; }
            red[pb][dg][e] = part;
            if (tid < 64) { nst = a * nst + bc * sk[tt][tid]; const float qn = wave_sum(sq[tt][tid] * nst); if (tid == 0) sden[pb] = qn; }
            __syncthreads();
            if (tid < 64) {
                const float num = red[pb][0][e] + red[pb][1][e] + red[pb][2][e] + red[pb][3][e];
                const float den = sden[pb];
                const float hv = num / fmaxf(fabsf(den), __expf(-m));
                const size_t row = (size_t)(b * SEQ + t0 + tt);
                const float o = sigmoidf_(bf2f(U[row * LDU + OFF_ML_O + h * 64 + e])) * hv;
                const float ss = wave_sum(o * o);
                Y[row * 1024 + h * 64 + e] = f2bf(o * rsqrtf(ss * (1.f / 64.f) + EPS) * g_head[h * 64 + e]);
            }
        }
    }
}
__global__ void __launch_bounds__(256) k_dil(const bf16_t* __restrict__ U, const float* __restrict__ g_head, bf16_t* __restrict__ Y) {
    const int lane = threadIdx.x & 63;
    const int wave = (blockIdx.x * blockDim.x + threadIdx.x) >> 6, nw = (gridDim.x * blockDim.x) >> 6;
    for (int item = wave; item < NB * 6 * SEQ; item += nw) {
        const int t = item % SEQ, h = (item / SEQ) % 6, b = item / (SEQ * 6);
        const size_t row = (size_t)b * SEQ + t;
        const float q = bf2f(U[row * LDU + OFF_DIL + h * 64 + lane]);
        const float slope = exp2f(-8.f * (float)(h + 1) / 6.f);
        float m = -INFINITY, l = 0.f, acc = 0.f;
        for (int p = 0; p < 3; ++p) {
            const int d = (p == 0) ? 1 : (p == 1 ? 4 : 16);
            for (int j = 0; j <= 128; ++j) {
                const int tk = t - j * d; if (tk < 0) break;
                const size_t kr = ((size_t)b * SEQ + tk) * LDU + OFF_DIL + h * 64 + lane;
                const float kv = bf2f(U[kr + 384]), vv = bf2f(U[kr + 768]);
                const float s = wave_sum(q * kv) * 0.125f - slope * (float)(j * d);
                const float mn = fmaxf(m, s); const float corr = __expf(m - mn), pe = __expf(s - mn);
                l = l * corr + pe; acc = acc * corr + pe * vv; m = mn;
            }
        }
        const float o = acc / l;
        const float ss = wave_sum(o * o);
        Y[row * 1024 + (4 + h) * 64 + lane] = f2bf(o * rsqrtf(ss * (1.f / 64.f) + EPS) * g_head[(4 + h) * 64 + lane]);
    }
}
__global__ void __launch_bounds__(256) k_sb(const bf16_t* __restrict__ U, const float* __restrict__ g_head, bf16_t* __restrict__ Y) {
    const int lane = threadIdx.x & 63;
    const int wave = (blockIdx.x * blockDim.x + threadIdx.x) >> 6, nw = (gridDim.x * blockDim.x) >> 6;
    for (int item = wave; item < NB * 6 * SEQ; item += nw) {
        const int t = item % SEQ, h = (item / SEQ) % 6, b = item / (SEQ * 6);
        const size_t row = (size_t)b * SEQ + t;
        const float q = bf2f(U[row * LDU + OFF_SB + h * 64 + lane]);
        float run = 0.f, acc = 0.f;
        for (int s = t - 1; s >= 0; --s) {
            const size_t kr = ((size_t)b * SEQ + s) * LDU + OFF_SB + h * 64 + lane;
            const float kv = bf2f(U[kr + 384]), vv = bf2f(U[kr + 768]);
            const float z = wave_sum(q * kv) * 0.125f;
            const float lk = -softplusf_(z);
            acc += __expf(z + lk + run) * vv;
            run += lk;
            if (run < -104.f) break;
        }
        const float ss = wave_sum(acc * acc);
        Y[row * 1024 + (10 + h) * 64 + lane] = f2bf(acc * rsqrtf(ss * (1.f / 64.f) + EPS) * g_head[(10 + h) * 64 + lane]);
    }
}

extern "C" void kernel_launch(void* const* d_in, const int* in_sizes, int n_in, void* d_out, int out_size, void* d_ws, size_t ws_size, hipStream_t stream) {
    static int grid = 0;
    if (grid == 0) {
        int dev = 0, cus = 0;
        if (ws_size < WS_END) { fprintf(stderr, "kernel_launch: workspace too small (%zu < %zu)\n", ws_size, (size_t)WS_END); grid = -1; return; }
        if (hipGetDevice(&dev) != hipSuccess || hipDeviceGetAttribute(&cus, hipDeviceAttributeMultiprocessorCount, dev) != hipSuccess) { grid = -1; return; }
        if (hipFuncSetAttribute((const void*)fwd, hipFuncAttributeMaxDynamicSharedMemorySize, LDS_BYTES) != hipSuccess) { fprintf(stderr, "kernel_launch: hipFuncSetAttribute failed\n"); grid = -1; return; }
        (void)hipGetLastError();
        grid = 256;
        if (cus < 256) { fprintf(stderr, "kernel_launch: needs 256 CUs, device has %d\n", cus); grid = -1; return; }
    }
    if (grid < 0) return;
    Args a{};
    a.x = (const float*)d_in[0]; a.c = (const float*)d_in[1]; a.w_in = (const float*)d_in[2]; a.conv_w = (const float*)d_in[3]; a.conv_b = (const float*)d_in[4];
    a.w_mq = (const float*)d_in[5]; a.w_mk = (const float*)d_in[6]; a.w_mv = (const float*)d_in[7]; a.gate_bias = (const float*)d_in[8]; a.g_head = (const float*)d_in[9];
    a.w_out = (const float*)d_in[10]; a.w_ada = (const float*)d_in[11]; a.b_ada = (const float*)d_in[12]; a.w_router = (const float*)d_in[13]; a.router_bias = (const float*)d_in[14];
    a.w_gate_e = (const float*)d_in[15]; a.w_up_e = (const float*)d_in[16]; a.w_down_e = (const float*)d_in[17]; a.g_final = (const float*)d_in[18];
    a.out = (float*)d_out; a.ws = (unsigned char*)d_ws;
    char* ws = (char*)d_ws;
    (void)hipMemsetAsync(ws + WS_CTL, 0, CTL_BYTES, stream);
    float* gate = (float*)(ws + WS_GATE); bf16_t* U = (bf16_t*)(ws + WS_U);
    bf16_t* Y = (bf16_t*)(ws + WS_Y); bf16_t* Qm = (bf16_t*)(ws + WS_QKV); bf16_t* Km = Qm + (size_t)T_TOK * 256; bf16_t* Vm = Km + (size_t)T_TOK * 256;
#define RUN(lo_, hi_) do { a.ph_lo = (lo_); a.ph_hi = (hi_); hipLaunchKernelGGL(fwd, dim3(grid), dim3(NWAVES * 64), LDS_BYTES, stream, a); } while (0)
#if defined(MK_SPLIT)
    RUN(0, 1);
    for (int l = 0; l < 2; ++l) { const int pb = 1 + 10 * l; for (int k = 0; k < 9; ++k) RUN(pb + k, pb + k + 1); }
    RUN(21, 22);
#else
    RUN(0, 22);
#endif
#undef RUN
}
```

```cpp
#include <hip/hip_runtime.h>
#include <stdint.h>
#include <stdio.h>

#define T_TOK 32768
#define SEQ 4096
#define DM 1024
#define NB 8
#define DIN 2824
#define LDU 2816
#define OFF_ML_X 0
#define OFF_ML_O 256
#define OFF_DIL 512
#define OFF_SB 1664
#define NMOD 6144
#define EPS 1e-6f
#define NBUCK 24

#define LAS __attribute__((address_space(3)))
typedef unsigned short bf16_t;
typedef short bf16x8 __attribute__((ext_vector_type(8)));
typedef float f32x4 __attribute__((ext_vector_type(4)));
typedef float f32x2 __attribute__((ext_vector_type(2)));
typedef unsigned u32x4 __attribute__((ext_vector_type(4)));
typedef unsigned u32x2 __attribute__((ext_vector_type(2)));

__device__ __forceinline__ float bf2f(bf16_t v) { return __uint_as_float(((unsigned)v) << 16); }
__device__ __forceinline__ unsigned f2bf_u(float f) { unsigned u = __float_as_uint(f); return (u + 0x7fffu + ((u >> 16) & 1u)) >> 16; }
__device__ __forceinline__ bf16_t f2bf(float f) { return (bf16_t)f2bf_u(f); }
__device__ __forceinline__ unsigned pk2(float lo, float hi) { return f2bf_u(lo) | (f2bf_u(hi) << 16); }
__device__ __forceinline__ float wave_sum(float v) {
#pragma unroll
    for (int o = 32; o > 0; o >>= 1) v += __shfl_xor(v, o, 64);
    return v;
}
__device__ __forceinline__ float bperm_f(float v, int srclane) { return __int_as_float(__builtin_amdgcn_ds_bpermute((srclane & 63) << 2, __float_as_int(v))); }
__device__ __forceinline__ int opaque_one() { int r; asm volatile("s_mov_b32 %0, 1" : "=s"(r)); return r; }
__device__ __forceinline__ int lane_id_opaque() { int r; asm volatile("v_mbcnt_lo_u32_b32 %0, -1, 0\n\tv_mbcnt_hi_u32_b32 %0, -1, %0" : "=v"(r)); return r; }
__device__ __forceinline__ float wave_sum_l(float v, int lane) {
#pragma unroll
    for (int o = 32; o > 0; o >>= 1) v += __int_as_float(__builtin_amdgcn_ds_bpermute((lane ^ o) << 2, __float_as_int(v)));
    return v;
}
__device__ __forceinline__ float sigmoidf_(float x) { return 1.f / (1.f + __expf(-x)); }
__device__ __forceinline__ float softplusf_(float z) { return fmaxf(z, 0.f) + log1pf(__expf(-fabsf(z))); }

constexpr size_t MiB = 1u << 20;
constexpr size_t WS_CTL   = 0;
constexpr size_t CTL_BYTES = 1 * MiB;
constexpr size_t WS_MOD   = 1 * MiB;
constexpr size_t WS_GATE  = WS_MOD + 512 * 1024;
constexpr size_t WS_RW    = WS_GATE + 1 * MiB;
constexpr size_t WS_LIST  = WS_RW + 256 * 1024;
constexpr size_t WS_WIN   = 6 * MiB;
constexpr size_t WS_WOUT  = 17 * MiB;
constexpr size_t WS_WGU   = 21 * MiB;
constexpr size_t WS_WD    = 85 * MiB;
constexpr size_t WS_H     = 117 * MiB;
constexpr size_t WS_U     = 181 * MiB;
constexpr size_t WS_Y     = 357 * MiB;
constexpr size_t WS_QKV   = 421 * MiB;
constexpr size_t WS_OP1   = WS_H;
constexpr size_t WS_CLOC  = WS_H + 24 * MiB;
constexpr size_t WS_OP2   = 469 * MiB;
constexpr size_t WS_LSE   = 493 * MiB;
constexpr size_t WS_CT    = 496 * MiB;
constexpr size_t WS_MLS   = 504 * MiB;
constexpr size_t WS_END   = 507 * MiB;
constexpr size_t MLS_CUM = 0, MLS_AA = 512 * 1024, MLS_PM = 1024 * 1024, MLS_NLOC = 1536 * 1024  , MLS_NC = 2048 * 1024, MLS_AMAX = 2304 * 1024, MLS_LSUM = 2308 * 1024, MLS_MC = 2312 * 1024, MLS_WT = 2560 * 1024;

constexpr int CW_BAR = 4096;
constexpr int CW_CNT = 8192;

namespace pg8 {
constexpr int BM = 256, BK = 64, HALF = 128, HTB = HALF * BK * 2, STAGE_BYTES = 8 * HTB, NXCD = 8, WGM = 8;
__host__ __device__ __forceinline__ int lds_byte(int r, int c) { const int st = (r >> 4) * 2 + (c >> 5), rr = r & 15, cc = c & 31, ob = rr * 64 + cc * 2; return st * 1024 + (ob ^ (((ob >> 9) & 1) << 5)); }
__host__ __device__ __forceinline__ void stage_rc(int b, int& R, int& C) { const int st = b / 1024, sb = b % 1024, swz = sb ^ (((sb >> 9) & 1) << 5); R = (st >> 1) * 16 + swz / 64; C = (st & 1) * 32 + (swz % 64) / 2; }
__host__ __device__ __forceinline__ int perm32(int rho) { const int n = rho >> 4, i = rho & 15; return 8 * (i >> 2) + 4 * n + (i & 3); }
struct Unit { int pm, pn; };
struct StaticOrder {
    int nM, nN, nwg, G, c;
    __device__ void init(int nM_, int nN_, int G_, int c_) { nM = nM_; nN = nN_; nwg = nM * nN; G = G_; c = c_; }
    __device__ bool next(int i, Unit& u) const {
        const long L = (long)i * G + c; if (L >= nwg) return false;
        int wgid = (int)L; { const int q = nwg / NXCD, r = nwg % NXCD, xcd = wgid % NXCD, off = wgid / NXCD; wgid = (xcd < r ? xcd * (q + 1) : r * (q + 1) + (xcd - r) * q) + off; }
        const int nig = WGM * nN, gid = wgid / nig, fm = gid * WGM, gsz = (nM - fm) < WGM ? (nM - fm) : WGM;
        u.pm = fm + ((wgid % nig) % gsz); u.pn = (wgid % nig) / gsz; return true;
    }
};
__device__ __forceinline__ unsigned cvt_pk_bf16(float lo, float hi) { unsigned r; asm volatile("v_cvt_pk_bf16_f32 %0, %1, %2" : "=v"(r) : "v"(lo), "v"(hi)); return r; }

template <class P, class Epi, class Sched>
__device__ __forceinline__ void gemm_phase(LAS unsigned char* lds, const P& pb, const Sched& S, const Epi& E, int wave_) {
    const int tid_ = wave_ * 64 + lane_id_opaque();
    const int tid = tid_, wid = __builtin_amdgcn_readfirstlane(tid >> 6), lane = tid & 63, wr = wid >> 2, wc = wid & 3, fr = lane & 15, fq = lane >> 4;
    const int nt = pb.nt();
    unsigned voffB[2];
#pragma unroll
    for (int i = 0; i < 2; ++i) { int R, C; stage_rc(tid * 16 + i * 8192, R, C); const int Rb = Epi::PERM ? ((R & ~31) + perm32(R & 31)) : R; voffB[i] = (unsigned)(Rb * pb.ldb() + C) * 2u; }
    const size_t hstepB = (size_t)HALF * pb.ldb() * 2;
    const unsigned ldsw = (unsigned)wid * 1024u;
    const int aoff = lds_byte(wr * 64 + fr, fq * 8), boff = lds_byte(wc * 32 + fr, fq * 8);
#define PG8_SA(b, h) (((b) * 2 + (h)) * HTB)
#define PG8_SB(b, h) ((4 + (b) * 2 + (h)) * HTB)
#define PG8_STAGE(bufoff, gbase, voff) do { _Pragma("unroll") for (int _i = 0; _i < 2; ++_i) \
        __builtin_amdgcn_global_load_lds((const unsigned*)((const char*)(gbase) + (voff)[_i]), (LAS unsigned*)(lds + (bufoff) + ldsw + _i * 8192), 16, 0, 0); } while (0)
#define PG8_LDA(dst, b, h) do { _Pragma("unroll") for (int m = 0; m < 4; ++m) _Pragma("unroll") for (int k = 0; k < 2; ++k) dst[m][k] = *(const LAS bf16x8*)(lds + PG8_SA(b, h) + aoff + m * 2048 + k * 1024); } while (0)
#define PG8_LDB(dst, b, h) do { _Pragma("unroll") for (int n = 0; n < 2; ++n) _Pragma("unroll") for (int k = 0; k < 2; ++k) dst[n][k] = *(const LAS bf16x8*)(lds + PG8_SB(b, h) + boff + n * 2048 + k * 1024); } while (0)
#define PG8_MMA(ai, bj, At, Bt) do { __builtin_amdgcn_s_setprio(1); _Pragma("unroll") for (int m = 0; m < 4; ++m) _Pragma("unroll") for (int n = 0; n < 2; ++n) _Pragma("unroll") for (int k = 0; k < 2; ++k) \
        acc[ai][bj][m][n] = __builtin_amdgcn_mfma_f32_16x16x32_bf16(Bt[n][k], At[m][k], acc[ai][bj][m][n], 0, 0, 0); __builtin_amdgcn_s_setprio(0); } while (0)
#define PG8_WAIT_V(n) asm volatile("s_waitcnt vmcnt(" #n ")" ::: "memory")
#define PG8_WAIT_L(n) asm volatile("s_waitcnt lgkmcnt(" #n ")" ::: "memory")
#define PG8_BAR __builtin_amdgcn_s_barrier()
#define PG8_SCHED __builtin_amdgcn_sched_barrier(0)
#define PG8_AOFF(dst, u) do { int _t = tid; asm volatile("" : "+v"(_t)); _Pragma("unroll") for (int _i = 0; _i < 2; ++_i) { int _R, _C; stage_rc(_t * 16 + _i * 8192, _R, _C); \
        _Pragma("unroll") for (int _h = 0; _h < 2; ++_h) dst[_h][_i] = pb.a_row(u, _h * HALF + _R) + (unsigned)_C * 2u; } } while (0)
    Unit cur, nxt; int ui = 0;
    if (!S.next(0, cur)) return;
    f32x4 acc[2][2][4][2];
#pragma unroll
    for (int a = 0; a < 2; ++a)
#pragma unroll
        for (int b = 0; b < 2; ++b)
#pragma unroll
            for (int m = 0; m < 4; ++m)
#pragma unroll
                for (int n = 0; n < 2; ++n) acc[a][b][m][n] = (f32x4){0.f, 0.f, 0.f, 0.f};
    bf16x8 At[4][2], B0[2][2], B1[2][2];
    unsigned ca[2][2], na[2][2];
    PG8_AOFF(ca, cur);
    const char* Ab = pb.a_base();
    {
        const char* b0 = pb.b_tile(cur, 0); const char* b1 = pb.b_tile(cur, 1);
        PG8_STAGE(PG8_SB(0, 0), b0, voffB); PG8_STAGE(PG8_SB(0, 1), b0 + hstepB, voffB); PG8_STAGE(PG8_SA(0, 0), Ab, ca[0]); PG8_STAGE(PG8_SA(0, 1), Ab, ca[1]);
        if (wr == 1) PG8_BAR;
        PG8_WAIT_V(2); PG8_BAR;
        PG8_STAGE(PG8_SB(1, 0), b1, voffB); PG8_STAGE(PG8_SA(1, 0), Ab + 128, ca[0]); PG8_STAGE(PG8_SB(1, 1), b1 + hstepB, voffB);
        PG8_WAIT_V(6); PG8_BAR;
    }
    for (;;) {
        const bool has_next = S.next(ui + 1, nxt);
        if (!has_next) nxt = cur;
        PG8_AOFF(na, nxt);
#define PG8_KPAIR(A2BASE, OFF2, B2, B3, A1P) do { \
              \
            PG8_LDB(B0, 0, 0); PG8_LDB(B1, 0, 1); PG8_SCHED; PG8_LDA(At, 0, 0); PG8_STAGE(PG8_SA(1, 1), A1P, ca[1]); \
            PG8_WAIT_V(8); PG8_WAIT_L(0); PG8_BAR; PG8_MMA(0, 0, At, B0); PG8_MMA(0, 1, At, B1); PG8_BAR; PG8_SCHED; \
              \
            PG8_LDA(At, 0, 1); PG8_STAGE(PG8_SB(0, 0), B2, voffB); PG8_STAGE(PG8_SB(0, 1), (B2) + hstepB, voffB); PG8_STAGE(PG8_SA(0, 0), A2BASE, OFF2[0]); \
            PG8_WAIT_V(8); PG8_WAIT_L(0); PG8_BAR; PG8_MMA(1, 0, At, B0); PG8_MMA(1, 1, At, B1); PG8_BAR; PG8_SCHED; \
              \
            PG8_LDB(B0, 1, 0); PG8_LDB(B1, 1, 1); PG8_SCHED; PG8_LDA(At, 1, 0); PG8_STAGE(PG8_SA(0, 1), A2BASE, OFF2[1]); \
            PG8_WAIT_V(8); PG8_WAIT_L(0); PG8_BAR; PG8_MMA(0, 0, At, B0); PG8_MMA(0, 1, At, B1); PG8_BAR; PG8_SCHED; \
              \
            PG8_LDA(At, 1, 1); PG8_STAGE(PG8_SB(1, 0), B3, voffB); PG8_STAGE(PG8_SB(1, 1), (B3) + hstepB, voffB); PG8_STAGE(PG8_SA(1, 0), (A2BASE) + 128, OFF2[0]); \
            PG8_WAIT_V(8); PG8_WAIT_L(0); PG8_BAR; PG8_MMA(1, 0, At, B0); PG8_MMA(1, 1, At, B1); PG8_BAR; PG8_SCHED; } while (0)
        for (int t = 0; t < nt - 2; t += 2) {
            const char* b2 = pb.b_tile(cur, t + 2); const char* b3 = pb.b_tile(cur, t + 3);
            const char* a1p = Ab + (size_t)(t + 1) * 128; const char* a2p = Ab + (size_t)(t + 2) * 128;
            PG8_KPAIR(a2p, ca, b2, b3, a1p);
        }
        {
            const char* b2 = pb.b_tile(nxt, 0); const char* b3 = pb.b_tile(nxt, 1);
            const char* a1p = Ab + (size_t)(nt - 1) * 128;
            PG8_KPAIR(Ab, na, b2, b3, a1p);
        }
#undef PG8_KPAIR
        if (wr == 0) PG8_BAR;
        E(acc, cur, wr, wc, fr, fq);
        if (!has_next) break;
#pragma unroll
        for (int a = 0; a < 2; ++a)
#pragma unroll
            for (int b = 0; b < 2; ++b)
#pragma unroll
                for (int m = 0; m < 4; ++m)
#pragma unroll
                    for (int n = 0; n < 2; ++n) acc[a][b][m][n] = (f32x4){0.f, 0.f, 0.f, 0.f};
        cur = nxt;
#pragma unroll
        for (int h = 0; h < 2; ++h)
#pragma unroll
            for (int i = 0; i < 2; ++i) ca[h][i] = na[h][i];
        ++ui;
        if (wr == 1) PG8_BAR;
    }
    PG8_WAIT_V(0);
    PG8_BAR;
#undef PG8_SA
#undef PG8_SB
#undef PG8_STAGE
#undef PG8_LDA
#undef PG8_LDB
#undef PG8_MMA
#undef PG8_WAIT_V
#undef PG8_WAIT_L
#undef PG8_BAR
#undef PG8_SCHED
#undef PG8_AOFF
}
}
using pg8::Unit;

struct ProbDense {
    const char* A; const char* B; int K;
    __device__ __forceinline__ int nt() const { return K / 64; }
    __device__ __forceinline__ int ldb() const { return K; }
    __device__ __forceinline__ const char* a_base() const { return A; }
    __device__ __forceinline__ unsigned a_row(const Unit& u, int r) const { return (unsigned)((u.pm * 256 + r) * K) * 2u; }
    __device__ __forceinline__ const char* b_tile(const Unit& u, int t) const { return B + (size_t)u.pn * 256 * K * 2 + (size_t)t * 128; }
};
__device__ __forceinline__ int bucket_e0(int k) { const int g = k / 6, p = k % 6; return 4 * g + (p < 3 ? 0 : (p < 5 ? 1 : 2)); }
__device__ __forceinline__ int bucket_e1(int k) { const int g = k / 6, p = k % 6; return 4 * g + (p < 3 ? p + 1 : (p < 5 ? p - 1 : 3)); }
struct ProbGU {
    const char* H; const char* W; const int* list; const LAS int* tab;
    __device__ __forceinline__ int nt() const { return 16; }
    __device__ __forceinline__ int ldb() const { return 1024; }
    __device__ __forceinline__ const char* a_base() const { return H; }
    __device__ __forceinline__ unsigned a_row(const Unit& u, int r) const {
        const int k = tab[32 + u.pm], rr = tab[192 + u.pm] + r; int tok = 0; if (rr < tab[k]) tok = list[(size_t)k * T_TOK + rr]; return (unsigned)tok * 2048u; }
    __device__ __forceinline__ const char* b_tile(const Unit& u, int t) const {
        const int k = __builtin_amdgcn_readfirstlane(tab[32 + u.pm]); const int e = (u.pn < 4) ? bucket_e0(k) : bucket_e1(k);
        return W + (size_t)e * (1024 * 1024 * 2) + (size_t)(u.pn & 3) * 256 * 2048 + (size_t)t * 128; }
};
struct ProbDown {
    const char* HE; const char* W; const LAS int* tab;
    __device__ __forceinline__ int nt() const { return 16; }
    __device__ __forceinline__ int ldb() const { return 512; }
    __device__ __forceinline__ const char* a_base() const { return HE; }
    __device__ __forceinline__ unsigned a_row(const Unit& u, int r) const { return (unsigned)(u.pm * 256 + r) * 2048u; }
    __device__ __forceinline__ const char* b_tile(const Unit& u, int t) const {
        const int k = __builtin_amdgcn_readfirstlane(tab[32 + u.pm]); const int e = (t < 8) ? bucket_e0(k) : bucket_e1(k);
        return W + (size_t)e * (1024 * 512 * 2) + (size_t)u.pn * 256 * 1024 + (size_t)(t & 7) * 128; }
};

__device__ __forceinline__ f32x4 bf4_lo(const u32x4& v) { return (f32x4){__uint_as_float(v.x << 16), __uint_as_float(v.x & 0xffff0000u), __uint_as_float(v.y << 16), __uint_as_float(v.y & 0xffff0000u)}; }
__device__ __forceinline__ f32x4 bf4_hi(const u32x4& v) { return (f32x4){__uint_as_float(v.z << 16), __uint_as_float(v.z & 0xffff0000u), __uint_as_float(v.w << 16), __uint_as_float(v.w & 0xffff0000u)}; }
#ifndef EPI_SC1
#define EPI_SC1 1
#endif
__device__ __forceinline__ void store16_wt(void* p, const u32x4& v) {
#if EPI_SC1
    asm volatile("global_store_dwordx4 %0, %1, off sc1\n\ts_nop 1" :: "v"(p), "v"(v) : "memory");
#else
    *(u32x4*)p = v;
#endif
}
struct EpiU {
    static constexpr bool PERM = true;
    bf16_t* O;
    __device__ __forceinline__ void operator()(const f32x4 (&acc)[2][2][4][2], const Unit& u, int wr, int wc, int fr, int fq) const {
        const int row0 = u.pm * 256 + wr * 64 + fr, col0 = u.pn * 256 + wc * 32 + 8 * fq;
#pragma unroll
        for (int ai = 0; ai < 2; ++ai)
#pragma unroll
            for (int m = 0; m < 4; ++m) { bf16_t* rowp = O + (size_t)(row0 + ai * 128 + m * 16) * LDU + col0;
#pragma unroll
                for (int bj = 0; bj < 2; ++bj) { const f32x4 v0 = acc[ai][bj][m][0], v1 = acc[ai][bj][m][1];
                    u32x4 w; w.x = pg8::cvt_pk_bf16(v0[0], v0[1]); w.y = pg8::cvt_pk_bf16(v0[2], v0[3]); w.z = pg8::cvt_pk_bf16(v1[0], v1[1]); w.w = pg8::cvt_pk_bf16(v1[2], v1[3]);
                    store16_wt(rowp + bj * 128, w); } }
    }
};
template <bool XINBF> struct EpiOut {
    static constexpr bool PERM = true;
    const void* xin; bf16_t* XB; const float* gate;
    __device__ __forceinline__ void operator()(const f32x4 (&acc)[2][2][4][2], const Unit& u, int wr, int wc, int fr, int fq) const {
        const int b = (u.pm * 256) / SEQ; const int col0 = u.pn * 256 + wc * 32 + 8 * fq;
        f32x4 gv[2][2];
#pragma unroll
        for (int bj = 0; bj < 2; ++bj)
#pragma unroll
            for (int n = 0; n < 2; ++n) gv[bj][n] = *(const f32x4*)(gate + (size_t)b * NMOD + col0 + bj * 128 + n * 4);
#pragma unroll
        for (int ai = 0; ai < 2; ++ai)
#pragma unroll
            for (int m = 0; m < 4; ++m) { const size_t off = (size_t)(u.pm * 256 + ai * 128 + wr * 64 + m * 16 + fr) * DM + col0;
#pragma unroll
                for (int bj = 0; bj < 2; ++bj) {
                    f32x4 x0, x1;
                    if (XINBF) { const u32x4 xv = *(const u32x4*)((const bf16_t*)xin + off + bj * 128); x0 = bf4_lo(xv); x1 = bf4_hi(xv); }
                    else { x0 = *(const f32x4*)((const float*)xin + off + bj * 128); x1 = *(const f32x4*)((const float*)xin + off + bj * 128 + 4); }
                    const f32x4 y0 = x0 + gv[bj][0] * acc[ai][bj][m][0], y1 = x1 + gv[bj][1] * acc[ai][bj][m][1];
                    u32x4 w; w.x = pg8::cvt_pk_bf16(y0[0], y0[1]); w.y = pg8::cvt_pk_bf16(y0[2], y0[3]); w.z = pg8::cvt_pk_bf16(y1[0], y1[1]); w.w = pg8::cvt_pk_bf16(y1[2], y1[3]);
                    store16_wt(XB + off + bj * 128, w); } }
    }
};
struct EpiGU {
    static constexpr bool PERM = true;
    bf16_t* HE; const int* list; const float* rw; const LAS int* tab;
    __device__ __forceinline__ void operator()(const f32x4 (&acc)[2][2][4][2], const Unit& u, int wr, int wc, int fr, int fq) const {
        const int k = tab[32 + u.pm], r0 = tab[192 + u.pm], cnt = tab[k]; const int part = u.pn >> 2;
        const int hcol0 = part * 512 + ((u.pn & 3) * 256 + wc * 32 + 8 * fq) / 2;
#pragma unroll
        for (int ai = 0; ai < 2; ++ai)
#pragma unroll
            for (int m = 0; m < 4; ++m) { const int r = ai * 128 + wr * 64 + m * 16 + fr; const int rr = r0 + r;
                if (rr < cnt) { const int tok = list[(size_t)k * T_TOK + rr]; const float w = rw[tok * 2 + part];
                    bf16_t* rowp = HE + (size_t)(u.pm * 256 + r) * 1024 + hcol0;
#pragma unroll
                    for (int bj = 0; bj < 2; ++bj) { const f32x4 v0 = acc[ai][bj][m][0], v1 = acc[ai][bj][m][1];
                        const float h0 = v0[0] * sigmoidf_(v0[0]) * v0[1] * w, h1 = v0[2] * sigmoidf_(v0[2]) * v0[3] * w, h2 = v1[0] * sigmoidf_(v1[0]) * v1[1] * w, h3 = v1[2] * sigmoidf_(v1[2]) * v1[3] * w;
                        u32x2 o; o.x = pg8::cvt_pk_bf16(h0, h1); o.y = pg8::cvt_pk_bf16(h2, h3);
                        *(u32x2*)(rowp + bj * 64) = o; } } }
    }
};
struct EpiDown {
    static constexpr bool PERM = true;
    bf16_t* XB; const int* list; const float* gate; const LAS int* tab;
    __device__ __forceinline__ void operator()(const f32x4 (&acc)[2][2][4][2], const Unit& u, int wr, int wc, int fr, int fq) const {
        const int k = tab[32 + u.pm], r0 = tab[192 + u.pm], cnt = tab[k]; const int col0 = u.pn * 256 + wc * 32 + 8 * fq;
        int tok[2][4];
#pragma unroll
        for (int ai = 0; ai < 2; ++ai)
#pragma unroll
            for (int m = 0; m < 4; ++m) { const int rr = r0 + ai * 128 + wr * 64 + m * 16 + fr; tok[ai][m] = (rr < cnt) ? list[(size_t)k * T_TOK + rr] : -1; }
#pragma unroll
        for (int ai = 0; ai < 2; ++ai)
#pragma unroll
            for (int mp = 0; mp < 4; mp += 2) {
                u32x4 xi[2][2]; f32x4 gv[2][2][2];
#pragma unroll
                for (int mm = 0; mm < 2; ++mm) { const int tk = tok[ai][mp + mm]; const int tks = tk < 0 ? 0 : tk; const bf16_t* xr = XB + (size_t)tks * DM + col0; const float* gr = gate + (size_t)(tks / SEQ) * NMOD + col0;
#pragma unroll
                    for (int bj = 0; bj < 2; ++bj) { xi[mm][bj] = *(const u32x4*)(xr + bj * 128); gv[mm][bj][0] = *(const f32x4*)(gr + bj * 128); gv[mm][bj][1] = *(const f32x4*)(gr + bj * 128 + 4); } }
#pragma unroll
                for (int mm = 0; mm < 2; ++mm) { const int tk = tok[ai][mp + mm];
                    if (tk >= 0) { bf16_t* xr = XB + (size_t)tk * DM + col0;
#pragma unroll
                        for (int bj = 0; bj < 2; ++bj) { const f32x4 y0 = bf4_lo(xi[mm][bj]) + gv[mm][bj][0] * acc[ai][bj][mp + mm][0], y1 = bf4_hi(xi[mm][bj]) + gv[mm][bj][1] * acc[ai][bj][mp + mm][1];
                            u32x4 w; w.x = pg8::cvt_pk_bf16(y0[0], y0[1]); w.y = pg8::cvt_pk_bf16(y0[2], y0[3]); w.z = pg8::cvt_pk_bf16(y1[0], y1[1]); w.w = pg8::cvt_pk_bf16(y1[2], y1[3]);
                            *(u32x4*)(xr + bj * 128) = w; } } }
            }
    }
};

#define XB_TMO      128
#define XB_XCNT(j)  (256  + 64 * (j))
#define XB_XSUB(j)  (1280 + 64 * (j))
#define XB_XGEN(j)  (2304 + 64 * (j))
#define XB_TOP      3328
#define XB_TOPGEN   3392
#define XCD_BAR_WORDS 3456
#define XB_SPIN_CAP (1u << 18)
__device__ __forceinline__ unsigned xb_ld(unsigned* p)              { return __hip_atomic_load(p, __ATOMIC_RELAXED, __HIP_MEMORY_SCOPE_AGENT); }
__device__ __forceinline__ unsigned xb_add(unsigned* p, unsigned v) { return __hip_atomic_fetch_add(p, v, __ATOMIC_RELAXED, __HIP_MEMORY_SCOPE_AGENT); }
__device__ __forceinline__ unsigned xb_xcc_id() { return (unsigned)__builtin_amdgcn_s_getreg((3 << 11) | 20) & 0xFu; }
#define XB_SPIN(cond, bar) do { unsigned _sp = 0; while (cond) { __builtin_amdgcn_s_sleep(1); \
    if ((++_sp & 255u) == 0u) { if (xb_ld(&(bar)[XB_TMO])) break; if (_sp > XB_SPIN_CAP) { atomicAdd(&(bar)[XB_TMO], 1u); break; } } } } while (0)
struct XcdBarrier { unsigned* bar; unsigned x; volatile LAS unsigned* st; };
__device__ __forceinline__ XcdBarrier xcd_barrier_post(unsigned* bar, volatile LAS unsigned* st, bool leader) {
    XcdBarrier b; b.bar = bar; b.x = xb_xcc_id(); b.st = st;
    if (leader) (void)xb_add(&bar[XB_XCNT(b.x)], 1u);
    return b;
}
__device__ __forceinline__ void xcd_barrier_complete(unsigned* bar, unsigned x, unsigned& nloc, unsigned& nx) {
    const unsigned G = gridDim.x * gridDim.y * gridDim.z;
    unsigned sum, cnt, mine, sp = 0u;
    for (;;) {
        sum = 0u; cnt = 0u; mine = 0u;
#pragma unroll
        for (unsigned j = 0; j < 16; ++j) { const unsigned c = xb_ld(&bar[XB_XCNT(j)]); sum += c; cnt += (c > 0u) ? 1u : 0u; mine = (j == x) ? c : mine; }
        if (sum == G) break;
        __builtin_amdgcn_s_sleep(1);
        if ((++sp & 255u) == 0u) { if (xb_ld(&bar[XB_TMO])) break; if (sp > XB_SPIN_CAP) { atomicAdd(&bar[XB_TMO], 1u); break; } }
    }
    nloc = mine > 0u ? mine : 1u; nx = cnt > 0u ? cnt : 1u;
}
__device__ __forceinline__ void xcd_barrier(const XcdBarrier& b, int wave_) {
    asm volatile("s_waitcnt vmcnt(0)" ::: "memory");
    __syncthreads();
    if (wave_ == 0 && lane_id_opaque() == 0) {
        unsigned* bar = b.bar; asm volatile("" : "+s"(bar));
        __builtin_amdgcn_s_waitcnt(0);
        unsigned nloc = b.st[0], nx = b.st[1];
        if (nloc == 0u) { xcd_barrier_complete(bar, b.x, nloc, nx); b.st[0] = nloc; b.st[1] = nx; }
        const unsigned old = xb_add(&bar[XB_XSUB(b.x)], 1u);
        const unsigned gen = old / nloc;
        if (old + 1u == (gen + 1u) * nloc) {
            __builtin_amdgcn_fence(__ATOMIC_RELEASE, "agent");
            asm volatile("s_waitcnt vmcnt(0)" ::: "memory");
            const unsigned og = xb_add(&bar[XB_TOP], 1u);
            const unsigned tg = og / nx;
            if (og + 1u == (tg + 1u) * nx) xb_add(&bar[XB_TOPGEN], 1u);
            else XB_SPIN(xb_ld(&bar[XB_TOPGEN]) == tg, bar);
            __builtin_amdgcn_fence(__ATOMIC_ACQUIRE, "agent");
            xb_add(&bar[XB_XGEN(b.x)], 1u);
            asm volatile("s_waitcnt vmcnt(0)" ::: "memory");
        } else {
            XB_SPIN(xb_ld(&bar[XB_XGEN(b.x)]) == gen, bar);
            __builtin_amdgcn_fence(__ATOMIC_ACQUIRE, "agent");
            asm volatile("s_waitcnt vmcnt(0)" ::: "memory");
        }
    }
    __syncthreads();
}

constexpr int NWAVES = 8;
constexpr int RING_BYTES = 131072;
constexpr int TAB_OFF = RING_BYTES;
constexpr int MISC_OFF = TAB_OFF + 2048;
constexpr int LDS_BYTES = 147456;

struct Args {
    const float* x; const float* c; const float* w_in; const float* conv_w; const float* conv_b; const float* w_mq; const float* w_mk; const float* w_mv;
    const float* gate_bias; const float* g_head; const float* w_out; const float* w_ada; const float* b_ada; const float* w_router; const float* router_bias;
    const float* w_gate_e; const float* w_up_e; const float* w_down_e; const float* g_final;
    float* out; unsigned char* ws; int ph_lo, ph_hi;
};

struct TpItem { const float* src0; long long dsrc; int ldw; int inter; bf16_t* dst; int Kd; };
__device__ __forceinline__ void tp_load(const TpItem& t, float (&v)[32], int lane) {
    const int c = lane & 31;
    const float* p = t.inter ? (t.src0 + ((c & 1) ? t.dsrc : 0ll) + (c >> 1)) : (t.src0 + c);
#pragma unroll
    for (int i = 0; i < 32; ++i) v[i] = p[(size_t)(2 * i + (lane >> 5)) * t.ldw];
}
__device__ __forceinline__ void tp_finish(const TpItem& t, const float (&v)[32], LAS float* scr, int lane) {
#pragma unroll
    for (int i = 0; i < 32; ++i) scr[(2 * i + (lane >> 5)) * 33 + (lane & 31)] = v[i];
    asm volatile("s_waitcnt lgkmcnt(0)" ::: "memory");
    const int c = lane & 7;
#pragma unroll
    for (int j = 0; j < 4; ++j) { const int n = (lane >> 3) + 8 * j; const LAS float* s = scr + (8 * c) * 33 + n;
        u32x4 o; o.x = pk2(s[0 * 33], s[1 * 33]); o.y = pk2(s[2 * 33], s[3 * 33]); o.z = pk2(s[4 * 33], s[5 * 33]); o.w = pk2(s[6 * 33], s[7 * 33]);
        *(u32x4*)(t.dst + (size_t)n * t.Kd + 8 * c) = o; }
    asm volatile("s_waitcnt lgkmcnt(0)" ::: "memory");
}
constexpr int TP_N_DENSE = 2 * (16 * 88 + 16 * 32), TP_N_MOE = 2 * (16 * 16 * 32 + 16 * 8 * 32);
constexpr int TP_TAIL_INPROJ = 8192;
__device__ __forceinline__ TpItem tp_decode(const Args& a, int it, bool moe) {
    constexpr int I_IN = 16 * 88, I_OUT = 16 * 32, I_GU = 16 * 16 * 32, I_D = 16 * 8 * 32;
    TpItem t; t.inter = 0; t.dsrc = 0;
    if (!moe) {
        const int l = it / (I_IN + I_OUT); int r = it % (I_IN + I_OUT);
        if (r < I_IN) { const int kb = r / 88, nb = r % 88, n0 = nb * 32, k0 = kb * 64; const int ns = n0 < 512 ? n0 : n0 + 8;
            t.src0 = a.w_in + (size_t)l * 1024 * DIN + (size_t)k0 * DIN + ns; t.ldw = DIN; t.Kd = 1024; t.dst = (bf16_t*)(a.ws + WS_WIN) + (size_t)l * LDU * 1024 + (size_t)n0 * 1024 + k0; return t; }
        r -= I_IN;
        { const int kb = r / 32, nb = r % 32, n0 = nb * 32, k0 = kb * 64;
            t.src0 = a.w_out + (size_t)l * 1024 * 1024 + (size_t)k0 * 1024 + n0; t.ldw = 1024; t.Kd = 1024; t.dst = (bf16_t*)(a.ws + WS_WOUT) + (size_t)l * 1024 * 1024 + (size_t)n0 * 1024 + k0; return t; }
    }
    const int l = it / (I_GU + I_D); int r = it % (I_GU + I_D);
    if (r < I_GU) { const int e = r / 512, rr = r % 512, kb = rr / 32, nb = rr % 32, n0 = nb * 32, k0 = kb * 64;
        t.src0 = a.w_gate_e + ((size_t)l * 16 + e) * 1024 * 512 + (size_t)k0 * 512 + n0 / 2; t.dsrc = (long long)(((uintptr_t)a.w_up_e - (uintptr_t)a.w_gate_e) / 4); t.inter = 1;
        t.ldw = 512; t.Kd = 1024; t.dst = (bf16_t*)(a.ws + WS_WGU) + ((size_t)l * 16 + e) * 1024 * 1024 + (size_t)n0 * 1024 + k0; return t; }
    r -= I_GU;
    { const int e = r / 256, rr = r % 256, kb = rr / 32, nb = rr % 32, n0 = nb * 32, k0 = kb * 64;
        t.src0 = a.w_down_e + ((size_t)l * 16 + e) * 512 * 1024 + (size_t)k0 * 1024 + n0; t.ldw = 1024; t.Kd = 512; t.dst = (bf16_t*)(a.ws + WS_WD) + ((size_t)l * 16 + e) * 1024 * 512 + (size_t)n0 * 512 + k0; return t; }
}
__device__ __forceinline__ void tp_run(const Args& a, bool moe, int lo, int hi, LAS float* scr, int gw, int ngw) {
    const int lane = lane_id_opaque();
    asm volatile("" : "+s"(gw));
    float va[32], vb[32]; TpItem ta, tb;
    int it = lo + gw;
    if (it < hi) { ta = tp_decode(a, it, moe); tp_load(ta, va, lane); }
#pragma unroll 1
    for (;;) {
        if (it >= hi) break;
        if (it + ngw < hi) { tb = tp_decode(a, it + ngw, moe); tp_load(tb, vb, lane); }
        tp_finish(ta, va, scr, lane);
        it += ngw; if (it >= hi) break;
        if (it + ngw < hi) { ta = tp_decode(a, it + ngw, moe); tp_load(ta, va, lane); }
        tp_finish(tb, vb, scr, lane);
        it += ngw;
    }
}

__device__ __forceinline__ void phase_prologue(const Args& a, LAS unsigned char* lds, int gw, int ngw, int wave_) {
    const int lane = lane_id_opaque(), tid = wave_ * 64 + lane;
    LAS float* cact = (LAS float*)(lds + 98304);
    for (int i = tid; i < 8192; i += NWAVES * 64) { const float cv = a.c[i]; cact[i] = cv * sigmoidf_(cv); }
    __syncthreads();
    float* mod = (float*)(a.ws + WS_MOD);
    for (int it = (gw % NWAVES == 0) ? gw / NWAVES : (ngw / NWAVES) * (gw % NWAVES) + gw / NWAVES; it < 2 * 96; it += ngw) {
        const int l = it / 96, j = (it % 96) * 64 + lane;
        const float* w = a.w_ada + (size_t)l * 1024 * NMOD + j;
        float acc[8];
#pragma unroll
        for (int b = 0; b < 8; ++b) acc[b] = a.b_ada[l * NMOD + j];
#pragma unroll 1
        for (int k = 0; k < 1024; k += 32) {
            float wv[32];
#pragma unroll
            for (int kk = 0; kk < 32; ++kk) wv[kk] = w[(size_t)(k + kk) * NMOD];
#pragma unroll
            for (int b = 0; b < 8; ++b)
#pragma unroll
                for (int k4 = 0; k4 < 32; k4 += 4) { const f32x4 cv = *(const LAS f32x4*)(cact + b * 1024 + k + k4);
                    acc[b] += (cv[0] * wv[k4] + cv[1] * wv[k4 + 1]) + (cv[2] * wv[k4 + 2] + cv[3] * wv[k4 + 3]); }
        }
#pragma unroll
        for (int b = 0; b < 8; ++b) mod[((size_t)l * 8 + b) * NMOD + j] = acc[b];
    }
    { bf16_t* WT = (bf16_t*)(a.ws + WS_MLS + MLS_WT);
      for (int i = gw * 64 + lane; i < 2 * 3 * 4 * 4096; i += ngw * 64) {
          const int d = i & 63, e = (i >> 6) & 63, h = (i >> 12) & 3, w = (i >> 14) % 3, l = i / (3 * 4 * 4096);
          const float* src = (w == 0) ? a.w_mq : (w == 1 ? a.w_mk : a.w_mv);
          const float v = src[((size_t)(l * 4 + h) * 64 + d) * 64 + e];
          WT[i] = f2bf(w == 1 ? v * 0.125f : v); } }
    tp_run(a, false, 0, TP_N_DENSE, (LAS float*)(lds + (tid >> 6) * 8704), gw, ngw);
    tp_run(a, true, TP_TAIL_INPROJ, TP_N_MOE / 2, (LAS float*)(lds + (tid >> 6) * 8704), gw, ngw);
}

__device__ __forceinline__ void tp_tail(const Args& a, int nunits, int G, int lo, int hi, LAS unsigned char* lds, int wave_) {
    const int rem = nunits % G;
    if ((int)blockIdx.x < rem || lo >= hi) return;
    tp_run(a, true, lo, hi, (LAS float*)(lds + wave_ * 8704), ((int)blockIdx.x - rem) * NWAVES + wave_, (G - rem) * NWAVES);
}
template <int HALF, int OFF, int N> __device__ __forceinline__ void reduce_tr_step(float (&v)[N], int lane) {
    const bool up = (lane & OFF) != 0;
#pragma unroll
    for (int i = 0; i < HALF; ++i) { const float snd = up ? v[i] : v[i + HALF], kep = up ? v[i + HALF] : v[i]; v[i] = kep + bperm_f(snd, lane ^ OFF); }
}
template <int N> __device__ __forceinline__ float reduce_tr(float (&v)[N], int lane);
template <> __device__ __forceinline__ float reduce_tr<16>(float (&v)[16], int lane) {
    reduce_tr_step<8, 32>(v, lane); reduce_tr_step<4, 16>(v, lane); reduce_tr_step<2, 8>(v, lane); reduce_tr_step<1, 4>(v, lane);
    float r = v[0]; r += bperm_f(r, lane ^ 2); r += bperm_f(r, lane ^ 1); return r; }
template <> __device__ __forceinline__ float reduce_tr<8>(float (&v)[8], int lane) {
    reduce_tr_step<4, 32>(v, lane); reduce_tr_step<2, 16>(v, lane); reduce_tr_step<1, 8>(v, lane);
    float r = v[0]; r += bperm_f(r, lane ^ 4); r += bperm_f(r, lane ^ 2); r += bperm_f(r, lane ^ 1); return r; }
template <int MODE, bool XBF>
__device__ __forceinline__ void phase_norm(const Args& a, int l, const void* xin, LAS unsigned char* lds, int gw, int ngw, int wave_) {
    const int lane = lane_id_opaque(), tid = wave_ * 64 + lane;
    constexpr int NC = (MODE == 1) ? 8 : 16;
    LAS float* wl = (LAS float*)lds;
    LAS int* hist = (LAS int*)(lds + 65536); LAS int* basek = hist + 32; LAS int* rowinfo = hist + 64;
    const int lc = l; l &= 1;
    const float* modl = (const float*)(a.ws + WS_MOD) + (size_t)l * 8 * NMOD;
    const int shift_off = (MODE == 1) ? 0 : 3072, scale_off = (MODE == 1) ? 1024 : 4096;
    if (MODE == 1) { const float* W = a.w_in + (size_t)l * 1024 * DIN + 512; for (int i = tid; i < 1024 * 8; i += NWAVES * 64) wl[(i & 7) * 1024 + (i >> 3)] = W[(size_t)(i >> 3) * DIN + (i & 7)]; }
    else { for (int i = tid; i < 1024 * 16; i += NWAVES * 64) wl[(i & 15) * 1024 + (i >> 4)] = a.w_router[i]; if (tid < 32) hist[tid] = 0; }
    __syncthreads();
    bf16_t* H = (bf16_t*)(a.ws + WS_H);
    float* gate = (float*)(a.ws + WS_GATE); float* rw = (float*)(a.ws + WS_RW); int* list = (int*)(a.ws + WS_LIST);
    int* cnt = (int*)(a.ws + WS_CTL) + CW_CNT + lc * 32;
    const int rows_per = (T_TOK + ngw - 1) / ngw;
    const int row0 = gw * rows_per;
    f32x4 msc[4], msh[4];
    { const int b = row0 / SEQ;
#pragma unroll
      for (int j = 0; j < 4; ++j) { const int k0 = XBF ? (8 * lane + 512 * (j >> 1) + 4 * (j & 1)) : (4 * lane + 256 * j); msc[j] = *(const f32x4*)(modl + (size_t)b * NMOD + scale_off + k0); msh[j] = *(const f32x4*)(modl + (size_t)b * NMOD + shift_off + k0);
#pragma unroll
          for (int q = 0; q < 4; ++q) msc[j][q] += 1.f; } }
    f32x4 nx0[4], nx1[4];
#define NORM_LOAD(T0, LN) do { \
        if (XBF) { _Pragma("unroll") for (int jj = 0; jj < 2; ++jj) { const u32x4 q0 = *((const u32x4*)((const bf16_t*)xin + (size_t)(T0) * DM) + (LN) + 64 * jj), q1 = *((const u32x4*)((const bf16_t*)xin + (size_t)((T0) + 1) * DM) + (LN) + 64 * jj); \
                nx0[2 * jj] = bf4_lo(q0); nx0[2 * jj + 1] = bf4_hi(q0); nx1[2 * jj] = bf4_lo(q1); nx1[2 * jj + 1] = bf4_hi(q1); } } \
        else { _Pragma("unroll") for (int j = 0; j < 4; ++j) { nx0[j] = *((const f32x4*)((const float*)xin + (size_t)(T0) * DM) + (LN) + 64 * j); nx1[j] = *((const f32x4*)((const float*)xin + (size_t)((T0) + 1) * DM) + (LN) + 64 * j); } } } while (0)
    NORM_LOAD(row0, lane);
#pragma unroll 1
    for (int i = 0; i < rows_per; i += 2) {
        const int lane = lane_id_opaque();
        const int t0 = row0 + i; if (t0 >= T_TOK) break;
        constexpr bool has1 = true; const int t1 = t0 + 1;
        f32x4 v0[4], v1[4]; float ss0 = 0.f, ss1 = 0.f;
#pragma unroll
        for (int j = 0; j < 4; ++j) { v0[j] = nx0[j]; v1[j] = nx1[j]; }
        { const int tn = (i + 2 < rows_per) ? t0 + 2 : t0;
          NORM_LOAD(tn, lane); }
#pragma unroll
        for (int j = 0; j < 4; ++j) { ss0 += (v0[j][0] * v0[j][0] + v0[j][1] * v0[j][1]) + (v0[j][2] * v0[j][2] + v0[j][3] * v0[j][3]); ss1 += (v1[j][0] * v1[j][0] + v1[j][1] * v1[j][1]) + (v1[j][2] * v1[j][2] + v1[j][3] * v1[j][3]); }
#pragma unroll
        for (int o = 32; o > 0; o >>= 1) { ss0 += bperm_f(ss0, lane ^ o); ss1 += bperm_f(ss1, lane ^ o); }
        const float rs0 = rsqrtf(ss0 * (1.f / 1024.f) + EPS), rs1 = rsqrtf(ss1 * (1.f / 1024.f) + EPS);
        float lg0[NC], lg1[NC];
#pragma unroll
        for (int e = 0; e < NC; ++e) { lg0[e] = 0.f; lg1[e] = 0.f; }
#pragma unroll
        for (int j = 0; j < 4; ++j) {
            const int k0 = XBF ? (8 * lane + 512 * (j >> 1) + 4 * (j & 1)) : (4 * lane + 256 * j);
            f32x4 h0, h1;
#pragma unroll
            for (int q = 0; q < 4; ++q) { h0[q] = v0[j][q] * rs0 * msc[j][q] + msh[j][q]; h1[q] = v1[j][q] * rs1 * msc[j][q] + msh[j][q]; }
            u32x2 o0; o0.x = pk2(h0[0], h0[1]); o0.y = pk2(h0[2], h0[3]); *(u32x2*)(H + (size_t)t0 * DM + k0) = o0;
            if (has1) { u32x2 o1; o1.x = pk2(h1[0], h1[1]); o1.y = pk2(h1[2], h1[3]); *(u32x2*)(H + (size_t)t1 * DM + k0) = o1; }
#pragma unroll
            for (int e8 = 0; e8 < NC; e8 += 8) {
#pragma unroll
                for (int e = e8; e < e8 + 8; ++e) { const f32x4 w = *(const LAS f32x4*)(wl + e * 1024 + k0);
                    lg0[e] += (h0[0] * w[0] + h0[1] * w[1]) + (h0[2] * w[2] + h0[3] * w[3]); lg1[e] += (h1[0] * w[0] + h1[1] * w[1]) + (h1[2] * w[2] + h1[3] * w[3]); }
                __builtin_amdgcn_sched_barrier(0);
            }
        }
        const float r0 = reduce_tr<NC>(lg0, lane), r1 = reduce_tr<NC>(lg1, lane);
        if (MODE == 1) {
            if ((lane & 7) == 0) { gate[(size_t)t0 * 8 + (lane >> 3)] = r0; if (has1) gate[(size_t)t1 * 8 + (lane >> 3)] = r1; }
        } else {
#pragma unroll
            for (int rr = 0; rr < 2; ++rr) {
                if (rr == 1 && !has1) break;
                const float rv = rr ? r1 : r0; const int t = rr ? t1 : t0;
                float sc[16], bs[16];
#pragma unroll
                for (int e = 0; e < 16; ++e) { const float lgt = __int_as_float(__builtin_amdgcn_readlane(__float_as_int(rv), 4 * e)); sc[e] = sigmoidf_(lgt); bs[e] = sc[e] + a.router_bias[e]; }
                float best_gs = -1e30f; int bk = 0; float bw0 = 0.f, bw1 = 0.f;
#pragma unroll
                for (int g = 0; g < 4; ++g) {
                    int i0 = 0; float q0 = bs[4 * g]; float s0 = sc[4 * g];
#pragma unroll
                    for (int j = 1; j < 4; ++j) if (bs[4 * g + j] > q0) { q0 = bs[4 * g + j]; i0 = j; s0 = sc[4 * g + j]; }
                    int i1 = -1; float q1 = -1e30f; float s1 = 0.f;
#pragma unroll
                    for (int j = 0; j < 4; ++j) if (j != i0 && bs[4 * g + j] > q1) { q1 = bs[4 * g + j]; i1 = j; s1 = sc[4 * g + j]; }
                    const float gs = q0 + q1;
                    if (gs > best_gs) { best_gs = gs;
                        const int lo = i0 < i1 ? i0 : i1, hi = i0 < i1 ? i1 : i0; const float wlo = i0 < i1 ? s0 : s1, whi = i0 < i1 ? s1 : s0;
                        const int pq = (lo == 0) ? (hi - 1) : (lo == 1 ? hi + 1 : 5);
                        bk = 6 * g + pq; bw0 = wlo; bw1 = whi; }
                }
                if (lane == 0) {
                    const float inv = 1.f / (bw0 + bw1);
                    *(f32x2*)(rw + (size_t)t * 2) = (f32x2){bw0 * inv, bw1 * inv};
                    const int pos = __hip_atomic_fetch_add(&hist[bk], 1, __ATOMIC_RELAXED, __HIP_MEMORY_SCOPE_WORKGROUP);
                    rowinfo[t - (int)blockIdx.x * (NWAVES * rows_per)] = bk | (pos << 8);
                }
            }
        }
    }
#undef NORM_LOAD
    if (MODE == 2) {
        __syncthreads();
        if (tid < NBUCK) { const int n = hist[tid]; basek[tid] = n ? atomicAdd(&cnt[tid], n) : 0; }
        __syncthreads();
        const int nrows = NWAVES * rows_per, brow0 = (int)blockIdx.x * nrows;
        for (int i = tid; i < nrows; i += NWAVES * 64) { const int t = brow0 + i; if (t < T_TOK) { const int ri = rowinfo[i]; const int k = ri & 255; list[(size_t)k * T_TOK + basek[k] + (ri >> 8)] = t; } }
    }
}

__device__ __forceinline__ void build_moe_tab(const Args& a, int l, LAS int* tab, int wave_) {
    const int tid = wave_ * 64 + lane_id_opaque();
    const int* cnt = (const int*)(a.ws + WS_CTL) + CW_CNT + l * 32;
    if (tid < 32) tab[tid] = (tid < NBUCK) ? cnt[tid] : 0;
    __syncthreads();
    if (tid < NBUCK) {
        int base = 0;
#pragma unroll 1
        for (int j = 0; j < tid; ++j) base += (tab[j] + 255) >> 8;
        const int mine = (tab[tid] + 255) >> 8;
#pragma unroll 1
        for (int i = 0; i < mine; ++i) { tab[32 + base + i] = tid; tab[192 + base + i] = i * 256; }
        if (tid == NBUCK - 1) tab[352] = base + mine;
    }
    __syncthreads();
}

__device__ __forceinline__ void phase_final(const Args& a, int gw, int ngw, float oscale, const XcdBarrier& bar, int wave_) {
    const int lane = lane_id_opaque();
    const bf16_t* XB = (const bf16_t*)a.out;
    const int row0 = gw * 16;
    u32x4 xv[16][2];
#pragma unroll
    for (int i = 0; i < 16; ++i)
#pragma unroll
        for (int jj = 0; jj < 2; ++jj) xv[i][jj] = *((const u32x4*)(XB + (size_t)(row0 + i) * DM) + lane + 64 * jj);
    xcd_barrier(bar, wave_);
    f32x4 g[4];
#pragma unroll
    for (int j = 0; j < 4; ++j) g[j] = *(const f32x4*)(a.g_final + 8 * lane + 512 * (j >> 1) + 4 * (j & 1));
#pragma unroll
    for (int i = 0; i < 16; ++i) {
        const f32x4 v[4] = {bf4_lo(xv[i][0]), bf4_hi(xv[i][0]), bf4_lo(xv[i][1]), bf4_hi(xv[i][1])};
        float ss = 0.f;
#pragma unroll
        for (int j = 0; j < 4; ++j) ss += (v[j][0] * v[j][0] + v[j][1] * v[j][1]) + (v[j][2] * v[j][2] + v[j][3] * v[j][3]);
        ss = wave_sum_l(ss, lane);
        const float rstd = rsqrtf(ss * (1.f / 1024.f) + EPS) * oscale;
        float* orow = a.out + (size_t)(row0 + i) * DM;
#pragma unroll
        for (int j = 0; j < 4; ++j) *(f32x4*)(orow + 8 * lane + 512 * (j >> 1) + 4 * (j & 1)) = v[j] * rstd * g[j];
    }
}

typedef float f32x16 __attribute__((ext_vector_type(16)));
typedef short s16x4 __attribute__((ext_vector_type(4)));
typedef short v4i16_t __attribute__((ext_vector_type(4)));
#define MFMA32(a, b, c) __builtin_amdgcn_mfma_f32_32x32x16_bf16((a), (b), (c), 0, 0, 0)
__device__ __forceinline__ int crow(int i, int h) { return (i & 3) + 8 * (i >> 2) + 4 * h; }
__device__ __forceinline__ unsigned cvtpk(float lo, float hi) { typedef float f2_t __attribute__((ext_vector_type(2))); typedef __bf16 b2_t __attribute__((ext_vector_type(2)));
    f2_t v = {lo, hi}; b2_t b = __builtin_convertvector(v, b2_t); return __builtin_bit_cast(unsigned, b); }
__device__ __forceinline__ bf16x8 pack8(const f32x16& x, int s) { u32x4 p; p.x = cvtpk(x[8 * s], x[8 * s + 1]); p.y = cvtpk(x[8 * s + 2], x[8 * s + 3]); p.z = cvtpk(x[8 * s + 4], x[8 * s + 5]); p.w = cvtpk(x[8 * s + 6], x[8 * s + 7]); return __builtin_bit_cast(bf16x8, p); }
__device__ __forceinline__ void halves(float v, float& v0, float& v1) { auto rr = __builtin_amdgcn_permlane32_swap(__float_as_uint(v), __float_as_uint(v), false, false); v0 = __uint_as_float(rr[0]); v1 = __uint_as_float(rr[1]); }
__device__ __forceinline__ s16x4 vtr(const LAS unsigned char* p) { return __builtin_bit_cast(s16x4, __builtin_amdgcn_ds_read_tr16_b64_v4i16((LAS v4i16_t*)p)); }
constexpr int VP = 144;
__device__ __forceinline__ bf16x8 vt_frag(const LAS unsigned char* vl, int vtr0, int s, int db) {
    const s16x4 lo = vtr(vl + vtr0 + s * (16 * VP) + db * 64), hi = vtr(vl + vtr0 + s * (16 * VP) + 8 * VP + db * 64);
    return __builtin_shufflevector(lo, hi, 0, 1, 2, 3, 4, 5, 6, 7); }

#define KT_WRITE(KL, KV) do { _Pragma("unroll") for (int i = 0; i < 4; ++i) *(LAS u32x4*)((KL) + (vrow + 8 * i) * 144 + vseg * 16) = KV[i]; } while (0)
#define KT_FRAG(KL, D0) (*(const LAS bf16x8*)((KL) + r * 144 + 32 * (D0) + 16 * hh))
#ifndef SB_EARLY_EXIT
#define SB_EARLY_EXIT 1
#endif
__device__ __forceinline__ void sb_item(const bf16_t* U, const float* gh  , bf16_t* Y, LAS unsigned char* vl, int b, int h, int qt, int lane) {
    const int r = lane & 31, hh = lane >> 5;
    const size_t rowb = (size_t)b * SEQ;
    const bf16_t* Qp = U + (rowb + 32 * qt + r) * LDU + OFF_SB + h * 64 + 8 * hh;
    bf16x8 qf[4];
#pragma unroll
    for (int d0 = 0; d0 < 4; ++d0) qf[d0] = *(const bf16x8*)(Qp + 16 * d0);
    f32x16 o0, o1;
#pragma unroll
    for (int i = 0; i < 16; ++i) { o0[i] = 0.f; o1[i] = 0.f; }
    float carry = 1.f;
    f32x4 gha[4], ghb[4];
#pragma unroll
    for (int g = 0; g < 4; ++g) { gha[g] = *(const f32x4*)(gh + 8 * g + 4 * hh); ghb[g] = *(const f32x4*)(gh + 32 + 8 * g + 4 * hh); }
    const bf16_t* Kb = U + rowb * LDU + OFF_SB + 384 + h * 64; const bf16_t* Vb = Kb + 384;
    const int vrow = lane >> 3, vseg = lane & 7;
    const int i16 = lane & 15, q4 = i16 >> 2, p4 = i16 & 3, blk = (lane >> 4) & 1;
    const int vtr0 = (4 * hh + q4) * VP + (16 * blk + 4 * p4) * 2;
    unsigned loff[4];
#pragma unroll
    for (int i = 0; i < 4; ++i) loff[i] = (unsigned)((vrow + 8 * i) * LDU + 8 * vseg) * 2u;
#define SB_LOAD(KT, KF, VV) do { const char* kb_ = (const char*)(Kb + (size_t)(32 * (KT)) * LDU); \
        _Pragma("unroll") for (int i = 0; i < 4; ++i) { KF[i] = *(const u32x4*)(kb_ + loff[i]); VV[i] = *(const u32x4*)(kb_ + 768 + loff[i]); } } while (0)
#define SB_TILE(KT, KF, VV) do { \
        KT_WRITE(kl, KF); \
        _Pragma("unroll") for (int i = 0; i < 4; ++i) *(LAS u32x4*)(vl + (vrow + 8 * i) * VP + vseg * 16) = VV[i]; \
        f32x16 sc; \
        _Pragma("unroll") for (int i = 0; i < 16; ++i) sc[i] = 0.f; \
        _Pragma("unroll") for (int d0 = 0; d0 < 4; ++d0) sc = MFMA32(KT_FRAG(kl, d0), qf[d0], sc); \
        float sg[16], kp[16]; \
        _Pragma("unroll") for (int i = 0; i < 16; ++i) { \
            const float z2 = fminf(sc[i] * (-0.125f * 1.4426950408889634f), 115.f); \
            const float e = __builtin_amdgcn_exp2f(z2); float sig = __builtin_amdgcn_rcpf(1.f + e); float keep = e * sig; \
            if ((KT) == qt) { const bool valid = crow(i, hh) < r; sig = valid ? sig : 0.f; keep = valid ? keep : 1.f; } \
            sg[i] = sig; kp[i] = keep; } \
        float G0[4], G1[4], PP[4]; \
        _Pragma("unroll") for (int g = 0; g < 4; ++g) { const float G = (kp[4 * g] * kp[4 * g + 1]) * (kp[4 * g + 2] * kp[4 * g + 3]); halves(G, G0[g], G1[g]); PP[g] = G0[g] * G1[g]; } \
        float SP[4]; SP[3] = 1.f; SP[2] = PP[3]; SP[1] = PP[3] * PP[2]; SP[0] = SP[1] * PP[1]; \
        const float total = SP[0] * PP[0]; \
        _Pragma("unroll") for (int g = 0; g < 4; ++g) { \
            const float r3 = carry * SP[g] * (hh ? 1.f : G1[g]); \
            const float r2 = r3 * kp[4 * g + 3], r1 = r2 * kp[4 * g + 2], r0 = r1 * kp[4 * g + 1]; \
            sc[4 * g + 3] = sg[4 * g + 3] * r3; sc[4 * g + 2] = sg[4 * g + 2] * r2; sc[4 * g + 1] = sg[4 * g + 1] * r1; sc[4 * g] = sg[4 * g] * r0; } \
        carry *= total; \
        const bf16x8 pb0 = pack8(sc, 0), pb1 = pack8(sc, 1); \
        o0 = MFMA32(vt_frag(vl, vtr0, 0, 0), pb0, o0); o0 = MFMA32(vt_frag(vl, vtr0, 1, 0), pb1, o0); \
        o1 = MFMA32(vt_frag(vl, vtr0, 0, 1), pb0, o1); o1 = MFMA32(vt_frag(vl, vtr0, 1, 1), pb1, o1); } while (0)
#define SB_DONE() (SB_EARLY_EXIT && __builtin_amdgcn_ballot_w64(carry >= 1e-37f) == 0ull)
    {
        u32x4 kA[4], kB[4], vA[4], vB[4];
        LAS unsigned char* kl = vl + 4608;
        int kt = qt;
        SB_LOAD(kt, kA, vA);
#pragma unroll 1
        for (;;) {
            if (kt > 0) SB_LOAD(kt - 1, kB, vB);
            SB_TILE(kt, kA, vA);
            if (kt == 0 || SB_DONE()) break;
            --kt;
            if (kt > 0) SB_LOAD(kt - 1, kA, vA);
            SB_TILE(kt, kB, vB);
            if (kt == 0 || SB_DONE()) break;
            --kt;
        }
    }
#undef SB_LOAD
#undef SB_TILE
#undef SB_DONE
    float ss = 0.f;
#pragma unroll
    for (int i = 0; i < 16; ++i) ss += o0[i] * o0[i] + o1[i] * o1[i];
    float s0, s1; halves(ss, s0, s1);
    const float rs = rsqrtf((s0 + s1) * (1.f / 64.f) + EPS);
    bf16_t* yr = Y + (rowb + 32 * qt + r) * 1024 + (10 + h) * 64;
#pragma unroll
    for (int g = 0; g < 4; ++g) {
        const int d0 = 8 * g + 4 * hh;
        const f32x4 ga = gha[g], gb = ghb[g];
        u32x2 wa, wb; wa.x = cvtpk(o0[4 * g] * rs * ga[0], o0[4 * g + 1] * rs * ga[1]); wa.y = cvtpk(o0[4 * g + 2] * rs * ga[2], o0[4 * g + 3] * rs * ga[3]);
        wb.x = cvtpk(o1[4 * g] * rs * gb[0], o1[4 * g + 1] * rs * gb[1]); wb.y = cvtpk(o1[4 * g + 2] * rs * gb[2], o1[4 * g + 3] * rs * gb[3]);
        *(u32x2*)(yr + d0) = wa; *(u32x2*)(yr + 32 + d0) = wb;
    }
}
__device__ __forceinline__ void phase_sb(const Args& a, int l, LAS unsigned char* lds, int gw, int ngw, int wave_) {
    const int lane = lane_id_opaque();
    LAS unsigned char* vl = lds + wave_ * 16384;
    const bf16_t* U = (const bf16_t*)(a.ws + WS_U); bf16_t* Y = (bf16_t*)(a.ws + WS_Y);
    for (int it = gw; it < NB * 6 * 128; it += ngw) {
        const int qt = 127 - (it % 128), h = (it / 128) % 6, b = it / 768;
        sb_item(U, a.g_head + l * 1024 + (10 + h) * 64, Y, vl, b, h, qt, lane);
    }
}


#ifdef TS_DIL
#define TSD(k) do { if (tsacc) { const unsigned long long t_ = __builtin_amdgcn_s_memrealtime(); if (TS_DIL == (k)) *tsacc += t_ - tsd_; tsd_ = t_; } } while (0)
#else
#define TSD(k) do { } while (0)
#endif
__device__ __forceinline__ void dil_item(const bf16_t* U, bf16_t* OP, int op_pitch, float* LSE, LAS unsigned char* vl, int b, int h, int p, int qi, int lane, unsigned long long* tsacc) {
#ifdef TS_DIL
    unsigned long long tsd_ = __builtin_amdgcn_s_memrealtime();
#endif
    const int r = lane & 31, hh = lane >> 5;
    const int sh = 2 * p, d = 1 << sh, nblk = (SEQ >> sh) / 32, c = qi / nblk, m0 = 32 * (qi % nblk);
    const size_t rowb = (size_t)b * SEQ;
    const int tq = ((m0 + r) << sh) + c;
    const bf16_t* Qp = U + (rowb + tq) * LDU + OFF_DIL + h * 64 + 8 * hh;
    bf16x8 qf[4];
#pragma unroll
    for (int d0 = 0; d0 < 4; ++d0) qf[d0] = *(const bf16x8*)(Qp + 16 * d0);
    const float sb = exp2f(-8.f * (float)(h + 1) / 6.f) * (float)d * 1.4426950408889634f;
    f32x16 o0, o1;
#pragma unroll
    for (int i = 0; i < 16; ++i) { o0[i] = 0.f; o1[i] = 0.f; }
    float m_run = -1e30f, l_run = 0.f;
    const bf16_t* Kb = U + rowb * LDU + OFF_DIL + 384 + h * 64; const bf16_t* Vb = Kb + 384;
    const int vrow = lane >> 3, vseg = lane & 7;
    const int i16 = lane & 15, q4 = i16 >> 2, p4 = i16 & 3, blk = (lane >> 4) & 1;
    const int vtr0 = (4 * hh + q4) * VP + (16 * blk + 4 * p4) * 2;
    unsigned loff[4];
#pragma unroll
    for (int i = 0; i < 4; ++i) loff[i] = (unsigned)(((vrow + 8 * i) << sh) * LDU + 8 * vseg) * 2u;
#define DL_LOAD(J, KF, VV) do { const int mk0_ = m0 - 128 + 32 * (J); const char* kb_ = (const char*)(Kb + (size_t)((mk0_ << sh) + c) * LDU); \
        _Pragma("unroll") for (int i = 0; i < 4; ++i) { KF[i] = *(const u32x4*)(kb_ + loff[i]); VV[i] = *(const u32x4*)(kb_ + 768 + loff[i]); } } while (0)
#define DL_TILE(J, KF, VV) do { \
        KT_WRITE(kl, KF); \
        _Pragma("unroll") for (int i = 0; i < 4; ++i) *(LAS u32x4*)(vl + (vrow + 8 * i) * VP + vseg * 16) = VV[i]; \
        f32x16 sc; \
        _Pragma("unroll") for (int i = 0; i < 16; ++i) sc[i] = 0.f; \
        _Pragma("unroll") for (int d0 = 0; d0 < 4; ++d0) sc = MFMA32(KT_FRAG(kl, d0), qf[d0], sc); \
        float mx = -1e30f; \
        const float base2 = -sb * (float)(r + 128 - 32 * (J) - 4 * hh); \
        _Pragma("unroll") for (int i = 0; i < 16; ++i) { \
            const int cr = crow(i, hh); \
            float v = fmaf(sb, (float)((i & 3) + 8 * (i >> 2)), fmaf(sc[i], 0.125f * 1.4426950408889634f, base2)); \
            if ((J) == 4) v = (cr <= r) ? v : -1e30f; \
            if ((J) == 0) v = (cr >= r) ? v : -1e30f; \
            sc[i] = v; mx = fmaxf(mx, v); } \
        float mx0, mx1; halves(mx, mx0, mx1); \
        const float m_new = fmaxf(m_run, fmaxf(mx0, mx1)); \
        const float corr = __builtin_amdgcn_exp2f(m_run - m_new); \
        float ps = 0.f; \
        _Pragma("unroll") for (int i = 0; i < 16; ++i) { const float pe = __builtin_amdgcn_exp2f(sc[i] - m_new); sc[i] = pe; ps += pe; } \
        float ps0, ps1; halves(ps, ps0, ps1); \
        l_run = l_run * corr + (ps0 + ps1); \
        if (__builtin_amdgcn_ballot_w64(m_new != m_run) != 0ull) { _Pragma("unroll") for (int i = 0; i < 16; ++i) { o0[i] *= corr; o1[i] *= corr; } } \
        m_run = m_new; \
        const bf16x8 pb0 = pack8(sc, 0), pb1 = pack8(sc, 1); \
        o0 = MFMA32(vt_frag(vl, vtr0, 0, 0), pb0, o0); o0 = MFMA32(vt_frag(vl, vtr0, 1, 0), pb1, o0); \
        o1 = MFMA32(vt_frag(vl, vtr0, 0, 1), pb0, o1); o1 = MFMA32(vt_frag(vl, vtr0, 1, 1), pb1, o1); } while (0)
    {
        TSD(0);
        const int jmin = (m0 >= 128) ? 0 : (4 - m0 / 32);
        u32x4 kA[4], kB[4], vA[4], vB[4];
        LAS unsigned char* kl = vl + 4608;
        int j = 4;
        DL_LOAD(j, kA, vA);
#pragma unroll 1
        for (;;) {
            if (j > jmin) DL_LOAD(j - 1, kB, vB);
            DL_TILE(j, kA, vA);
            if (j == jmin) break;
            --j;
            if (j > jmin) DL_LOAD(j - 1, kA, vA);
            DL_TILE(j, kB, vB);
            if (j == jmin) break;
            --j;
        }
    }
#undef DL_LOAD
#undef DL_TILE
    TSD(1);
    const float inv = 1.f / l_run;
    bf16_t* orow = OP + (rowb + tq) * op_pitch + h * 64;
#pragma unroll
    for (int g = 0; g < 4; ++g) {
        const int d0 = 8 * g + 4 * hh;
        u32x2 wa, wb; wa.x = cvtpk(o0[4 * g] * inv, o0[4 * g + 1] * inv); wa.y = cvtpk(o0[4 * g + 2] * inv, o0[4 * g + 3] * inv);
        wb.x = cvtpk(o1[4 * g] * inv, o1[4 * g + 1] * inv); wb.y = cvtpk(o1[4 * g + 2] * inv, o1[4 * g + 3] * inv);
        *(u32x2*)(orow + d0) = wa; *(u32x2*)(orow + 32 + d0) = wb;
    }
    if (hh == 0) LSE[(rowb + tq) * 6 + h] = m_run * 0.6931471805599453f + __logf(l_run);
    TSD(2);
}
__device__ __forceinline__ bf16_t* dil_op(unsigned char* ws, int p) { return (p == 0) ? (bf16_t*)(ws + WS_Y) + 256 : ((p == 1) ? (bf16_t*)(ws + WS_OP1) : (bf16_t*)(ws + WS_OP2)); }
__device__ __forceinline__ int dil_pitch(int p) { return p == 0 ? 1024 : 384; }
__device__ __forceinline__ void phase_dil(const Args& a, int l, LAS unsigned char* lds, int gw, int ngw, int wave_, int p_lo, int p_hi) {
    const int lane = lane_id_opaque();
    LAS unsigned char* vl = lds + wave_ * 16384;
    const bf16_t* U = (const bf16_t*)(a.ws + WS_U);
    for (int it = gw; it < (p_hi - p_lo) * NB * 6 * 128; it += ngw) {
        const int qi = it % 128, h = (it / 128) % 6, b = (it / 768) % NB, p = p_lo + it / (768 * NB);
        dil_item(U, dil_op(a.ws, p), dil_pitch(p), (float*)(a.ws + WS_LSE) + (size_t)p * T_TOK * 6, vl, b, h, p, qi, lane,
#ifdef TS_DIL
                 (gw == 77 && lane == 0 && l == 0) ? (unsigned long long*)((unsigned*)(a.ws + WS_CTL) + 12288) + 40 : nullptr
#else
                 nullptr
#endif
                 );
    }
}
__device__ __forceinline__ void phase_dil_merge(const Args& a, int l, int gw, int ngw) {
    const int lane = lane_id_opaque(); const int pr = lane >> 3, ch = lane & 7;
    const bf16_t* O0 = dil_op(a.ws, 0); const bf16_t* O1 = dil_op(a.ws, 1); const bf16_t* O2 = dil_op(a.ws, 2);
    const float* L0 = (const float*)(a.ws + WS_LSE); const float* L1 = L0 + (size_t)T_TOK * 6; const float* L2 = L1 + (size_t)T_TOK * 6;
    bf16_t* Y = (bf16_t*)(a.ws + WS_Y);
    for (int it = gw; it < T_TOK * 6 / 8; it += ngw) {
        const int pi = it * 8 + pr; const int t = pi / 6, hd = pi - 6 * t;
        const float l0 = L0[pi], l1 = L1[pi], l2 = L2[pi];
        const size_t o = (size_t)t * 384 + hd * 64 + ch * 8;
        const u32x4 a0 = *(const u32x4*)(O0 + (size_t)t * 1024 + hd * 64 + ch * 8), a1 = *(const u32x4*)(O1 + o), a2 = *(const u32x4*)(O2 + o);
        const float mx = fmaxf(l0, fmaxf(l1, l2));
        float w0 = __expf(l0 - mx), w1 = __expf(l1 - mx), w2 = __expf(l2 - mx); const float inv = 1.f / (w0 + w1 + w2); w0 *= inv; w1 *= inv; w2 *= inv;
        float v[8]; float ss = 0.f;
#pragma unroll
        for (int q = 0; q < 4; ++q) {
            v[2 * q]     = w0 * __uint_as_float(a0[q] << 16) + w1 * __uint_as_float(a1[q] << 16) + w2 * __uint_as_float(a2[q] << 16);
            v[2 * q + 1] = w0 * __uint_as_float(a0[q] & 0xffff0000u) + w1 * __uint_as_float(a1[q] & 0xffff0000u) + w2 * __uint_as_float(a2[q] & 0xffff0000u);
            ss += v[2 * q] * v[2 * q] + v[2 * q + 1] * v[2 * q + 1];
        }
#pragma unroll
        for (int of = 1; of < 8; of <<= 1) ss += bperm_f(ss, lane ^ of);
        const float rs = rsqrtf(ss * (1.f / 64.f) + EPS);
        const float* gh = a.g_head + l * 1024 + (4 + hd) * 64 + ch * 8;
        const f32x4 ga = *(const f32x4*)gh, gb = *(const f32x4*)(gh + 4);
        u32x4 w; w.x = cvtpk(v[0] * rs * ga[0], v[1] * rs * ga[1]); w.y = cvtpk(v[2] * rs * ga[2], v[3] * rs * ga[3]); w.z = cvtpk(v[4] * rs * gb[0], v[5] * rs * gb[1]); w.w = cvtpk(v[6] * rs * gb[2], v[7] * rs * gb[3]);
        *(u32x4*)(Y + (size_t)t * 1024 + (4 + hd) * 64 + ch * 8) = w;
    }
}

__device__ __forceinline__ float scan_add64(float v, int lane) {
#pragma unroll
    for (int o = 1; o < 64; o <<= 1) { const float t = bperm_f(v, lane - o); v = (lane >= o) ? v + t : v; }
    return v; }
__device__ __forceinline__ float scan_max64(float v, int lane) {
#pragma unroll
    for (int o = 1; o < 64; o <<= 1) { const float t = bperm_f(v, lane - o); v = (lane >= o) ? fmaxf(v, t) : v; }
    return v; }
__device__ __forceinline__ float bcast63(float v) { return __int_as_float(__builtin_amdgcn_readlane(__float_as_int(v), 63)); }

__device__ __forceinline__ void ml_b1_item(const Args& a, int l, LAS unsigned char* wl  , int b, int h, int c, int half) {
    const int bh = b * 4 + h;
    const size_t rowb = (size_t)b * SEQ + 128 * c;
    unsigned char* mls = a.ws + WS_MLS;
    LAS float* cw = (LAS float*)(wl + 9216);
    float w0, w1;
    const bf16_t* U = (const bf16_t*)(a.ws + WS_U);
    bf16_t* Qm = (bf16_t*)(a.ws + WS_QKV); bf16_t* Km = Qm + (size_t)T_TOK * 256; bf16_t* Vm = Km + (size_t)T_TOK * 256;
    { const int lane = lane_id_opaque();
    const float* GATE = (const float*)(a.ws + WS_GATE);
    const float gbi = a.gate_bias[l * 8 + h], gbf = a.gate_bias[l * 8 + 4 + h];
    const size_t t0 = rowb + lane, t1 = t0 + 64;
    const float ig0 = GATE[t0 * 8 + h] + gbi, ig1 = GATE[t1 * 8 + h] + gbi;
    const float lf0 = -softplusf_(-(GATE[t0 * 8 + 4 + h] + gbf)), lf1 = -softplusf_(-(GATE[t1 * 8 + 4 + h] + gbf));
    const float c0 = scan_add64(lf0, lane); const float c1 = scan_add64(lf1, lane) + bcast63(c0);
    const float a0 = ig0 - c0, a1 = ig1 - c1;
    const float p0 = scan_max64(a0, lane); const float p1 = fmaxf(scan_max64(a1, lane), bcast63(p0));
    const float Amax = bcast63(p1), Lsum = bcast63(c1);
    if (half == 0) {
    ((float*)(mls + MLS_CUM))[t0 * 4 + h] = c0; ((float*)(mls + MLS_CUM))[t1 * 4 + h] = c1;
    ((float*)(mls + MLS_AA))[t0 * 4 + h] = a0;  ((float*)(mls + MLS_AA))[t1 * 4 + h] = a1;
    ((float*)(mls + MLS_PM))[t0 * 4 + h] = p0;  ((float*)(mls + MLS_PM))[t1 * 4 + h] = p1;
    if (lane == 0) { ((float*)(mls + MLS_AMAX))[bh * 32 + c] = Amax; ((float*)(mls + MLS_LSUM))[bh * 32 + c] = Lsum; }
    }
    w0 = __expf(a0 - Amax); w1 = __expf(a1 - Amax);
#pragma unroll
    for (int j = 0; j < 4; ++j) cw[j * 64 + lane] = a.conv_w[(l * 4 + j) * 256 + h * 64 + lane];
    cw[256 + lane] = a.conv_b[l * 256 + h * 64 + lane];
    }
    const bf16_t* WT = (const bf16_t*)(mls + MLS_WT) + (size_t)(l * 3 * 4 + h) * 4096;
    LAS unsigned char* vt = wl; LAS unsigned char* kt = wl + 4608;
    f32x16 acc[2][2], nacc[2];
#pragma unroll
    for (int i = 0; i < 16; ++i) { acc[0][0][i] = 0.f; acc[0][1][i] = 0.f; acc[1][0][i] = 0.f; acc[1][1][i] = 0.f; nacc[0][i] = 0.f; nacc[1][i] = 0.f; }
    bf16x8 ones;
#pragma unroll
    for (int j = 0; j < 8; ++j) ones[j] = (short)0x3F80;
#pragma unroll 1
    for (int st = 2 * half; st < 2 * half + 2; ++st) {
        const int lane = lane_id_opaque(); const int r = lane & 31, hh = lane >> 5;
        const int i16 = lane & 15, q4 = i16 >> 2, p4 = i16 & 3, blk = (lane >> 4) & 1;
        const int vtr0 = (4 * hh + q4) * VP + (16 * blk + 4 * p4) * 2;
        const size_t row = rowb + 32 * st + r; const int tt = 128 * c + 32 * st + r;
        const float wt = bperm_f((st < 2) ? w0 : w1, 32 * (st & 1) + r);
        bf16x8 xcf[4], xmf[4];
        bf16x8 xa[4][4];
#pragma unroll
        for (int d0 = 0; d0 < 4; ++d0) {
            const int ch = 16 * d0 + 8 * hh;
#pragma unroll
            for (int j = 0; j < 4; ++j) { const bool ok = (tt - 3 + j >= 0); const bf16x8 ld = *(const bf16x8*)(U + (ok ? row - 3 + j : row) * LDU + OFF_ML_X + h * 64 + ch);
                const u32x4 lu = __builtin_bit_cast(u32x4, ld); u32x4 z; z.x = ok ? lu.x : 0u; z.y = ok ? lu.y : 0u; z.z = ok ? lu.z : 0u; z.w = ok ? lu.w : 0u; xa[d0][j] = __builtin_bit_cast(bf16x8, z); }
        }
#pragma unroll
        for (int d0 = 0; d0 < 4; ++d0) {
            const int ch = 16 * d0 + 8 * hh;
            const bf16x8 (&x)[4] = xa[d0];
            xmf[d0] = x[3];
            float xv[8];
            { const f32x4 ba = *(const LAS f32x4*)(cw + 256 + ch), bb = *(const LAS f32x4*)(cw + 256 + ch + 4);
              xv[0] = ba[0]; xv[1] = ba[1]; xv[2] = ba[2]; xv[3] = ba[3]; xv[4] = bb[0]; xv[5] = bb[1]; xv[6] = bb[2]; xv[7] = bb[3]; }
#pragma unroll
            for (int j = 0; j < 4; ++j) { const f32x4 wa = *(const LAS f32x4*)(cw + j * 64 + ch), wb = *(const LAS f32x4*)(cw + j * 64 + ch + 4);
#pragma unroll
                for (int e = 0; e < 4; ++e) { xv[e] += wa[e] * bf2f((bf16_t)x[j][e]); xv[4 + e] += wb[e] * bf2f((bf16_t)x[j][4 + e]); } }
            u32x4 pk;
            pk.x = cvtpk(xv[0] * sigmoidf_(xv[0]), xv[1] * sigmoidf_(xv[1])); pk.y = cvtpk(xv[2] * sigmoidf_(xv[2]), xv[3] * sigmoidf_(xv[3]));
            pk.z = cvtpk(xv[4] * sigmoidf_(xv[4]), xv[5] * sigmoidf_(xv[5])); pk.w = cvtpk(xv[6] * sigmoidf_(xv[6]), xv[7] * sigmoidf_(xv[7]));
            xcf[d0] = __builtin_bit_cast(bf16x8, pk);
        }
#pragma unroll
        for (int w = 0; w < 3; ++w) {
            bf16x8 wf[2][4];
#pragma unroll
            for (int eb = 0; eb < 2; ++eb)
#pragma unroll
                for (int d0 = 0; d0 < 4; ++d0) wf[eb][d0] = *(const bf16x8*)(WT + (size_t)w * 4 * 4096 + (32 * eb + r) * 64 + 16 * d0 + 8 * hh);
#pragma unroll
            for (int eb = 0; eb < 2; ++eb) {
                f32x16 pr;
#pragma unroll
                for (int i = 0; i < 16; ++i) pr[i] = 0.f;
#pragma unroll
                for (int d0 = 0; d0 < 4; ++d0) pr = MFMA32(wf[eb][d0], (w == 2) ? xmf[d0] : xcf[d0], pr);
                bf16_t* dst = ((w == 0) ? Qm : (w == 1 ? Km : Vm)) + row * 256 + h * 64 + 32 * eb;
#pragma unroll
                for (int g = 0; g < 4; ++g) {
                    const int e0 = 8 * g + 4 * hh;
                    u32x2 o; o.x = cvtpk(pr[4 * g], pr[4 * g + 1]); o.y = cvtpk(pr[4 * g + 2], pr[4 * g + 3]);
                    *(u32x2*)(dst + e0) = o;
                    if (w == 1) { u32x2 k2; k2.x = cvtpk(pr[4 * g] * wt, pr[4 * g + 1] * wt); k2.y = cvtpk(pr[4 * g + 2] * wt, pr[4 * g + 3] * wt); *(LAS u32x2*)(kt + r * VP + (32 * eb + e0) * 2) = k2; }
                    if (w == 2) *(LAS u32x2*)(vt + r * VP + (32 * eb + e0) * 2) = o;
                }
            }
            __builtin_amdgcn_sched_barrier(0);
        }
#pragma unroll
        for (int sk = 0; sk < 2; ++sk) {
            const bf16x8 kb0 = vt_frag(kt, vtr0, sk, 0), kb1 = vt_frag(kt, vtr0, sk, 1), va0 = vt_frag(vt, vtr0, sk, 0), va1 = vt_frag(vt, vtr0, sk, 1);
            acc[0][0] = MFMA32(va0, kb0, acc[0][0]); acc[0][1] = MFMA32(va0, kb1, acc[0][1]);
            acc[1][0] = MFMA32(va1, kb0, acc[1][0]); acc[1][1] = MFMA32(va1, kb1, acc[1][1]);
            nacc[0] = MFMA32(ones, kb0, nacc[0]); nacc[1] = MFMA32(ones, kb1, nacc[1]);
        }
    }
    const int lane = lane_id_opaque(); const int r = lane & 31, hh = lane >> 5;
    float* CL = (float*)(a.ws + WS_CLOC) + ((size_t)half * 1024 + bh * 32 + c) * 4096;
#pragma unroll
    for (int eb = 0; eb < 2; ++eb)
#pragma unroll
        for (int db = 0; db < 2; ++db)
#pragma unroll
            for (int i = 0; i < 16; ++i) CL[(32 * eb + crow(i, hh)) * 64 + 32 * db + r] = acc[eb][db][i];
    if (hh == 0) { float* NL = (float*)(mls + MLS_NLOC) + ((size_t)half * 1024 + bh * 32 + c) * 64; NL[r] = nacc[0][0]; NL[32 + r] = nacc[1][0]; }
}

__device__ __forceinline__ void phase_ml_b2(const Args& a, int gthread, int nthreads) {
    unsigned char* mls = a.ws + WS_MLS;
    const float* AM = (const float*)(mls + MLS_AMAX); const float* LS = (const float*)(mls + MLS_LSUM);
    for (int idx = gthread; idx < 32 * 4096; idx += nthreads) {
        const int bh = idx >> 12, ed = idx & 4095;
        const float* CL = (const float*)(a.ws + WS_CLOC) + (size_t)bh * 32 * 4096 + ed;
        bf16_t* CT = (bf16_t*)(a.ws + WS_CT) + (size_t)bh * 32 * 4096 + ed;
        const bool isn = ed < 64;
        const float* NL = (const float*)(mls + MLS_NLOC) + (size_t)bh * 32 * 64 + (ed & 63);
        float* NCp = (float*)(mls + MLS_NC) + (size_t)bh * 32 * 64 + (ed & 63);
        float C = 0.f, n = 0.f, m = 0.f;
        float cl[32];
#pragma unroll
        for (int c = 0; c < 32; ++c) cl[c] = CL[(size_t)c * 4096] + CL[(size_t)(1024 + c) * 4096];
#pragma unroll
        for (int c = 0; c < 32; ++c) {
            CT[(size_t)c * 4096] = f2bf(C);
            if (isn) NCp[c * 64] = n;
            if (ed == 0) ((float*)(mls + MLS_MC))[bh * 32 + c] = m;
            const float A = AM[bh * 32 + c], L = LS[bh * 32 + c];
            const float M = fmaxf(m, A); const float dec = __expf(m - M), sc = __expf(A - M);
            C = dec * C + sc * cl[c];
            if (isn) n = dec * n + sc * (NL[c * 64] + NL[(1024 + c) * 64]);
            m = L + M;
        }
    }
}

__device__ __forceinline__ void ml_b3_item(const Args& a, int l, LAS unsigned char* wl, int b, int h, int c, int qt, int lane) {
    const int r = lane & 31, hh = lane >> 5, bh = b * 4 + h;
    const size_t rowc = (size_t)b * SEQ + 128 * c, rowq = rowc + 32 * qt + r;
    unsigned char* mls = a.ws + WS_MLS;
    const bf16_t* Qm = (const bf16_t*)(a.ws + WS_QKV); const bf16_t* Km = Qm + (size_t)T_TOK * 256; const bf16_t* Vm = Km + (size_t)T_TOK * 256;
    LAS float* atab = (LAS float*)(wl + 4608);
    atab[lane] = ((const float*)(mls + MLS_AA))[(rowc + lane) * 4 + h]; atab[64 + lane] = ((const float*)(mls + MLS_AA))[(rowc + 64 + lane) * 4 + h];
    const float cum_t = ((const float*)(mls + MLS_CUM))[rowq * 4 + h], pm_t = ((const float*)(mls + MLS_PM))[rowq * 4 + h];
    const float m_c = ((const float*)(mls + MLS_MC))[bh * 32 + c];
    const float M_t = fmaxf(m_c, pm_t), inter = __expf(m_c - M_t), m_t = cum_t + M_t;
    bf16x8 qf[4];
#pragma unroll
    for (int d0 = 0; d0 < 4; ++d0) qf[d0] = *(const bf16x8*)(Qm + rowq * 256 + h * 64 + 16 * d0 + 8 * hh);
    const bf16_t* og = (const bf16_t*)(a.ws + WS_U) + rowq * LDU + OFF_ML_O + h * 64;
    const float* gh = a.g_head + l * 1024 + h * 64;
    u32x2 oga[4], ogb[4]; f32x4 gha[4], ghb[4];
#pragma unroll
    for (int g = 0; g < 4; ++g) { const int d0 = 8 * g + 4 * hh; oga[g] = *(const u32x2*)(og + d0); ogb[g] = *(const u32x2*)(og + 32 + d0); gha[g] = *(const f32x4*)(gh + d0); ghb[g] = *(const f32x4*)(gh + 32 + d0); }
    const float* NCp = (const float*)(mls + MLS_NC) + (size_t)(bh * 32 + c) * 64;
    f32x4 nca[4], ncb[4];
#pragma unroll
    for (int d0 = 0; d0 < 4; ++d0) { nca[d0] = *(const f32x4*)(NCp + 16 * d0 + 8 * hh); ncb[d0] = *(const f32x4*)(NCp + 16 * d0 + 8 * hh + 4); }
    const bf16_t* CT = (const bf16_t*)(a.ws + WS_CT) + (size_t)(bh * 32 + c) * 4096;
    bf16x8 ctf[2][4];
#pragma unroll
    for (int d0 = 0; d0 < 4; ++d0) { ctf[0][d0] = *(const bf16x8*)(CT + (size_t)r * 64 + 16 * d0 + 8 * hh); ctf[1][d0] = *(const bf16x8*)(CT + (size_t)(32 + r) * 64 + 16 * d0 + 8 * hh); }
    f32x16 n0, n1;
#pragma unroll
    for (int i = 0; i < 16; ++i) { n0[i] = 0.f; n1[i] = 0.f; }
#pragma unroll
    for (int d0 = 0; d0 < 4; ++d0) { n0 = MFMA32(ctf[0][d0], qf[d0], n0); n1 = MFMA32(ctf[1][d0], qf[d0], n1); }
    float qn = 0.f;
#pragma unroll
    for (int d0 = 0; d0 < 4; ++d0) { const f32x4 na = nca[d0], nb = ncb[d0];
#pragma unroll
        for (int e = 0; e < 4; ++e) { qn += bf2f((bf16_t)qf[d0][e]) * na[e]; qn += bf2f((bf16_t)qf[d0][4 + e]) * nb[e]; } }
    float qn0, qn1; halves(qn, qn0, qn1); qn = qn0 + qn1;
#pragma unroll
    for (int i = 0; i < 16; ++i) { n0[i] *= inter; n1[i] *= inter; }
    float dsum = 0.f;
    const int vrow = lane >> 3, vseg = lane & 7;
    const int i16 = lane & 15, q4 = i16 >> 2, p4 = i16 & 3, blk = (lane >> 4) & 1;
    const int vtr0 = (4 * hh + q4) * VP + (16 * blk + 4 * p4) * 2;
    LAS unsigned char* vl = wl;
    unsigned loff[4];
#pragma unroll
    for (int i = 0; i < 4; ++i) loff[i] = (unsigned)((vrow + 8 * i) * 256 + 8 * vseg) * 2u;
#define B3_LOAD(KT, KF, VV) do { const size_t tb_ = (rowc + 32 * (KT)) * 256 + h * 64; const char* kb_ = (const char*)(Km + tb_); const char* vb_ = (const char*)(Vm + tb_); \
        _Pragma("unroll") for (int i = 0; i < 4; ++i) { KF[i] = *(const u32x4*)(kb_ + loff[i]); VV[i] = *(const u32x4*)(vb_ + loff[i]); } } while (0)
#define B3_TILE(KT, KF, VV) do { \
        KT_WRITE(kl, KF); \
        _Pragma("unroll") for (int i = 0; i < 4; ++i) *(LAS u32x4*)(vl + (vrow + 8 * i) * VP + vseg * 16) = VV[i]; \
        f32x16 sc; \
        _Pragma("unroll") for (int i = 0; i < 16; ++i) sc[i] = 0.f; \
        _Pragma("unroll") for (int d0 = 0; d0 < 4; ++d0) sc = MFMA32(KT_FRAG(kl, d0), qf[d0], sc); \
        _Pragma("unroll") for (int g = 0; g < 4; ++g) { \
            const f32x4 av = *(const LAS f32x4*)(atab + 32 * (KT) + 8 * g + 4 * hh); \
            _Pragma("unroll") for (int e = 0; e < 4; ++e) { const int i = 4 * g + e; float dm = __expf(av[e] - M_t); if ((KT) == qt && crow(i, hh) > r) dm = 0.f; const float pv = sc[i] * dm; sc[i] = pv; dsum += pv; } } \
        const bf16x8 pb0 = pack8(sc, 0), pb1 = pack8(sc, 1); \
        n0 = MFMA32(vt_frag(vl, vtr0, 0, 0), pb0, n0); n0 = MFMA32(vt_frag(vl, vtr0, 1, 0), pb1, n0); \
        n1 = MFMA32(vt_frag(vl, vtr0, 0, 1), pb0, n1); n1 = MFMA32(vt_frag(vl, vtr0, 1, 1), pb1, n1); } while (0)
    {
        u32x4 kA[4], kB[4], vA[4], vB[4];
        LAS unsigned char* kl = wl + 8192;
        int kt = 0;
        B3_LOAD(kt, kA, vA);
#pragma unroll 1
        for (;;) {
            if (kt < qt) B3_LOAD(kt + 1, kB, vB);
            B3_TILE(kt, kA, vA);
            if (kt == qt) break;
            ++kt;
            if (kt < qt) B3_LOAD(kt + 1, kA, vA);
            B3_TILE(kt, kB, vB);
            if (kt == qt) break;
            ++kt;
        }
    }
#undef B3_LOAD
#undef B3_TILE
    float ds0, ds1; halves(dsum, ds0, ds1);
    const float den = inter * qn + (ds0 + ds1);
    const float hinv = 1.f / fmaxf(fabsf(den), __expf(-m_t));
    float ss = 0.f;
#pragma unroll
    for (int g = 0; g < 4; ++g) {
        const int d0 = 8 * g + 4 * hh;
        const u32x2 ga = oga[g], gb = ogb[g];
        const float oa[4] = {__uint_as_float(ga.x << 16), __uint_as_float(ga.x & 0xffff0000u), __uint_as_float(ga.y << 16), __uint_as_float(ga.y & 0xffff0000u)};
        const float ob[4] = {__uint_as_float(gb.x << 16), __uint_as_float(gb.x & 0xffff0000u), __uint_as_float(gb.y << 16), __uint_as_float(gb.y & 0xffff0000u)};
#pragma unroll
        for (int e = 0; e < 4; ++e) { const float va = sigmoidf_(oa[e]) * n0[4 * g + e] * hinv, vb = sigmoidf_(ob[e]) * n1[4 * g + e] * hinv; n0[4 * g + e] = va; n1[4 * g + e] = vb; ss += va * va + vb * vb; }
    }
    float s0, s1; halves(ss, s0, s1);
    const float rs = rsqrtf((s0 + s1) * (1.f / 64.f) + EPS);
    bf16_t* yr = (bf16_t*)(a.ws + WS_Y) + rowq * 1024 + h * 64;
#pragma unroll
    for (int g = 0; g < 4; ++g) {
        const int d0 = 8 * g + 4 * hh;
        const f32x4 ga = gha[g], gb = ghb[g];
        u32x2 wa, wb; wa.x = cvtpk(n0[4 * g] * rs * ga[0], n0[4 * g + 1] * rs * ga[1]); wa.y = cvtpk(n0[4 * g + 2] * rs * ga[2], n0[4 * g + 3] * rs * ga[3]);
        wb.x = cvtpk(n1[4 * g] * rs * gb[0], n1[4 * g + 1] * rs * gb[1]); wb.y = cvtpk(n1[4 * g + 2] * rs * gb[2], n1[4 * g + 3] * rs * gb[3]);
        *(u32x2*)(yr + d0) = wa; *(u32x2*)(yr + 32 + d0) = wb;
    }
}
__device__ __forceinline__ void phase_ml_b1(const Args& a, int l, LAS unsigned char* lds, int gw, int ngw, int wave_) {
    for (int it = gw; it < NB * 4 * 32 * 2; it += ngw) ml_b1_item(a, l, lds + wave_ * 16384, it / 256, (it / 64) & 3, (it >> 1) & 31, it & 1);
}
__device__ __forceinline__ void phase_ml_b3(const Args& a, int l, LAS unsigned char* lds, int gw, int ngw, int wave_) {
    const int lane = lane_id_opaque();
    for (int it = gw, k = 0; it < NB * 4 * 32 * 4; it += ngw, ++k) ml_b3_item(a, l, lds + wave_ * 16384, it / 512, (it / 128) & 3, (it >> 2) & 31, (k & 1) ? (it & 3) : 3 - (it & 3), lane);
}

__device__ __forceinline__ Args load_args() {
#if defined(__HIP_DEVICE_COMPILE__)
    typedef const __attribute__((address_space(4))) Args* KArgs;
    KArgs p_ = (KArgs)__builtin_amdgcn_kernarg_segment_ptr(); asm volatile("" : "+s"(p_)); return *p_;
#else
    return Args{};
#endif
}
#define KA() load_args()
__global__ void __launch_bounds__(NWAVES * 64, 2) fwd(Args a_unused) {
    extern __shared__ __attribute__((aligned(16))) unsigned char lds_raw[];
    LAS unsigned char* lds = (LAS unsigned char*)lds_raw;
    const int wave = __builtin_amdgcn_readfirstlane((int)threadIdx.x >> 6);
    const int G = gridDim.x, gw = blockIdx.x * NWAVES + wave, ngw = G * NWAVES;
    volatile LAS unsigned* MISC = (volatile LAS unsigned*)(lds + MISC_OFF);
    { const int t0 = wave * 64 + lane_id_opaque(); if (t0 < 32) MISC[t0] = 0u; }
    __syncthreads();
#if defined(MK_SPLIT)
    int lo, hi; unsigned* ctl; { const Args a = KA(); ctl = (unsigned*)(a.ws + WS_CTL); lo = a.ph_lo; hi = a.ph_hi; }
#else
    constexpr int lo = 0, hi = 22; unsigned* ctl; { const Args a = KA(); ctl = (unsigned*)(a.ws + WS_CTL); }
#endif
    XcdBarrier bar; bar.bar = ctl + CW_BAR; bar.x = 0; bar.st = nullptr;
    if (hi - lo > 1) bar = xcd_barrier_post(ctl + CW_BAR, MISC + 8, wave == 0 && lane_id_opaque() == 0);
#define IN(k) (lo <= (k) && (k) < hi)
#ifndef DISMASK
#define DISMASK 0
#endif
#define DIS(k) ((DISMASK >> (k)) & 1)
#ifndef REPMASK
#define REPMASK 0
#endif
#define NREP(k) ((((REPMASK) >> (k)) & 1) ? (1 + opaque_one()) : 1)
#define REPSYNC(k) do { if (rep_ + 1 < nrep_) xcd_barrier(bar, wave); } while (0)
#ifdef TS_PHASE
#define SEAM(k) do { if (IN(k) && IN((k) + 1)) { xcd_barrier(bar, wave); if (blockIdx.x == 0 && wave == 0 && lane_id_opaque() == 0) ((unsigned long long*)(ctl + 12288))[(k) + 1] = __builtin_amdgcn_s_memrealtime(); } } while (0)
#else
#define SEAM(k) do { if (IN(k) && IN((k) + 1)) xcd_barrier(bar, wave); } while (0)
#endif
    if (IN(0) && !DIS(0)) _Pragma("unroll 1") for (int rep_ = 0, nrep_ = NREP(0); rep_ < nrep_; ++rep_) { const Args a = KA(); phase_prologue(a, lds, gw, ngw, wave); REPSYNC(0); }
    SEAM(0);
    for (int l = 0; l < 2; ++l) {
        const int pb = 1 + 10 * l;
        if (IN(pb + 0) && !DIS(1)) _Pragma("unroll 1") for (int rep_ = 0, nrep_ = NREP(1); rep_ < nrep_; ++rep_) { const Args a = KA(); if (l == 0) phase_norm<1, false>(a, l, a.x, lds, gw, ngw, wave); else phase_norm<1, true>(a, l, a.out, lds, gw, ngw, wave); __syncthreads(); REPSYNC(1); }
        SEAM(pb + 0);
        if (IN(pb + 1) && !DIS(2)) _Pragma("unroll 1") for (int rep_ = 0, nrep_ = NREP(2); rep_ < nrep_; ++rep_) { const Args a = KA();
            ProbDense P{(const char*)(a.ws + WS_H), (const char*)(a.ws + WS_WIN) + (size_t)l * LDU * 1024 * 2, 1024};
            pg8::StaticOrder S; S.init(T_TOK / 256, LDU / 256, G, (int)blockIdx.x);
            EpiU E{(bf16_t*)(a.ws + WS_U)};
            pg8::gemm_phase(lds, P, S, E, wave);
            if (l == 0) tp_tail(a, (T_TOK / 256) * (LDU / 256), G, 0, TP_TAIL_INPROJ, lds, wave);
            REPSYNC(2);
        }
        SEAM(pb + 1);
        if (IN(pb + 2) && !DIS(8)) { const Args a = KA();
            _Pragma("unroll 1") for (int rep_ = 0, nrep_ = NREP(11); rep_ < nrep_; ++rep_) { phase_ml_b1(a, l, lds, gw, ngw, wave); REPSYNC(11); }
            _Pragma("unroll 1") for (int rep_ = 0, nrep_ = NREP(12); rep_ < nrep_; ++rep_) { phase_sb(a, l, lds, gw, ngw, wave); REPSYNC(12); }
            phase_dil(a, l, lds, gw, ngw, wave, 0, 1); }
        SEAM(pb + 2);
        if (IN(pb + 3) && !DIS(9)) { const Args a = KA();
            _Pragma("unroll 1") for (int rep_ = 0, nrep_ = NREP(13); rep_ < nrep_; ++rep_) { phase_ml_b2(a, (int)blockIdx.x * (NWAVES * 64) + wave * 64 + lane_id_opaque(), G * NWAVES * 64); REPSYNC(13); }
            _Pragma("unroll 1") for (int rep_ = 0, nrep_ = NREP(14); rep_ < nrep_; ++rep_) { phase_dil(a, l, lds, gw, ngw, wave, 1, 3); REPSYNC(14); } }
        SEAM(pb + 3);
        if (IN(pb + 4) && !DIS(10)) { const Args a = KA();
            _Pragma("unroll 1") for (int rep_ = 0, nrep_ = NREP(15); rep_ < nrep_; ++rep_) { phase_ml_b3(a, l, lds, gw, ngw, wave); REPSYNC(15); }
            _Pragma("unroll 1") for (int rep_ = 0, nrep_ = NREP(16); rep_ < nrep_; ++rep_) { phase_dil_merge(a, l, gw, ngw); REPSYNC(16); } }
        SEAM(pb + 4);
        if (IN(pb + 5) && !DIS(3)) _Pragma("unroll 1") for (int rep_ = 0, nrep_ = ((l == 0) ? NREP(3) : 1); rep_ < nrep_; ++rep_) { const Args a = KA(); const float* xin = (l == 0) ? a.x : a.out; const float* modl = (const float*)(a.ws + WS_MOD) + (size_t)l * 8 * NMOD;
            ProbDense P{(const char*)(a.ws + WS_Y), (const char*)(a.ws + WS_WOUT) + (size_t)l * 1024 * 1024 * 2, 1024};
            pg8::StaticOrder S; S.init(T_TOK / 256, 4, G, (int)blockIdx.x);
            if (l == 0) { EpiOut<false> E{a.x, (bf16_t*)a.out, modl + 2048}; pg8::gemm_phase(lds, P, S, E, wave); }
            else { EpiOut<true> E{a.out, (bf16_t*)a.out, modl + 2048}; pg8::gemm_phase(lds, P, S, E, wave); }
            if (l == 0) REPSYNC(3);
        }
        SEAM(pb + 5);
        if (IN(pb + 6) && !DIS(4)) _Pragma("unroll 1") for (int rep_ = 0, nrep_ = NREP(4); rep_ < nrep_; ++rep_) { const Args a = KA(); phase_norm<2, true>(a, (rep_ + 1 < nrep_) ? l + 2 : l, a.out, lds, gw, ngw, wave); __syncthreads(); REPSYNC(4); }
        SEAM(pb + 6);
        if (IN(pb + 7) && !DIS(5)) _Pragma("unroll 1") for (int rep_ = 0, nrep_ = NREP(5); rep_ < nrep_; ++rep_) { const Args a = KA();
            LAS int* tab = (LAS int*)(lds + TAB_OFF); build_moe_tab(a, l, tab, wave);
            const int nMt = tab[352];
            ProbGU P{(const char*)(a.ws + WS_H), (const char*)(a.ws + WS_WGU) + (size_t)l * 16 * 1024 * 1024 * 2, (const int*)(a.ws + WS_LIST), tab};
            pg8::StaticOrder S; S.init(nMt, 8, G, (int)blockIdx.x);
            EpiGU E{(bf16_t*)(a.ws + WS_U), (const int*)(a.ws + WS_LIST), (const float*)(a.ws + WS_RW), tab};
            pg8::gemm_phase(lds, P, S, E, wave);
            if (l == 0) tp_tail(a, nMt * 8, G, TP_N_MOE / 2, TP_N_MOE / 2 + 5120, lds, wave);
            REPSYNC(5);
        }
        SEAM(pb + 7);
        if (IN(pb + 8) && !DIS(6)) _Pragma("unroll 1") for (int rep_ = 0, nrep_ = NREP(6); rep_ < nrep_; ++rep_) { const Args a = KA(); const float* modl = (const float*)(a.ws + WS_MOD) + (size_t)l * 8 * NMOD;
            LAS int* tab = (LAS int*)(lds + TAB_OFF); build_moe_tab(a, l, tab, wave);
            const int nMt = tab[352];
            ProbDown P{(const char*)(a.ws + WS_U), (const char*)(a.ws + WS_WD) + (size_t)l * 16 * 1024 * 512 * 2, tab};
            pg8::StaticOrder S; S.init(nMt, 4, G, (int)blockIdx.x);
            EpiDown E{(rep_ + 1 < nrep_) ? (bf16_t*)(a.ws + WS_Y) : (bf16_t*)a.out, (const int*)(a.ws + WS_LIST), modl + 5120, tab};
            pg8::gemm_phase(lds, P, S, E, wave);
            if (l == 0) tp_tail(a, nMt * 4, G, TP_N_MOE / 2 + 5120, TP_N_MOE, lds, wave);
            REPSYNC(6);
        }
        SEAM(pb + 8);
    }
#if defined(TS_DIL)
    if (IN(21)) { const Args a = KA(); const unsigned long long* st = (const unsigned long long*)(ctl + 12288);
        const float eps = (float)(long long)st[40] * 0.01f * TS_SCALE; phase_final(a, gw, ngw, 1.f + eps, bar, wave); }
#elif defined(TS_PHASE)
    if (IN(21)) { const Args a = KA(); const unsigned long long* st = (const unsigned long long*)(ctl + 12288);
        const float eps = (float)(long long)(st[TS_PHASE + 1] - st[TS_PHASE]) * 0.01f * TS_SCALE; phase_final(a, gw, ngw, 1.f + eps, bar, wave); }
#else
    if (IN(21) && !DIS(7)) { const Args a = KA(); phase_final(a, gw, ngw, 1.f, bar, wave); }
#endif
#undef IN
#undef SEAM
}

__global__ void __launch_bounds__(256) k_qkvm(const bf16_t* __restrict__ U, const float* __restrict__ conv_w, const float* __restrict__ conv_b,
                                              const float* __restrict__ wq, const float* __restrict__ wk, const float* __restrict__ wv, bf16_t* __restrict__ Q, bf16_t* __restrict__ K, bf16_t* __restrict__ V) {
    __shared__ float xc[4][64], xm[4][64];
    const int tid = threadIdx.x, ti = tid >> 6, e = tid & 63;
    const int nitem = (T_TOK / 4) * 4;
    for (int item = blockIdx.x; item < nitem; item += gridDim.x) {
        const int h = item & 3, t = (item >> 2) * 4 + ti;
        const int ts = t % SEQ; const int ch = h * 64 + e;
        float a = conv_b[ch];
#pragma unroll
        for (int j = 0; j < 4; ++j) { const int tt = ts - 3 + j; if (tt >= 0) a += conv_w[j * 256 + ch] * bf2f(U[(size_t)(t - 3 + j) * LDU + OFF_ML_X + ch]); }
        __syncthreads();
        xc[ti][e] = a * sigmoidf_(a);
        xm[ti][e] = bf2f(U[(size_t)t * LDU + OFF_ML_X + ch]);
        __syncthreads();
        float q = 0.f, k = 0.f, v = 0.f;
        for (int d = 0; d < 64; ++d) { const float c = xc[ti][d]; q += c * wq[(h * 64 + d) * 64 + e]; k += c * wk[(h * 64 + d) * 64 + e]; v += xm[ti][d] * wv[(h * 64 + d) * 64 + e]; }
        Q[(size_t)t * 256 + ch] = f2bf(q); K[(size_t)t * 256 + ch] = f2bf(k * 0.125f); V[(size_t)t * 256 + ch] = f2bf(v);
    }
}
__global__ void __launch_bounds__(256) k_mlstm_seq(const bf16_t* __restrict__ Q, const bf16_t* __restrict__ K, const bf16_t* __restrict__ V, const float* __restrict__ gate, const float* __restrict__ gate_bias,
                                                   const bf16_t* __restrict__ U, const float* __restrict__ g_head, bf16_t* __restrict__ Y) {
    __shared__ float sq[32][64], sk[32][64], sv[32][64], sig[32], slf[32];
    __shared__ float red[2][4][64]; __shared__ float sden[2];
    const int tid = threadIdx.x, e = tid & 63, dg = tid >> 6;
    const int b = blockIdx.x >> 2, h = blockIdx.x & 3;
    float C[16];
#pragma unroll
    for (int i = 0; i < 16; ++i) C[i] = 0.f;
    float nst = 0.f, m = 0.f;
    const float bi = gate_bias[h], bff = gate_bias[4 + h];
    for (int t0 = 0; t0 < SEQ; t0 += 32) {
        __syncthreads();
        for (int i = tid; i < 32 * 64; i += 256) { const int tt = i >> 6, d = i & 63; const size_t r = (size_t)(b * SEQ + t0 + tt) * 256 + h * 64 + d; sq[tt][d] = bf2f(Q[r]); sk[tt][d] = bf2f(K[r]); sv[tt][d] = bf2f(V[r]); }
        if (tid < 32) { const size_t r = (size_t)(b * SEQ + t0 + tid) * 8; sig[tid] = gate[r + h] + bi; const float fp = gate[r + 4 + h] + bff; slf[tid] = -softplusf_(-fp); }
        __syncthreads();
        for (int tt = 0; tt < 32; ++tt) {
            const int pb = tt & 1;
            const float ig = sig[tt], lf = slf[tt];
            const float mn = fmaxf(lf + m, ig);
            const float a = __expf(lf + m - mn), bc = __expf(ig - mn);
            m = mn;
            const float ve = sv[tt][e];
            float part = 0.f;
#pragma unroll
            for (int i = 0; i < 16; ++i) { const int d = dg * 16 + i; C[i] = a * C[i] + bc * sk[tt][d] * ve; part += sq[tt][d] * C[i]; }
            red[pb][dg][e] = part;
            if (tid < 64) { nst = a * nst + bc * sk[tt][tid]; const float qn = wave_sum(sq[tt][tid] * nst); if (tid == 0) sden[pb] = qn; }
            __syncthreads();
            if (tid < 64) {
                const float num = red[pb][0][e] + red[pb][1][e] + red[pb][2][e] + red[pb][3][e];
                const float den = sden[pb];
                const float hv = num / fmaxf(fabsf(den), __expf(-m));
                const size_t row = (size_t)(b * SEQ + t0 + tt);
                const float o = sigmoidf_(bf2f(U[row * LDU + OFF_ML_O + h * 64 + e])) * hv;
                const float ss = wave_sum(o * o);
                Y[row * 1024 + h * 64 + e] = f2bf(o * rsqrtf(ss * (1.f / 64.f) + EPS) * g_head[h * 64 + e]);
            }
        }
    }
}
__global__ void __launch_bounds__(256) k_dil(const bf16_t* __restrict__ U, const float* __restrict__ g_head, bf16_t* __restrict__ Y) {
    const int lane = threadIdx.x & 63;
    const int wave = (blockIdx.x * blockDim.x + threadIdx.x) >> 6, nw = (gridDim.x * blockDim.x) >> 6;
    for (int item = wave; item < NB * 6 * SEQ; item += nw) {
        const int t = item % SEQ, h = (item / SEQ) % 6, b = item / (SEQ * 6);
        const size_t row = (size_t)b * SEQ + t;
        const float q = bf2f(U[row * LDU + OFF_DIL + h * 64 + lane]);
        const float slope = exp2f(-8.f * (float)(h + 1) / 6.f);
        float m = -INFINITY, l = 0.f, acc = 0.f;
        for (int p = 0; p < 3; ++p) {
            const int d = (p == 0) ? 1 : (p == 1 ? 4 : 16);
            for (int j = 0; j <= 128; ++j) {
                const int tk = t - j * d; if (tk < 0) break;
                const size_t kr = ((size_t)b * SEQ + tk) * LDU + OFF_DIL + h * 64 + lane;
                const float kv = bf2f(U[kr + 384]), vv = bf2f(U[kr + 768]);
                const float s = wave_sum(q * kv) * 0.125f - slope * (float)(j * d);
                const float mn = fmaxf(m, s); const float corr = __expf(m - mn), pe = __expf(s - mn);
                l = l * corr + pe; acc = acc * corr + pe * vv; m = mn;
            }
        }
        const float o = acc / l;
        const float ss = wave_sum(o * o);
        Y[row * 1024 + (4 + h) * 64 + lane] = f2bf(o * rsqrtf(ss * (1.f / 64.f) + EPS) * g_head[(4 + h) * 64 + lane]);
    }
}
__global__ void __launch_bounds__(256) k_sb(const bf16_t* __restrict__ U, const float* __restrict__ g_head, bf16_t* __restrict__ Y) {
    const int lane = threadIdx.x & 63;
    const int wave = (blockIdx.x * blockDim.x + threadIdx.x) >> 6, nw = (gridDim.x * blockDim.x) >> 6;
    for (int item = wave; item < NB * 6 * SEQ; item += nw) {
        const int t = item % SEQ, h = (item / SEQ) % 6, b = item / (SEQ * 6);
        const size_t row = (size_t)b * SEQ + t;
        const float q = bf2f(U[row * LDU + OFF_SB + h * 64 + lane]);
        float run = 0.f, acc = 0.f;
        for (int s = t - 1; s >= 0; --s) {
            const size_t kr = ((size_t)b * SEQ + s) * LDU + OFF_SB + h * 64 + lane;
            const float kv = bf2f(U[kr + 384]), vv = bf2f(U[kr + 768]);
            const float z = wave_sum(q * kv) * 0.125f;
            const float lk = -softplusf_(z);
            acc += __expf(z + lk + run) * vv;
            run += lk;
            if (run < -104.f) break;
        }
        const float ss = wave_sum(acc * acc);
        Y[row * 1024 + (10 + h) * 64 + lane] = f2bf(acc * rsqrtf(ss * (1.f / 64.f) + EPS) * g_head[(10 + h) * 64 + lane]);
    }
}

extern "C" void kernel_launch(void* const* d_in, const int* in_sizes, int n_in, void* d_out, int out_size, void* d_ws, size_t ws_size, hipStream_t stream) {
    static int grid = 0;
    if (grid == 0) {
        int dev = 0, cus = 0;
        if (ws_size < WS_END) { fprintf(stderr, "kernel_launch: workspace too small (%zu < %zu)\n", ws_size, (size_t)WS_END); grid = -1; return; }
        if (hipGetDevice(&dev) != hipSuccess || hipDeviceGetAttribute(&cus, hipDeviceAttributeMultiprocessorCount, dev) != hipSuccess) { grid = -1; return; }
        if (hipFuncSetAttribute((const void*)fwd, hipFuncAttributeMaxDynamicSharedMemorySize, LDS_BYTES) != hipSuccess) { fprintf(stderr, "kernel_launch: hipFuncSetAttribute failed\n"); grid = -1; return; }
        (void)hipGetLastError();
        grid = 256;
        if (cus < 256) { fprintf(stderr, "kernel_launch: needs 256 CUs, device has %d\n", cus); grid = -1; return; }
    }
    if (grid < 0) return;
    Args a{};
    a.x = (const float*)d_in[0]; a.c = (const float*)d_in[1]; a.w_in = (const float*)d_in[2]; a.conv_w = (const float*)d_in[3]; a.conv_b = (const float*)d_in[4];
    a.w_mq = (const float*)d_in[5]; a.w_mk = (const float*)d_in[6]; a.w_mv = (const float*)d_in[7]; a.gate_bias = (const float*)d_in[8]; a.g_head = (const float*)d_in[9];
    a.w_out = (const float*)d_in[10]; a.w_ada = (const float*)d_in[11]; a.b_ada = (const float*)d_in[12]; a.w_router = (const float*)d_in[13]; a.router_bias = (const float*)d_in[14];
    a.w_gate_e = (const float*)d_in[15]; a.w_up_e = (const float*)d_in[16]; a.w_down_e = (const float*)d_in[17]; a.g_final = (const float*)d_in[18];
    a.out = (float*)d_out; a.ws = (unsigned char*)d_ws;
    char* ws = (char*)d_ws;
    (void)hipMemsetAsync(ws + WS_CTL, 0, CTL_BYTES, stream);
    float* gate = (float*)(ws + WS_GATE); bf16_t* U = (bf16_t*)(ws + WS_U);
    bf16_t* Y = (bf16_t*)(ws + WS_Y); bf16_t* Qm = (bf16_t*)(ws + WS_QKV); bf16_t* Km = Qm + (size_t)T_TOK * 256; bf16_t* Vm = Km + (size_t)T_TOK * 256;
#define RUN(lo_, hi_) do { a.ph_lo = (lo_); a.ph_hi = (hi_); hipLaunchKernelGGL(fwd, dim3(grid), dim3(NWAVES * 64), LDS_BYTES, stream, a); } while (0)
#if defined(MK_SPLIT)
    RUN(0, 1);
    for (int l = 0; l < 2; ++l) { const int pb = 1 + 10 * l; for (int k = 0; k < 9; ++k) RUN(pb + k, pb + k + 1); }
    RUN(21, 22);
#else
    RUN(0, 22);
#endif
#undef RUN
}
```

```cpp
#include <hip/hip_runtime.h>
#include <stdint.h>
#include <stdio.h>

#define T_TOK 32768
#define SEQ 4096
#define DM 1024
#define NB 8
#define DIN 2824
#define LDU 2816
#define OFF_ML_X 0
#define OFF_ML_O 256
#define OFF_DIL 512
#define OFF_SB 1664
#define NMOD 6144
#define EPS 1e-6f
#define NBUCK 24

#define LAS __attribute__((address_space(3)))
typedef unsigned short bf16_t;
typedef short bf16x8 __attribute__((ext_vector_type(8)));
typedef float f32x4 __attribute__((ext_vector_type(4)));
typedef float f32x2 __attribute__((ext_vector_type(2)));
typedef unsigned u32x4 __attribute__((ext_vector_type(4)));
typedef unsigned u32x2 __attribute__((ext_vector_type(2)));

__device__ __forceinline__ float bf2f(bf16_t v) { return __uint_as_float(((unsigned)v) << 16); }
__device__ __forceinline__ unsigned f2bf_u(float f) { unsigned u = __float_as_uint(f); return (u + 0x7fffu + ((u >> 16) & 1u)) >> 16; }
__device__ __forceinline__ bf16_t f2bf(float f) { return (bf16_t)f2bf_u(f); }
__device__ __forceinline__ unsigned pk2(float lo, float hi) { return f2bf_u(lo) | (f2bf_u(hi) << 16); }
__device__ __forceinline__ float wave_sum(float v) {
#pragma unroll
    for (int o = 32; o > 0; o >>= 1) v += __shfl_xor(v, o, 64);
    return v;
}
__device__ __forceinline__ float bperm_f(float v, int srclane) { return __int_as_float(__builtin_amdgcn_ds_bpermute((srclane & 63) << 2, __float_as_int(v))); }
__device__ __forceinline__ int opaque_one() { int r; asm volatile("s_mov_b32 %0, 1" : "=s"(r)); return r; }
__device__ __forceinline__ int lane_id_opaque() { int r; asm volatile("v_mbcnt_lo_u32_b32 %0, -1, 0\n\tv_mbcnt_hi_u32_b32 %0, -1, %0" : "=v"(r)); return r; }
__device__ __forceinline__ float wave_sum_l(float v, int lane) {
#pragma unroll
    for (int o = 32; o > 0; o >>= 1) v += __int_as_float(__builtin_amdgcn_ds_bpermute((lane ^ o) << 2, __float_as_int(v)));
    return v;
}
__device__ __forceinline__ float sigmoidf_(float x) { return 1.f / (1.f + __expf(-x)); }
__device__ __forceinline__ float softplusf_(float z) { return fmaxf(z, 0.f) + log1pf(__expf(-fabsf(z))); }

constexpr size_t MiB = 1u << 20;
constexpr size_t WS_CTL   = 0;
constexpr size_t CTL_BYTES = 1 * MiB;
constexpr size_t WS_MOD   = 1 * MiB;
constexpr size_t WS_GATE  = WS_MOD + 512 * 1024;
constexpr size_t WS_RW    = WS_GATE + 1 * MiB;
constexpr size_t WS_LIST  = WS_RW + 256 * 1024;
constexpr size_t WS_WIN   = 6 * MiB;
constexpr size_t WS_WOUT  = 17 * MiB;
constexpr size_t WS_WGU   = 21 * MiB;
constexpr size_t WS_WD    = 85 * MiB;
constexpr size_t WS_H     = 117 * MiB;
constexpr size_t WS_U     = 181 * MiB;
constexpr size_t WS_Y     = 357 * MiB;
constexpr size_t WS_QKV   = 421 * MiB;
constexpr size_t WS_OP1   = WS_H;
constexpr size_t WS_CLOC  = WS_H + 24 * MiB;
constexpr size_t WS_OP2   = 469 * MiB;
constexpr size_t WS_LSE   = 493 * MiB;
constexpr size_t WS_CT    = 496 * MiB;
constexpr size_t WS_MLS   = 504 * MiB;
constexpr size_t WS_END   = 507 * MiB;
constexpr size_t MLS_CUM = 0, MLS_AA = 512 * 1024, MLS_PM = 1024 * 1024, MLS_NLOC = 1536 * 1024  , MLS_NC = 2048 * 1024, MLS_AMAX = 2304 * 1024, MLS_LSUM = 2308 * 1024, MLS_MC = 2312 * 1024, MLS_WT = 2560 * 1024;

constexpr int CW_BAR = 4096;
constexpr int CW_CNT = 8192;

namespace pg8 {
constexpr int BM = 256, BK = 64, HALF = 128, HTB = HALF * BK * 2, STAGE_BYTES = 8 * HTB, NXCD = 8, WGM = 8;
__host__ __device__ __forceinline__ int lds_byte(int r, int c) { const int st = (r >> 4) * 2 + (c >> 5), rr = r & 15, cc = c & 31, ob = rr * 64 + cc * 2; return st * 1024 + (ob ^ (((ob >> 9) & 1) << 5)); }
__host__ __device__ __forceinline__ void stage_rc(int b, int& R, int& C) { const int st = b / 1024, sb = b % 1024, swz = sb ^ (((sb >> 9) & 1) << 5); R = (st >> 1) * 16 + swz / 64; C = (st & 1) * 32 + (swz % 64) / 2; }
__host__ __device__ __forceinline__ int perm32(int rho) { const int n = rho >> 4, i = rho & 15; return 8 * (i >> 2) + 4 * n + (i & 3); }
struct Unit { int pm, pn; };
struct StaticOrder {
    int nM, nN, nwg, G, c;
    __device__ void init(int nM_, int nN_, int G_, int c_) { nM = nM_; nN = nN_; nwg = nM * nN; G = G_; c = c_; }
    __device__ bool next(int i, Unit& u) const {
        const long L = (long)i * G + c; if (L >= nwg) return false;
        int wgid = (int)L; { const int q = nwg / NXCD, r = nwg % NXCD, xcd = wgid % NXCD, off = wgid / NXCD; wgid = (xcd < r ? xcd * (q + 1) : r * (q + 1) + (xcd - r) * q) + off; }
        const int nig = WGM * nN, gid = wgid / nig, fm = gid * WGM, gsz = (nM - fm) < WGM ? (nM - fm) : WGM;
        u.pm = fm + ((wgid % nig) % gsz); u.pn = (wgid % nig) / gsz; return true;
    }
};
__device__ __forceinline__ unsigned cvt_pk_bf16(float lo, float hi) { unsigned r; asm volatile("v_cvt_pk_bf16_f32 %0, %1, %2" : "=v"(r) : "v"(lo), "v"(hi)); return r; }

template <class P, class Epi, class Sched>
__device__ __forceinline__ void gemm_phase(LAS unsigned char* lds, const P& pb, const Sched& S, const Epi& E, int wave_) {
    const int tid_ = wave_ * 64 + lane_id_opaque();
    const int tid = tid_, wid = __builtin_amdgcn_readfirstlane(tid >> 6), lane = tid & 63, wr = wid >> 2, wc = wid & 3, fr = lane & 15, fq = lane >> 4;
    const int nt = pb.nt();
    unsigned voffB[2];
#pragma unroll
    for (int i = 0; i < 2; ++i) { int R, C; stage_rc(tid * 16 + i * 8192, R, C); const int Rb = Epi::PERM ? ((R & ~31) + perm32(R & 31)) : R; voffB[i] = (unsigned)(Rb * pb.ldb() + C) * 2u; }
    const size_t hstepB = (size_t)HALF * pb.ldb() * 2;
    const unsigned ldsw = (unsigned)wid * 1024u;
    const int aoff = lds_byte(wr * 64 + fr, fq * 8), boff = lds_byte(wc * 32 + fr, fq * 8);
#define PG8_SA(b, h) (((b) * 2 + (h)) * HTB)
#define PG8_SB(b, h) ((4 + (b) * 2 + (h)) * HTB)
#define PG8_STAGE(bufoff, gbase, voff) do { _Pragma("unroll") for (int _i = 0; _i < 2; ++_i) \
        __builtin_amdgcn_global_load_lds((const unsigned*)((const char*)(gbase) + (voff)[_i]), (LAS unsigned*)(lds + (bufoff) + ldsw + _i * 8192), 16, 0, 0); } while (0)
#define PG8_LDA(dst, b, h) do { _Pragma("unroll") for (int m = 0; m < 4; ++m) _Pragma("unroll") for (int k = 0; k < 2; ++k) dst[m][k] = *(const LAS bf16x8*)(lds + PG8_SA(b, h) + aoff + m * 2048 + k * 1024); } while (0)
#define PG8_LDB(dst, b, h) do { _Pragma("unroll") for (int n = 0; n < 2; ++n) _Pragma("unroll") for (int k = 0; k < 2; ++k) dst[n][k] = *(const LAS bf16x8*)(lds + PG8_SB(b, h) + boff + n * 2048 + k * 1024); } while (0)
#define PG8_MMA(ai, bj, At, Bt) do { __builtin_amdgcn_s_setprio(1); _Pragma("unroll") for (int m = 0; m < 4; ++m) _Pragma("unroll") for (int n = 0; n < 2; ++n) _Pragma("unroll") for (int k = 0; k < 2; ++k) \
        acc[ai][bj][m][n] = __builtin_amdgcn_mfma_f32_16x16x32_bf16(Bt[n][k], At[m][k], acc[ai][bj][m][n], 0, 0, 0); __builtin_amdgcn_s_setprio(0); } while (0)
#define PG8_WAIT_V(n) asm volatile("s_waitcnt vmcnt(" #n ")" ::: "memory")
#define PG8_WAIT_L(n) asm volatile("s_waitcnt lgkmcnt(" #n ")" ::: "memory")
#define PG8_BAR __builtin_amdgcn_s_barrier()
#define PG8_SCHED __builtin_amdgcn_sched_barrier(0)
#define PG8_AOFF(dst, u) do { int _t = tid; asm volatile("" : "+v"(_t)); _Pragma("unroll") for (int _i = 0; _i < 2; ++_i) { int _R, _C; stage_rc(_t * 16 + _i * 8192, _R, _C); \
        _Pragma("unroll") for (int _h = 0; _h < 2; ++_h) dst[_h][_i] = pb.a_row(u, _h * HALF + _R) + (unsigned)_C * 2u; } } while (0)
    Unit cur, nxt; int ui = 0;
    if (!S.next(0, cur)) return;
    f32x4 acc[2][2][4][2];
#pragma unroll
    for (int a = 0; a < 2; ++a)
#pragma unroll
        for (int b = 0; b < 2; ++b)
#pragma unroll
            for (int m = 0; m < 4; ++m)
#pragma unroll
                for (int n = 0; n < 2; ++n) acc[a][b][m][n] = (f32x4){0.f, 0.f, 0.f, 0.f};
    bf16x8 At[4][2], B0[2][2], B1[2][2];
    unsigned ca[2][2], na[2][2];
    PG8_AOFF(ca, cur);
    const char* Ab = pb.a_base();
    {
        const char* b0 = pb.b_tile(cur, 0); const char* b1 = pb.b_tile(cur, 1);
        PG8_STAGE(PG8_SB(0, 0), b0, voffB); PG8_STAGE(PG8_SB(0, 1), b0 + hstepB, voffB); PG8_STAGE(PG8_SA(0, 0), Ab, ca[0]); PG8_STAGE(PG8_SA(0, 1), Ab, ca[1]);
        if (wr == 1) PG8_BAR;
        PG8_WAIT_V(2); PG8_BAR;
        PG8_STAGE(PG8_SB(1, 0), b1, voffB); PG8_STAGE(PG8_SA(1, 0), Ab + 128, ca[0]); PG8_STAGE(PG8_SB(1, 1), b1 + hstepB, voffB);
        PG8_WAIT_V(6); PG8_BAR;
    }
    for (;;) {
        const bool has_next = S.next(ui + 1, nxt);
        if (!has_next) nxt = cur;
        PG8_AOFF(na, nxt);
#define PG8_KPAIR(A2BASE, OFF2, B2, B3, A1P) do { \
              \
            PG8_LDB(B0, 0, 0); PG8_LDB(B1, 0, 1); PG8_SCHED; PG8_LDA(At, 0, 0); PG8_STAGE(PG8_SA(1, 1), A1P, ca[1]); \
            PG8_WAIT_V(8); PG8_WAIT_L(0); PG8_BAR; PG8_MMA(0, 0, At, B0); PG8_MMA(0, 1, At, B1); PG8_BAR; PG8_SCHED; \
              \
            PG8_LDA(At, 0, 1); PG8_STAGE(PG8_SB(0, 0), B2, voffB); PG8_STAGE(PG8_SB(0, 1), (B2) + hstepB, voffB); PG8_STAGE(PG8_SA(0, 0), A2BASE, OFF2[0]); \
            PG8_WAIT_V(8); PG8_WAIT_L(0); PG8_BAR; PG8_MMA(1, 0, At, B0); PG8_MMA(1, 1, At, B1); PG8_BAR; PG8_SCHED; \
              \
            PG8_LDB(B0, 1, 0); PG8_LDB(B1, 1, 1); PG8_SCHED; PG8_LDA(At, 1, 0); PG8_STAGE(PG8_SA(0, 1), A2BASE, OFF2[1]); \
            PG8_WAIT_V(8); PG8_WAIT_L(0); PG8_BAR; PG8_MMA(0, 0, At, B0); PG8_MMA(0, 1, At, B1); PG8_BAR; PG8_SCHED; \
              \
            PG8_LDA(At, 1, 1); PG8_STAGE(PG8_SB(1, 0), B3, voffB); PG8_STAGE(PG8_SB(1, 1), (B3) + hstepB, voffB); PG8_STAGE(PG8_SA(1, 0), (A2BASE) + 128, OFF2[0]); \
            PG8_WAIT_V(8); PG8_WAIT_L(0); PG8_BAR; PG8_MMA(1, 0, At, B0); PG8_MMA(1, 1, At, B1); PG8_BAR; PG8_SCHED; } while (0)
        for (int t = 0; t < nt - 2; t += 2) {
            const char* b2 = pb.b_tile(cur, t + 2); const char* b3 = pb.b_tile(cur, t + 3);
            const char* a1p = Ab + (size_t)(t + 1) * 128; const char* a2p = Ab + (size_t)(t + 2) * 128;
            PG8_KPAIR(a2p, ca, b2, b3, a1p);
        }
        {
            const char* b2 = pb.b_tile(nxt, 0); const char* b3 = pb.b_tile(nxt, 1);
            const char* a1p = Ab + (size_t)(nt - 1) * 128;
            PG8_KPAIR(Ab, na, b2, b3, a1p);
        }
#undef PG8_KPAIR
        if (wr == 0) PG8_BAR;
        E(acc, cur, wr, wc, fr, fq);
        if (!has_next) break;
#pragma unroll
        for (int a = 0; a < 2; ++a)
#pragma unroll
            for (int b = 0; b < 2; ++b)
#pragma unroll
                for (int m = 0; m < 4; ++m)
#pragma unroll
                    for (int n = 0; n < 2; ++n) acc[a][b][m][n] = (f32x4){0.f, 0.f, 0.f, 0.f};
        cur = nxt;
#pragma unroll
        for (int h = 0; h < 2; ++h)
#pragma unroll
            for (int i = 0; i < 2; ++i) ca[h][i] = na[h][i];
        ++ui;
        if (wr == 1) PG8_BAR;
    }
    PG8_WAIT_V(0);
    PG8_BAR;
#undef PG8_SA
#undef PG8_SB
#undef PG8_STAGE
#undef PG8_LDA
#undef PG8_LDB
#undef PG8_MMA
#undef PG8_WAIT_V
#undef PG8_WAIT_L
#undef PG8_BAR
#undef PG8_SCHED
#undef PG8_AOFF
}
}
using pg8::Unit;

struct ProbDense {
    const char* A; const char* B; int K;
    __device__ __forceinline__ int nt() const { return K / 64; }
    __device__ __forceinline__ int ldb() const { return K; }
    __device__ __forceinline__ const char* a_base() const { return A; }
    __device__ __forceinline__ unsigned a_row(const Unit& u, int r) const { return (unsigned)((u.pm * 256 + r) * K) * 2u; }
    __device__ __forceinline__ const char* b_tile(const Unit& u, int t) const { return B + (size_t)u.pn * 256 * K * 2 + (size_t)t * 128; }
};
__device__ __forceinline__ int bucket_e0(int k) { const int g = k / 6, p = k % 6; return 4 * g + (p < 3 ? 0 : (p < 5 ? 1 : 2)); }
__device__ __forceinline__ int bucket_e1(int k) { const int g = k / 6, p = k % 6; return 4 * g + (p < 3 ? p + 1 : (p < 5 ? p - 1 : 3)); }
struct ProbGU {
    const char* H; const char* W; const int* list; const LAS int* tab;
    __device__ __forceinline__ int nt() const { return 16; }
    __device__ __forceinline__ int ldb() const { return 1024; }
    __device__ __forceinline__ const char* a_base() const { return H; }
    __device__ __forceinline__ unsigned a_row(const Unit& u, int r) const {
        const int k = tab[32 + u.pm], rr = tab[192 + u.pm] + r; int tok = 0; if (rr < tab[k]) tok = list[(size_t)k * T_TOK + rr]; return (unsigned)tok * 2048u; }
    __device__ __forceinline__ const char* b_tile(const Unit& u, int t) const {
        const int k = __builtin_amdgcn_readfirstlane(tab[32 + u.pm]); const int e = (u.pn < 4) ? bucket_e0(k) : bucket_e1(k);
        return W + (size_t)e * (1024 * 1024 * 2) + (size_t)(u.pn & 3) * 256 * 2048 + (size_t)t * 128; }
};
struct ProbDown {
    const char* HE; const char* W; const LAS int* tab;
    __device__ __forceinline__ int nt() const { return 16; }
    __device__ __forceinline__ int ldb() const { return 512; }
    __device__ __forceinline__ const char* a_base() const { return HE; }
    __device__ __forceinline__ unsigned a_row(const Unit& u, int r) const { return (unsigned)(u.pm * 256 + r) * 2048u; }
    __device__ __forceinline__ const char* b_tile(const Unit& u, int t) const {
        const int k = __builtin_amdgcn_readfirstlane(tab[32 + u.pm]); const int e = (t < 8) ? bucket_e0(k) : bucket_e1(k);
        return W + (size_t)e * (1024 * 512 * 2) + (size_t)u.pn * 256 * 1024 + (size_t)(t & 7) * 128; }
};

__device__ __forceinline__ f32x4 bf4_lo(const u32x4& v) { return (f32x4){__uint_as_float(v.x << 16), __uint_as_float(v.x & 0xffff0000u), __uint_as_float(v.y << 16), __uint_as_float(v.y & 0xffff0000u)}; }
__device__ __forceinline__ f32x4 bf4_hi(const u32x4& v) { return (f32x4){__uint_as_float(v.z << 16), __uint_as_float(v.z & 0xffff0000u), __uint_as_float(v.w << 16), __uint_as_float(v.w & 0xffff0000u)}; }
struct EpiU {
    static constexpr bool PERM = true;
    bf16_t* O;
    __device__ __forceinline__ void operator()(const f32x4 (&acc)[2][2][4][2], const Unit& u, int wr, int wc, int fr, int fq) const {
        const int row0 = u.pm * 256 + wr * 64 + fr, col0 = u.pn * 256 + wc * 32 + 8 * fq;
#pragma unroll
        for (int ai = 0; ai < 2; ++ai)
#pragma unroll
            for (int m = 0; m < 4; ++m) { bf16_t* rowp = O + (size_t)(row0 + ai * 128 + m * 16) * LDU + col0;
#pragma unroll
                for (int bj = 0; bj < 2; ++bj) { const f32x4 v0 = acc[ai][bj][m][0], v1 = acc[ai][bj][m][1];
                    u32x4 w; w.x = pg8::cvt_pk_bf16(v0[0], v0[1]); w.y = pg8::cvt_pk_bf16(v0[2], v0[3]); w.z = pg8::cvt_pk_bf16(v1[0], v1[1]); w.w = pg8::cvt_pk_bf16(v1[2], v1[3]);
                    *(u32x4*)(rowp + bj * 128) = w; } }
    }
};
template <bool XINBF> struct EpiOut {
    static constexpr bool PERM = true;
    const void* xin; bf16_t* XB; const float* gate;
    __device__ __forceinline__ void operator()(const f32x4 (&acc)[2][2][4][2], const Unit& u, int wr, int wc, int fr, int fq) const {
        const int b = (u.pm * 256) / SEQ; const int col0 = u.pn * 256 + wc * 32 + 8 * fq;
        f32x4 gv[2][2];
#pragma unroll
        for (int bj = 0; bj < 2; ++bj)
#pragma unroll
            for (int n = 0; n < 2; ++n) gv[bj][n] = *(const f32x4*)(gate + (size_t)b * NMOD + col0 + bj * 128 + n * 4);
#pragma unroll
        for (int ai = 0; ai < 2; ++ai)
#pragma unroll
            for (int m = 0; m < 4; ++m) { const size_t off = (size_t)(u.pm * 256 + ai * 128 + wr * 64 + m * 16 + fr) * DM + col0;
#pragma unroll
                for (int bj = 0; bj < 2; ++bj) {
                    f32x4 x0, x1;
                    if (XINBF) { const u32x4 xv = *(const u32x4*)((const bf16_t*)xin + off + bj * 128); x0 = bf4_lo(xv); x1 = bf4_hi(xv); }
                    else { x0 = *(const f32x4*)((const float*)xin + off + bj * 128); x1 = *(const f32x4*)((const float*)xin + off + bj * 128 + 4); }
                    const f32x4 y0 = x0 + gv[bj][0] * acc[ai][bj][m][0], y1 = x1 + gv[bj][1] * acc[ai][bj][m][1];
                    u32x4 w; w.x = pg8::cvt_pk_bf16(y0[0], y0[1]); w.y = pg8::cvt_pk_bf16(y0[2], y0[3]); w.z = pg8::cvt_pk_bf16(y1[0], y1[1]); w.w = pg8::cvt_pk_bf16(y1[2], y1[3]);
                    *(u32x4*)(XB + off + bj * 128) = w; } }
    }
};
struct EpiGU {
    static constexpr bool PERM = true;
    bf16_t* HE; const int* list; const float* rw; const LAS int* tab;
    __device__ __forceinline__ void operator()(const f32x4 (&acc)[2][2][4][2], const Unit& u, int wr, int wc, int fr, int fq) const {
        const int k = tab[32 + u.pm], r0 = tab[192 + u.pm], cnt = tab[k]; const int part = u.pn >> 2;
        const int hcol0 = part * 512 + ((u.pn & 3) * 256 + wc * 32 + 8 * fq) / 2;
#pragma unroll
        for (int ai = 0; ai < 2; ++ai)
#pragma unroll
            for (int m = 0; m < 4; ++m) { const int r = ai * 128 + wr * 64 + m * 16 + fr; const int rr = r0 + r;
                if (rr < cnt) { const int tok = list[(size_t)k * T_TOK + rr]; const float w = rw[tok * 2 + part];
                    bf16_t* rowp = HE + (size_t)(u.pm * 256 + r) * 1024 + hcol0;
#pragma unroll
                    for (int bj = 0; bj < 2; ++bj) { const f32x4 v0 = acc[ai][bj][m][0], v1 = acc[ai][bj][m][1];
                        const float h0 = v0[0] * sigmoidf_(v0[0]) * v0[1] * w, h1 = v0[2] * sigmoidf_(v0[2]) * v0[3] * w, h2 = v1[0] * sigmoidf_(v1[0]) * v1[1] * w, h3 = v1[2] * sigmoidf_(v1[2]) * v1[3] * w;
                        u32x2 o; o.x = pg8::cvt_pk_bf16(h0, h1); o.y = pg8::cvt_pk_bf16(h2, h3);
                        *(u32x2*)(rowp + bj * 64) = o; } } }
    }
};
struct EpiDown {
    static constexpr bool PERM = true;
    const bf16_t* XS; bf16_t* XB; const int* list; const float* gate; const LAS int* tab;
    __device__ __forceinline__ void operator()(const f32x4 (&acc)[2][2][4][2], const Unit& u, int wr, int wc, int fr, int fq) const {
        const int k = tab[32 + u.pm], r0 = tab[192 + u.pm], cnt = tab[k]; const int col0 = u.pn * 256 + wc * 32 + 8 * fq;
        int tok[2][4];
#pragma unroll
        for (int ai = 0; ai < 2; ++ai)
#pragma unroll
            for (int m = 0; m < 4; ++m) { const int rr = r0 + ai * 128 + wr * 64 + m * 16 + fr; tok[ai][m] = (rr < cnt) ? list[(size_t)k * T_TOK + rr] : -1; }
#pragma unroll
        for (int ai = 0; ai < 2; ++ai)
#pragma unroll
            for (int mp = 0; mp < 4; mp += 2) {
                u32x4 xi[2][2]; f32x4 gv[2][2][2];
#pragma unroll
                for (int mm = 0; mm < 2; ++mm) { const int tk = tok[ai][mp + mm]; const int tks = tk < 0 ? 0 : tk; const bf16_t* xr = XS + (size_t)tks * DM + col0; const float* gr = gate + (size_t)(tks / SEQ) * NMOD + col0;
#pragma unroll
                    for (int bj = 0; bj < 2; ++bj) { xi[mm][bj] = *(const u32x4*)(xr + bj * 128); gv[mm][bj][0] = *(const f32x4*)(gr + bj * 128); gv[mm][bj][1] = *(const f32x4*)(gr + bj * 128 + 4); } }
#pragma unroll
                for (int mm = 0; mm < 2; ++mm) { const int tk = tok[ai][mp + mm];
                    if (tk >= 0) { bf16_t* xr = XB + (size_t)tk * DM + col0;
#pragma unroll
                        for (int bj = 0; bj < 2; ++bj) { const f32x4 y0 = bf4_lo(xi[mm][bj]) + gv[mm][bj][0] * acc[ai][bj][mp + mm][0], y1 = bf4_hi(xi[mm][bj]) + gv[mm][bj][1] * acc[ai][bj][mp + mm][1];
                            u32x4 w; w.x = pg8::cvt_pk_bf16(y0[0], y0[1]); w.y = pg8::cvt_pk_bf16(y0[2], y0[3]); w.z = pg8::cvt_pk_bf16(y1[0], y1[1]); w.w = pg8::cvt_pk_bf16(y1[2], y1[3]);
                            *(u32x4*)(xr + bj * 128) = w; } } }
            }
    }
};

#define XB_TMO      128
#define XB_XCNT(j)  (256  + 64 * (j))
#define XB_XSUB(j)  (1280 + 64 * (j))
#define XB_XGEN(j)  (2304 + 64 * (j))
#define XB_TOP      3328
#define XB_TOPGEN   3392
#define XCD_BAR_WORDS 3456
#define XB_SPIN_CAP (1u << 18)
__device__ __forceinline__ unsigned xb_ld(unsigned* p)              { return __hip_atomic_load(p, __ATOMIC_RELAXED, __HIP_MEMORY_SCOPE_AGENT); }
__device__ __forceinline__ unsigned xb_add(unsigned* p, unsigned v) { return __hip_atomic_fetch_add(p, v, __ATOMIC_RELAXED, __HIP_MEMORY_SCOPE_AGENT); }
__device__ __forceinline__ unsigned xb_xcc_id() { return (unsigned)__builtin_amdgcn_s_getreg((3 << 11) | 20) & 0xFu; }
#define XB_SPIN(cond, bar) do { unsigned _sp = 0; while (cond) { __builtin_amdgcn_s_sleep(1); \
    if ((++_sp & 255u) == 0u) { if (xb_ld(&(bar)[XB_TMO])) break; if (_sp > XB_SPIN_CAP) { atomicAdd(&(bar)[XB_TMO], 1u); break; } } } } while (0)
struct XcdBarrier { unsigned* bar; unsigned x; volatile LAS unsigned* st; };
__device__ __forceinline__ XcdBarrier xcd_barrier_post(unsigned* bar, volatile LAS unsigned* st, bool leader) {
    XcdBarrier b; b.bar = bar; b.x = xb_xcc_id(); b.st = st;
    if (leader) (void)xb_add(&bar[XB_XCNT(b.x)], 1u);
    return b;
}
__device__ __forceinline__ void xcd_barrier_complete(unsigned* bar, unsigned x, unsigned& nloc, unsigned& nx) {
    const unsigned G = gridDim.x * gridDim.y * gridDim.z;
    unsigned sum, cnt, mine, sp = 0u;
    for (;;) {
        sum = 0u; cnt = 0u; mine = 0u;
#pragma unroll
        for (unsigned j = 0; j < 16; ++j) { const unsigned c = xb_ld(&bar[XB_XCNT(j)]); sum += c; cnt += (c > 0u) ? 1u : 0u; mine = (j == x) ? c : mine; }
        if (sum == G) break;
        __builtin_amdgcn_s_sleep(1);
        if ((++sp & 255u) == 0u) { if (xb_ld(&bar[XB_TMO])) break; if (sp > XB_SPIN_CAP) { atomicAdd(&bar[XB_TMO], 1u); break; } }
    }
    nloc = mine > 0u ? mine : 1u; nx = cnt > 0u ? cnt : 1u;
}
__device__ __forceinline__ void xcd_barrier(const XcdBarrier& b, int wave_) {
    asm volatile("s_waitcnt vmcnt(0)" ::: "memory");
    __syncthreads();
    if (wave_ == 0 && lane_id_opaque() == 0) {
        unsigned* bar = b.bar; asm volatile("" : "+s"(bar));
        __builtin_amdgcn_s_waitcnt(0);
        unsigned nloc = b.st[0], nx = b.st[1];
        if (nloc == 0u) { xcd_barrier_complete(bar, b.x, nloc, nx); b.st[0] = nloc; b.st[1] = nx; }
        const unsigned old = xb_add(&bar[XB_XSUB(b.x)], 1u);
        const unsigned gen = old / nloc;
        if (old + 1u == (gen + 1u) * nloc) {
            __builtin_amdgcn_fence(__ATOMIC_RELEASE, "agent");
            asm volatile("s_waitcnt vmcnt(0)" ::: "memory");
            const unsigned og = xb_add(&bar[XB_TOP], 1u);
            const unsigned tg = og / nx;
            if (og + 1u == (tg + 1u) * nx) xb_add(&bar[XB_TOPGEN], 1u);
            else XB_SPIN(xb_ld(&bar[XB_TOPGEN]) == tg, bar);
            __builtin_amdgcn_fence(__ATOMIC_ACQUIRE, "agent");
            xb_add(&bar[XB_XGEN(b.x)], 1u);
            asm volatile("s_waitcnt vmcnt(0)" ::: "memory");
        } else {
            XB_SPIN(xb_ld(&bar[XB_XGEN(b.x)]) == gen, bar);
            __builtin_amdgcn_fence(__ATOMIC_ACQUIRE, "agent");
            asm volatile("s_waitcnt vmcnt(0)" ::: "memory");
        }
    }
    __syncthreads();
}

constexpr int NWAVES = 8;
constexpr int RING_BYTES = 131072;
constexpr int TAB_OFF = RING_BYTES;
constexpr int MISC_OFF = TAB_OFF + 2048;
constexpr int LDS_BYTES = 147456;

struct Args {
    const float* x; const float* c; const float* w_in; const float* conv_w; const float* conv_b; const float* w_mq; const float* w_mk; const float* w_mv;
    const float* gate_bias; const float* g_head; const float* w_out; const float* w_ada; const float* b_ada; const float* w_router; const float* router_bias;
    const float* w_gate_e; const float* w_up_e; const float* w_down_e; const float* g_final;
    float* out; unsigned char* ws; int ph_lo, ph_hi;
};

struct TpItem { const float* src0; long long dsrc; int ldw; int inter; bf16_t* dst; int Kd; };
__device__ __forceinline__ void tp_load(const TpItem& t, float (&v)[32], int lane) {
    const int c = lane & 31;
    const float* p = t.inter ? (t.src0 + ((c & 1) ? t.dsrc : 0ll) + (c >> 1)) : (t.src0 + c);
#pragma unroll
    for (int i = 0; i < 32; ++i) v[i] = p[(size_t)(2 * i + (lane >> 5)) * t.ldw];
}
__device__ __forceinline__ void tp_finish(const TpItem& t, const float (&v)[32], LAS float* scr, int lane) {
#pragma unroll
    for (int i = 0; i < 32; ++i) scr[(2 * i + (lane >> 5)) * 33 + (lane & 31)] = v[i];
    asm volatile("s_waitcnt lgkmcnt(0)" ::: "memory");
    const int c = lane & 7;
#pragma unroll
    for (int j = 0; j < 4; ++j) { const int n = (lane >> 3) + 8 * j; const LAS float* s = scr + (8 * c) * 33 + n;
        u32x4 o; o.x = pk2(s[0 * 33], s[1 * 33]); o.y = pk2(s[2 * 33], s[3 * 33]); o.z = pk2(s[4 * 33], s[5 * 33]); o.w = pk2(s[6 * 33], s[7 * 33]);
        *(u32x4*)(t.dst + (size_t)n * t.Kd + 8 * c) = o; }
    asm volatile("s_waitcnt lgkmcnt(0)" ::: "memory");
}
constexpr int TP_N_DENSE = 2 * (16 * 88 + 16 * 32), TP_N_MOE = 2 * (16 * 16 * 32 + 16 * 8 * 32);
constexpr int TP_TAIL_INPROJ = 8192;
__device__ __forceinline__ TpItem tp_decode(const Args& a, int it, bool moe) {
    constexpr int I_IN = 16 * 88, I_OUT = 16 * 32, I_GU = 16 * 16 * 32, I_D = 16 * 8 * 32;
    TpItem t; t.inter = 0; t.dsrc = 0;
    if (!moe) {
        const int l = it / (I_IN + I_OUT); int r = it % (I_IN + I_OUT);
        if (r < I_IN) { const int kb = r / 88, nb = r % 88, n0 = nb * 32, k0 = kb * 64; const int ns = n0 < 512 ? n0 : n0 + 8;
            t.src0 = a.w_in + (size_t)l * 1024 * DIN + (size_t)k0 * DIN + ns; t.ldw = DIN; t.Kd = 1024; t.dst = (bf16_t*)(a.ws + WS_WIN) + (size_t)l * LDU * 1024 + (size_t)n0 * 1024 + k0; return t; }
        r -= I_IN;
        { const int kb = r / 32, nb = r % 32, n0 = nb * 32, k0 = kb * 64;
            t.src0 = a.w_out + (size_t)l * 1024 * 1024 + (size_t)k0 * 1024 + n0; t.ldw = 1024; t.Kd = 1024; t.dst = (bf16_t*)(a.ws + WS_WOUT) + (size_t)l * 1024 * 1024 + (size_t)n0 * 1024 + k0; return t; }
    }
    const int l = it / (I_GU + I_D); int r = it % (I_GU + I_D);
    if (r < I_GU) { const int e = r / 512, rr = r % 512, kb = rr / 32, nb = rr % 32, n0 = nb * 32, k0 = kb * 64;
        t.src0 = a.w_gate_e + ((size_t)l * 16 + e) * 1024 * 512 + (size_t)k0 * 512 + n0 / 2; t.dsrc = (long long)(((uintptr_t)a.w_up_e - (uintptr_t)a.w_gate_e) / 4); t.inter = 1;
        t.ldw = 512; t.Kd = 1024; t.dst = (bf16_t*)(a.ws + WS_WGU) + ((size_t)l * 16 + e) * 1024 * 1024 + (size_t)n0 * 1024 + k0; return t; }
    r -= I_GU;
    { const int e = r / 256, rr = r % 256, kb = rr / 32, nb = rr % 32, n0 = nb * 32, k0 = kb * 64;
        t.src0 = a.w_down_e + ((size_t)l * 16 + e) * 512 * 1024 + (size_t)k0 * 1024 + n0; t.ldw = 1024; t.Kd = 512; t.dst = (bf16_t*)(a.ws + WS_WD) + ((size_t)l * 16 + e) * 1024 * 512 + (size_t)n0 * 512 + k0; return t; }
}
__device__ __forceinline__ void tp_run(const Args& a, bool moe, int lo, int hi, LAS float* scr, int gw, int ngw) {
    const int lane = lane_id_opaque();
    asm volatile("" : "+s"(gw));
    float va[32], vb[32]; TpItem ta, tb;
    int it = lo + gw;
    if (it < hi) { ta = tp_decode(a, it, moe); tp_load(ta, va, lane); }
#pragma unroll 1
    for (;;) {
        if (it >= hi) break;
        if (it + ngw < hi) { tb = tp_decode(a, it + ngw, moe); tp_load(tb, vb, lane); }
        tp_finish(ta, va, scr, lane);
        it += ngw; if (it >= hi) break;
        if (it + ngw < hi) { ta = tp_decode(a, it + ngw, moe); tp_load(ta, va, lane); }
        tp_finish(tb, vb, scr, lane);
        it += ngw;
    }
}

__device__ __forceinline__ void phase_prologue(const Args& a, LAS unsigned char* lds, int gw, int ngw, int wave_) {
    const int lane = lane_id_opaque(), tid = wave_ * 64 + lane;
    LAS float* cact = (LAS float*)(lds + 98304);
    for (int i = tid; i < 8192; i += NWAVES * 64) { const float cv = a.c[i]; cact[i] = cv * sigmoidf_(cv); }
    __syncthreads();
    float* mod = (float*)(a.ws + WS_MOD);
    for (int it = (gw % NWAVES == 0) ? gw / NWAVES : (ngw / NWAVES) * (gw % NWAVES) + gw / NWAVES; it < 2 * 96; it += ngw) {
        const int l = it / 96, j = (it % 96) * 64 + lane;
        const float* w = a.w_ada + (size_t)l * 1024 * NMOD + j;
        float acc[8];
#pragma unroll
        for (int b = 0; b < 8; ++b) acc[b] = a.b_ada[l * NMOD + j];
#pragma unroll 1
        for (int k = 0; k < 1024; k += 32) {
            float wv[32];
#pragma unroll
            for (int kk = 0; kk < 32; ++kk) wv[kk] = w[(size_t)(k + kk) * NMOD];
#pragma unroll
            for (int b = 0; b < 8; ++b)
#pragma unroll
                for (int k4 = 0; k4 < 32; k4 += 4) { const f32x4 cv = *(const LAS f32x4*)(cact + b * 1024 + k + k4);
                    acc[b] += (cv[0] * wv[k4] + cv[1] * wv[k4 + 1]) + (cv[2] * wv[k4 + 2] + cv[3] * wv[k4 + 3]); }
        }
#pragma unroll
        for (int b = 0; b < 8; ++b) mod[((size_t)l * 8 + b) * NMOD + j] = acc[b];
    }
    { bf16_t* WT = (bf16_t*)(a.ws + WS_MLS + MLS_WT);
      for (int i = gw * 64 + lane; i < 2 * 3 * 4 * 4096; i += ngw * 64) {
          const int d = i & 63, e = (i >> 6) & 63, h = (i >> 12) & 3, w = (i >> 14) % 3, l = i / (3 * 4 * 4096);
          const float* src = (w == 0) ? a.w_mq : (w == 1 ? a.w_mk : a.w_mv);
          const float v = src[((size_t)(l * 4 + h) * 64 + d) * 64 + e];
          WT[i] = f2bf(w == 1 ? v * 0.125f : v); } }
    tp_run(a, false, 0, TP_N_DENSE, (LAS float*)(lds + (tid >> 6) * 8704), gw, ngw);
    tp_run(a, true, TP_TAIL_INPROJ, TP_N_MOE / 2, (LAS float*)(lds + (tid >> 6) * 8704), gw, ngw);
}

__device__ __forceinline__ void tp_tail(const Args& a, int nunits, int G, int lo, int hi, LAS unsigned char* lds, int wave_) {
    const int rem = nunits % G;
    if ((int)blockIdx.x < rem || lo >= hi) return;
    tp_run(a, true, lo, hi, (LAS float*)(lds + wave_ * 8704), ((int)blockIdx.x - rem) * NWAVES + wave_, (G - rem) * NWAVES);
}
template <int HALF, int OFF, int N> __device__ __forceinline__ void reduce_tr_step(float (&v)[N], int lane) {
    const bool up = (lane & OFF) != 0;
#pragma unroll
    for (int i = 0; i < HALF; ++i) { const float snd = up ? v[i] : v[i + HALF], kep = up ? v[i + HALF] : v[i]; v[i] = kep + bperm_f(snd, lane ^ OFF); }
}
template <int N> __device__ __forceinline__ float reduce_tr(float (&v)[N], int lane);
template <> __device__ __forceinline__ float reduce_tr<16>(float (&v)[16], int lane) {
    reduce_tr_step<8, 32>(v, lane); reduce_tr_step<4, 16>(v, lane); reduce_tr_step<2, 8>(v, lane); reduce_tr_step<1, 4>(v, lane);
    float r = v[0]; r += bperm_f(r, lane ^ 2); r += bperm_f(r, lane ^ 1); return r; }
template <> __device__ __forceinline__ float reduce_tr<8>(float (&v)[8], int lane) {
    reduce_tr_step<4, 32>(v, lane); reduce_tr_step<2, 16>(v, lane); reduce_tr_step<1, 8>(v, lane);
    float r = v[0]; r += bperm_f(r, lane ^ 4); r += bperm_f(r, lane ^ 2); r += bperm_f(r, lane ^ 1); return r; }
template <int MODE, bool XBF>
__device__ __forceinline__ void phase_norm(const Args& a, int l, const void* xin, LAS unsigned char* lds, int gw, int ngw, int wave_) {
    const int lane = lane_id_opaque(), tid = wave_ * 64 + lane;
    constexpr int NC = (MODE == 1) ? 8 : 16;
    LAS float* wl = (LAS float*)lds;
    LAS int* hist = (LAS int*)(lds + 65536); LAS int* basek = hist + 32; LAS int* rowinfo = hist + 64;
    const int lc = l; l &= 1;
    const float* modl = (const float*)(a.ws + WS_MOD) + (size_t)l * 8 * NMOD;
    const int shift_off = (MODE == 1) ? 0 : 3072, scale_off = (MODE == 1) ? 1024 : 4096;
    if (MODE == 1) { const float* W = a.w_in + (size_t)l * 1024 * DIN + 512; for (int i = tid; i < 1024 * 8; i += NWAVES * 64) wl[(i & 7) * 1024 + (i >> 3)] = W[(size_t)(i >> 3) * DIN + (i & 7)]; }
    else { for (int i = tid; i < 1024 * 16; i += NWAVES * 64) wl[(i & 15) * 1024 + (i >> 4)] = a.w_router[i]; if (tid < 32) hist[tid] = 0; }
    __syncthreads();
    bf16_t* H = (bf16_t*)(a.ws + WS_H);
    float* gate = (float*)(a.ws + WS_GATE); float* rw = (float*)(a.ws + WS_RW); int* list = (int*)(a.ws + WS_LIST);
    int* cnt = (int*)(a.ws + WS_CTL) + CW_CNT + lc * 32;
    const int rows_per = (T_TOK + ngw - 1) / ngw;
    const int row0 = gw * rows_per;
    f32x4 msc[4], msh[4];
    { const int b = row0 / SEQ;
#pragma unroll
      for (int j = 0; j < 4; ++j) { const int k0 = XBF ? (8 * lane + 512 * (j >> 1) + 4 * (j & 1)) : (4 * lane + 256 * j); msc[j] = *(const f32x4*)(modl + (size_t)b * NMOD + scale_off + k0); msh[j] = *(const f32x4*)(modl + (size_t)b * NMOD + shift_off + k0);
#pragma unroll
          for (int q = 0; q < 4; ++q) msc[j][q] += 1.f; } }
    f32x4 nx0[4], nx1[4];
#define NORM_LOAD(T0, LN) do { \
        if (XBF) { _Pragma("unroll") for (int jj = 0; jj < 2; ++jj) { const u32x4 q0 = *((const u32x4*)((const bf16_t*)xin + (size_t)(T0) * DM) + (LN) + 64 * jj), q1 = *((const u32x4*)((const bf16_t*)xin + (size_t)((T0) + 1) * DM) + (LN) + 64 * jj); \
                nx0[2 * jj] = bf4_lo(q0); nx0[2 * jj + 1] = bf4_hi(q0); nx1[2 * jj] = bf4_lo(q1); nx1[2 * jj + 1] = bf4_hi(q1); } } \
        else { _Pragma("unroll") for (int j = 0; j < 4; ++j) { nx0[j] = *((const f32x4*)((const float*)xin + (size_t)(T0) * DM) + (LN) + 64 * j); nx1[j] = *((const f32x4*)((const float*)xin + (size_t)((T0) + 1) * DM) + (LN) + 64 * j); } } } while (0)
    NORM_LOAD(row0, lane);
#pragma unroll 1
    for (int i = 0; i < rows_per; i += 2) {
        const int lane = lane_id_opaque();
        const int t0 = row0 + i; if (t0 >= T_TOK) break;
        constexpr bool has1 = true; const int t1 = t0 + 1;
        f32x4 v0[4], v1[4]; float ss0 = 0.f, ss1 = 0.f;
#pragma unroll
        for (int j = 0; j < 4; ++j) { v0[j] = nx0[j]; v1[j] = nx1[j]; }
        { const int tn = (i + 2 < rows_per) ? t0 + 2 : t0;
          NORM_LOAD(tn, lane); }
#pragma unroll
        for (int j = 0; j < 4; ++j) { ss0 += (v0[j][0] * v0[j][0] + v0[j][1] * v0[j][1]) + (v0[j][2] * v0[j][2] + v0[j][3] * v0[j][3]); ss1 += (v1[j][0] * v1[j][0] + v1[j][1] * v1[j][1]) + (v1[j][2] * v1[j][2] + v1[j][3] * v1[j][3]); }
#pragma unroll
        for (int o = 32; o > 0; o >>= 1) { ss0 += bperm_f(ss0, lane ^ o); ss1 += bperm_f(ss1, lane ^ o); }
        const float rs0 = rsqrtf(ss0 * (1.f / 1024.f) + EPS), rs1 = rsqrtf(ss1 * (1.f / 1024.f) + EPS);
        float lg0[NC], lg1[NC];
#pragma unroll
        for (int e = 0; e < NC; ++e) { lg0[e] = 0.f; lg1[e] = 0.f; }
#pragma unroll
        for (int j = 0; j < 4; ++j) {
            const int k0 = XBF ? (8 * lane + 512 * (j >> 1) + 4 * (j & 1)) : (4 * lane + 256 * j);
            f32x4 h0, h1;
#pragma unroll
            for (int q = 0; q < 4; ++q) { h0[q] = v0[j][q] * rs0 * msc[j][q] + msh[j][q]; h1[q] = v1[j][q] * rs1 * msc[j][q] + msh[j][q]; }
            u32x2 o0; o0.x = pk2(h0[0], h0[1]); o0.y = pk2(h0[2], h0[3]); *(u32x2*)(H + (size_t)t0 * DM + k0) = o0;
            if (has1) { u32x2 o1; o1.x = pk2(h1[0], h1[1]); o1.y = pk2(h1[2], h1[3]); *(u32x2*)(H + (size_t)t1 * DM + k0) = o1; }
#pragma unroll
            for (int e8 = 0; e8 < NC; e8 += 8) {
#pragma unroll
                for (int e = e8; e < e8 + 8; ++e) { const f32x4 w = *(const LAS f32x4*)(wl + e * 1024 + k0);
                    lg0[e] += (h0[0] * w[0] + h0[1] * w[1]) + (h0[2] * w[2] + h0[3] * w[3]); lg1[e] += (h1[0] * w[0] + h1[1] * w[1]) + (h1[2] * w[2] + h1[3] * w[3]); }
                __builtin_amdgcn_sched_barrier(0);
            }
        }
        const float r0 = reduce_tr<NC>(lg0, lane), r1 = reduce_tr<NC>(lg1, lane);
        if (MODE == 1) {
            if ((lane & 7) == 0) { gate[(size_t)t0 * 8 + (lane >> 3)] = r0; if (has1) gate[(size_t)t1 * 8 + (lane >> 3)] = r1; }
        } else {
#pragma unroll
            for (int rr = 0; rr < 2; ++rr) {
                if (rr == 1 && !has1) break;
                const float rv = rr ? r1 : r0; const int t = rr ? t1 : t0;
                float sc[16], bs[16];
#pragma unroll
                for (int e = 0; e < 16; ++e) { const float lgt = __int_as_float(__builtin_amdgcn_readlane(__float_as_int(rv), 4 * e)); sc[e] = sigmoidf_(lgt); bs[e] = sc[e] + a.router_bias[e]; }
                float best_gs = -1e30f; int bk = 0; float bw0 = 0.f, bw1 = 0.f;
#pragma unroll
                for (int g = 0; g < 4; ++g) {
                    int i0 = 0; float q0 = bs[4 * g]; float s0 = sc[4 * g];
#pragma unroll
                    for (int j = 1; j < 4; ++j) if (bs[4 * g + j] > q0) { q0 = bs[4 * g + j]; i0 = j; s0 = sc[4 * g + j]; }
                    int i1 = -1; float q1 = -1e30f; float s1 = 0.f;
#pragma unroll
                    for (int j = 0; j < 4; ++j) if (j != i0 && bs[4 * g + j] > q1) { q1 = bs[4 * g + j]; i1 = j; s1 = sc[4 * g + j]; }
                    const float gs = q0 + q1;
                    if (gs > best_gs) { best_gs = gs;
                        const int lo = i0 < i1 ? i0 : i1, hi = i0 < i1 ? i1 : i0; const float wlo = i0 < i1 ? s0 : s1, whi = i0 < i1 ? s1 : s0;
                        const int pq = (lo == 0) ? (hi - 1) : (lo == 1 ? hi + 1 : 5);
                        bk = 6 * g + pq; bw0 = wlo; bw1 = whi; }
                }
                if (lane == 0) {
                    const float inv = 1.f / (bw0 + bw1);
                    *(f32x2*)(rw + (size_t)t * 2) = (f32x2){bw0 * inv, bw1 * inv};
                    const int pos = __hip_atomic_fetch_add(&hist[bk], 1, __ATOMIC_RELAXED, __HIP_MEMORY_SCOPE_WORKGROUP);
                    rowinfo[t - (int)blockIdx.x * (NWAVES * rows_per)] = bk | (pos << 8);
                }
            }
        }
    }
#undef NORM_LOAD
    if (MODE == 2) {
        __syncthreads();
        if (tid < NBUCK) { const int n = hist[tid]; basek[tid] = n ? atomicAdd(&cnt[tid], n) : 0; }
        __syncthreads();
        const int nrows = NWAVES * rows_per, brow0 = (int)blockIdx.x * nrows;
        for (int i = tid; i < nrows; i += NWAVES * 64) { const int t = brow0 + i; if (t < T_TOK) { const int ri = rowinfo[i]; const int k = ri & 255; list[(size_t)k * T_TOK + basek[k] + (ri >> 8)] = t; } }
    }
}

__device__ __forceinline__ void build_moe_tab(const Args& a, int l, LAS int* tab, int wave_) {
    const int tid = wave_ * 64 + lane_id_opaque();
    const int* cnt = (const int*)(a.ws + WS_CTL) + CW_CNT + l * 32;
    if (tid < 32) tab[tid] = (tid < NBUCK) ? cnt[tid] : 0;
    __syncthreads();
    if (tid < NBUCK) {
        int base = 0;
#pragma unroll 1
        for (int j = 0; j < tid; ++j) base += (tab[j] + 255) >> 8;
        const int mine = (tab[tid] + 255) >> 8;
#pragma unroll 1
        for (int i = 0; i < mine; ++i) { tab[32 + base + i] = tid; tab[192 + base + i] = i * 256; }
        if (tid == NBUCK - 1) tab[352] = base + mine;
    }
    __syncthreads();
}

__device__ __forceinline__ void phase_final(const Args& a, int gw, int ngw, float oscale, const XcdBarrier& bar, int wave_) {
    const int lane = lane_id_opaque();
    const bf16_t* XB = (const bf16_t*)(a.ws + WS_H);
    const int rows_per = (T_TOK + ngw - 1) / ngw, row0 = gw * rows_per;
    f32x4 g[4];
#pragma unroll
    for (int j = 0; j < 4; ++j) g[j] = *(const f32x4*)(a.g_final + 8 * lane + 512 * (j >> 1) + 4 * (j & 1));
    u32x4 nx[2][2];
#pragma unroll
    for (int rr = 0; rr < 2; ++rr)
#pragma unroll
        for (int jj = 0; jj < 2; ++jj) nx[rr][jj] = *((const u32x4*)(XB + (size_t)(row0 + rr) * DM) + lane + 64 * jj);
#pragma unroll 1
    for (int i = 0; i < rows_per; i += 2) {
        const int t0 = row0 + i; if (t0 >= T_TOK) break;
        u32x4 xv[2][2];
#pragma unroll
        for (int rr = 0; rr < 2; ++rr)
#pragma unroll
            for (int jj = 0; jj < 2; ++jj) xv[rr][jj] = nx[rr][jj];
        { const int tn = (i + 2 < rows_per) ? t0 + 2 : t0;
#pragma unroll
          for (int rr = 0; rr < 2; ++rr)
#pragma unroll
              for (int jj = 0; jj < 2; ++jj) nx[rr][jj] = *((const u32x4*)(XB + (size_t)(tn + rr) * DM) + lane + 64 * jj); }
#pragma unroll
        for (int rr = 0; rr < 2; ++rr) {
            const f32x4 v[4] = {bf4_lo(xv[rr][0]), bf4_hi(xv[rr][0]), bf4_lo(xv[rr][1]), bf4_hi(xv[rr][1])};
            float ss = 0.f;
#pragma unroll
            for (int j = 0; j < 4; ++j) ss += (v[j][0] * v[j][0] + v[j][1] * v[j][1]) + (v[j][2] * v[j][2] + v[j][3] * v[j][3]);
            ss = wave_sum_l(ss, lane);
            const float rstd = rsqrtf(ss * (1.f / 1024.f) + EPS) * oscale;
            float* orow = a.out + (size_t)(t0 + rr) * DM;
#pragma unroll
            for (int j = 0; j < 4; ++j) *(f32x4*)(orow + 8 * lane + 512 * (j >> 1) + 4 * (j & 1)) = v[j] * rstd * g[j];
        }
    }
}

typedef float f32x16 __attribute__((ext_vector_type(16)));
typedef short s16x4 __attribute__((ext_vector_type(4)));
typedef short v4i16_t __attribute__((ext_vector_type(4)));
#define MFMA32(a, b, c) __builtin_amdgcn_mfma_f32_32x32x16_bf16((a), (b), (c), 0, 0, 0)
__device__ __forceinline__ int crow(int i, int h) { return (i & 3) + 8 * (i >> 2) + 4 * h; }
__device__ __forceinline__ unsigned cvtpk(float lo, float hi) { typedef float f2_t __attribute__((ext_vector_type(2))); typedef __bf16 b2_t __attribute__((ext_vector_type(2)));
    f2_t v = {lo, hi}; b2_t b = __builtin_convertvector(v, b2_t); return __builtin_bit_cast(unsigned, b); }
__device__ __forceinline__ bf16x8 pack8(const f32x16& x, int s) { u32x4 p; p.x = cvtpk(x[8 * s], x[8 * s + 1]); p.y = cvtpk(x[8 * s + 2], x[8 * s + 3]); p.z = cvtpk(x[8 * s + 4], x[8 * s + 5]); p.w = cvtpk(x[8 * s + 6], x[8 * s + 7]); return __builtin_bit_cast(bf16x8, p); }
__device__ __forceinline__ void halves(float v, float& v0, float& v1) { auto rr = __builtin_amdgcn_permlane32_swap(__float_as_uint(v), __float_as_uint(v), false, false); v0 = __uint_as_float(rr[0]); v1 = __uint_as_float(rr[1]); }
__device__ __forceinline__ s16x4 vtr(const LAS unsigned char* p) { return __builtin_bit_cast(s16x4, __builtin_amdgcn_ds_read_tr16_b64_v4i16((LAS v4i16_t*)p)); }
constexpr int VP = 144;
__device__ __forceinline__ bf16x8 vt_frag(const LAS unsigned char* vl, int vtr0, int s, int db) {
    const s16x4 lo = vtr(vl + vtr0 + s * (16 * VP) + db * 64), hi = vtr(vl + vtr0 + s * (16 * VP) + 8 * VP + db * 64);
    return __builtin_shufflevector(lo, hi, 0, 1, 2, 3, 4, 5, 6, 7); }

#define KT_WRITE(KL, KV) do { _Pragma("unroll") for (int i = 0; i < 4; ++i) *(LAS u32x4*)((KL) + (vrow + 8 * i) * 144 + vseg * 16) = KV[i]; } while (0)
#define KT_FRAG(KL, D0) (*(const LAS bf16x8*)((KL) + r * 144 + 32 * (D0) + 16 * hh))
#ifndef SB_EARLY_EXIT
#define SB_EARLY_EXIT 1
#endif
__device__ __forceinline__ void sb_item(const bf16_t* U, const float* gh  , bf16_t* Y, LAS unsigned char* vl, int b, int h, int qt, int lane) {
    const int r = lane & 31, hh = lane >> 5;
    const size_t rowb = (size_t)b * SEQ;
    const bf16_t* Qp = U + (rowb + 32 * qt + r) * LDU + OFF_SB + h * 64 + 8 * hh;
    bf16x8 qf[4];
#pragma unroll
    for (int d0 = 0; d0 < 4; ++d0) qf[d0] = *(const bf16x8*)(Qp + 16 * d0);
    f32x16 o0, o1;
#pragma unroll
    for (int i = 0; i < 16; ++i) { o0[i] = 0.f; o1[i] = 0.f; }
    float carry = 1.f;
    f32x4 gha[4], ghb[4];
#pragma unroll
    for (int g = 0; g < 4; ++g) { gha[g] = *(const f32x4*)(gh + 8 * g + 4 * hh); ghb[g] = *(const f32x4*)(gh + 32 + 8 * g + 4 * hh); }
    const bf16_t* Kb = U + rowb * LDU + OFF_SB + 384 + h * 64; const bf16_t* Vb = Kb + 384;
    const int vrow = lane >> 3, vseg = lane & 7;
    const int i16 = lane & 15, q4 = i16 >> 2, p4 = i16 & 3, blk = (lane >> 4) & 1;
    const int vtr0 = (4 * hh + q4) * VP + (16 * blk + 4 * p4) * 2;
    unsigned loff[4];
#pragma unroll
    for (int i = 0; i < 4; ++i) loff[i] = (unsigned)((vrow + 8 * i) * LDU + 8 * vseg) * 2u;
#define SB_LOAD(KT, KF, VV) do { const char* kb_ = (const char*)(Kb + (size_t)(32 * (KT)) * LDU); \
        _Pragma("unroll") for (int i = 0; i < 4; ++i) { KF[i] = *(const u32x4*)(kb_ + loff[i]); VV[i] = *(const u32x4*)(kb_ + 768 + loff[i]); } } while (0)
#define SB_TILE(KT, KF, VV) do { \
        KT_WRITE(kl, KF); \
        _Pragma("unroll") for (int i = 0; i < 4; ++i) *(LAS u32x4*)(vl + (vrow + 8 * i) * VP + vseg * 16) = VV[i]; \
        f32x16 sc; \
        _Pragma("unroll") for (int i = 0; i < 16; ++i) sc[i] = 0.f; \
        _Pragma("unroll") for (int d0 = 0; d0 < 4; ++d0) sc = MFMA32(KT_FRAG(kl, d0), qf[d0], sc); \
        float sg[16], kp[16]; \
        _Pragma("unroll") for (int i = 0; i < 16; ++i) { \
            const float z2 = fminf(sc[i] * (-0.125f * 1.4426950408889634f), 115.f); \
            const float e = __builtin_amdgcn_exp2f(z2); float sig = __builtin_amdgcn_rcpf(1.f + e); float keep = e * sig; \
            if ((KT) == qt) { const bool valid = crow(i, hh) < r; sig = valid ? sig : 0.f; keep = valid ? keep : 1.f; } \
            sg[i] = sig; kp[i] = keep; } \
        float G0[4], G1[4], PP[4]; \
        _Pragma("unroll") for (int g = 0; g < 4; ++g) { const float G = (kp[4 * g] * kp[4 * g + 1]) * (kp[4 * g + 2] * kp[4 * g + 3]); halves(G, G0[g], G1[g]); PP[g] = G0[g] * G1[g]; } \
        float SP[4]; SP[3] = 1.f; SP[2] = PP[3]; SP[1] = PP[3] * PP[2]; SP[0] = SP[1] * PP[1]; \
        const float total = SP[0] * PP[0]; \
        _Pragma("unroll") for (int g = 0; g < 4; ++g) { \
            const float r3 = carry * SP[g] * (hh ? 1.f : G1[g]); \
            const float r2 = r3 * kp[4 * g + 3], r1 = r2 * kp[4 * g + 2], r0 = r1 * kp[4 * g + 1]; \
            sc[4 * g + 3] = sg[4 * g + 3] * r3; sc[4 * g + 2] = sg[4 * g + 2] * r2; sc[4 * g + 1] = sg[4 * g + 1] * r1; sc[4 * g] = sg[4 * g] * r0; } \
        carry *= total; \
        const bf16x8 pb0 = pack8(sc, 0), pb1 = pack8(sc, 1); \
        o0 = MFMA32(vt_frag(vl, vtr0, 0, 0), pb0, o0); o0 = MFMA32(vt_frag(vl, vtr0, 1, 0), pb1, o0); \
        o1 = MFMA32(vt_frag(vl, vtr0, 0, 1), pb0, o1); o1 = MFMA32(vt_frag(vl, vtr0, 1, 1), pb1, o1); } while (0)
#define SB_DONE() (SB_EARLY_EXIT && __builtin_amdgcn_ballot_w64(carry >= 1e-37f) == 0ull)
    {
        u32x4 kA[4], kB[4], vA[4], vB[4];
        LAS unsigned char* kl = vl + 4608;
        int kt = qt;
        SB_LOAD(kt, kA, vA);
#pragma unroll 1
        for (;;) {
            if (kt > 0) SB_LOAD(kt - 1, kB, vB);
            SB_TILE(kt, kA, vA);
            if (kt == 0 || SB_DONE()) break;
            --kt;
            if (kt > 0) SB_LOAD(kt - 1, kA, vA);
            SB_TILE(kt, kB, vB);
            if (kt == 0 || SB_DONE()) break;
            --kt;
        }
    }
#undef SB_LOAD
#undef SB_TILE
#undef SB_DONE
    float ss = 0.f;
#pragma unroll
    for (int i = 0; i < 16; ++i) ss += o0[i] * o0[i] + o1[i] * o1[i];
    float s0, s1; halves(ss, s0, s1);
    const float rs = rsqrtf((s0 + s1) * (1.f / 64.f) + EPS);
    bf16_t* yr = Y + (rowb + 32 * qt + r) * 1024 + (10 + h) * 64;
#pragma unroll
    for (int g = 0; g < 4; ++g) {
        const int d0 = 8 * g + 4 * hh;
        const f32x4 ga = gha[g], gb = ghb[g];
        u32x2 wa, wb; wa.x = cvtpk(o0[4 * g] * rs * ga[0], o0[4 * g + 1] * rs * ga[1]); wa.y = cvtpk(o0[4 * g + 2] * rs * ga[2], o0[4 * g + 3] * rs * ga[3]);
        wb.x = cvtpk(o1[4 * g] * rs * gb[0], o1[4 * g + 1] * rs * gb[1]); wb.y = cvtpk(o1[4 * g + 2] * rs * gb[2], o1[4 * g + 3] * rs * gb[3]);
        *(u32x2*)(yr + d0) = wa; *(u32x2*)(yr + 32 + d0) = wb;
    }
}
__device__ __forceinline__ void phase_sb(const Args& a, int l, LAS unsigned char* lds, int gw, int ngw, int wave_) {
    const int lane = lane_id_opaque();
    LAS unsigned char* vl = lds + wave_ * 16384;
    const bf16_t* U = (const bf16_t*)(a.ws + WS_U); bf16_t* Y = (bf16_t*)(a.ws + WS_Y);
    for (int it = gw; it < NB * 6 * 128; it += ngw) {
        const int qt = 127 - (it % 128), h = (it / 128) % 6, b = it / 768;
        sb_item(U, a.g_head + l * 1024 + (10 + h) * 64, Y, vl, b, h, qt, lane);
    }
}


#ifdef TS_DIL
#define TSD(k) do { if (tsacc) { const unsigned long long t_ = __builtin_amdgcn_s_memrealtime(); if (TS_DIL == (k)) *tsacc += t_ - tsd_; tsd_ = t_; } } while (0)
#else
#define TSD(k) do { } while (0)
#endif
__device__ __forceinline__ void dil_item(const bf16_t* U, bf16_t* OP, int op_pitch, float* LSE, LAS unsigned char* vl, int b, int h, int p, int qi, int lane, unsigned long long* tsacc) {
#ifdef TS_DIL
    unsigned long long tsd_ = __builtin_amdgcn_s_memrealtime();
#endif
    const int r = lane & 31, hh = lane >> 5;
    const int sh = 2 * p, d = 1 << sh, nblk = (SEQ >> sh) / 32, c = qi / nblk, m0 = 32 * (qi % nblk);
    const size_t rowb = (size_t)b * SEQ;
    const int tq = ((m0 + r) << sh) + c;
    const bf16_t* Qp = U + (rowb + tq) * LDU + OFF_DIL + h * 64 + 8 * hh;
    bf16x8 qf[4];
#pragma unroll
    for (int d0 = 0; d0 < 4; ++d0) qf[d0] = *(const bf16x8*)(Qp + 16 * d0);
    const float sb = exp2f(-8.f * (float)(h + 1) / 6.f) * (float)d * 1.4426950408889634f;
    f32x16 o0, o1;
#pragma unroll
    for (int i = 0; i < 16; ++i) { o0[i] = 0.f; o1[i] = 0.f; }
    float m_run = -1e30f, l_run = 0.f;
    const bf16_t* Kb = U + rowb * LDU + OFF_DIL + 384 + h * 64; const bf16_t* Vb = Kb + 384;
    const int vrow = lane >> 3, vseg = lane & 7;
    const int i16 = lane & 15, q4 = i16 >> 2, p4 = i16 & 3, blk = (lane >> 4) & 1;
    const int vtr0 = (4 * hh + q4) * VP + (16 * blk + 4 * p4) * 2;
    unsigned loff[4];
#pragma unroll
    for (int i = 0; i < 4; ++i) loff[i] = (unsigned)(((vrow + 8 * i) << sh) * LDU + 8 * vseg) * 2u;
#define DL_LOAD(J, KF, VV) do { const int mk0_ = m0 - 128 + 32 * (J); const char* kb_ = (const char*)(Kb + (size_t)((mk0_ << sh) + c) * LDU); \
        _Pragma("unroll") for (int i = 0; i < 4; ++i) { KF[i] = *(const u32x4*)(kb_ + loff[i]); VV[i] = *(const u32x4*)(kb_ + 768 + loff[i]); } } while (0)
#define DL_TILE(J, KF, VV) do { \
        KT_WRITE(kl, KF); \
        _Pragma("unroll") for (int i = 0; i < 4; ++i) *(LAS u32x4*)(vl + (vrow + 8 * i) * VP + vseg * 16) = VV[i]; \
        f32x16 sc; \
        _Pragma("unroll") for (int i = 0; i < 16; ++i) sc[i] = 0.f; \
        _Pragma("unroll") for (int d0 = 0; d0 < 4; ++d0) sc = MFMA32(KT_FRAG(kl, d0), qf[d0], sc); \
        float mx = -1e30f; \
        const float base2 = -sb * (float)(r + 128 - 32 * (J) - 4 * hh); \
        _Pragma("unroll") for (int i = 0; i < 16; ++i) { \
            const int cr = crow(i, hh); \
            float v = fmaf(sb, (float)((i & 3) + 8 * (i >> 2)), fmaf(sc[i], 0.125f * 1.4426950408889634f, base2)); \
            if ((J) == 4) v = (cr <= r) ? v : -1e30f; \
            if ((J) == 0) v = (cr >= r) ? v : -1e30f; \
            sc[i] = v; mx = fmaxf(mx, v); } \
        float mx0, mx1; halves(mx, mx0, mx1); \
        const float m_new = fmaxf(m_run, fmaxf(mx0, mx1)); \
        const float corr = __builtin_amdgcn_exp2f(m_run - m_new); \
        float ps = 0.f; \
        _Pragma("unroll") for (int i = 0; i < 16; ++i) { const float pe = __builtin_amdgcn_exp2f(sc[i] - m_new); sc[i] = pe; ps += pe; } \
        float ps0, ps1; halves(ps, ps0, ps1); \
        l_run = l_run * corr + (ps0 + ps1); \
        if (__builtin_amdgcn_ballot_w64(m_new != m_run) != 0ull) { _Pragma("unroll") for (int i = 0; i < 16; ++i) { o0[i] *= corr; o1[i] *= corr; } } \
        m_run = m_new; \
        const bf16x8 pb0 = pack8(sc, 0), pb1 = pack8(sc, 1); \
        o0 = MFMA32(vt_frag(vl, vtr0, 0, 0), pb0, o0); o0 = MFMA32(vt_frag(vl, vtr0, 1, 0), pb1, o0); \
        o1 = MFMA32(vt_frag(vl, vtr0, 0, 1), pb0, o1); o1 = MFMA32(vt_frag(vl, vtr0, 1, 1), pb1, o1); } while (0)
    {
        TSD(0);
        const int jmin = (m0 >= 128) ? 0 : (4 - m0 / 32);
        u32x4 kA[4], kB[4], vA[4], vB[4];
        LAS unsigned char* kl = vl + 4608;
        int j = 4;
        DL_LOAD(j, kA, vA);
#pragma unroll 1
        for (;;) {
            if (j > jmin) DL_LOAD(j - 1, kB, vB);
            DL_TILE(j, kA, vA);
            if (j == jmin) break;
            --j;
            if (j > jmin) DL_LOAD(j - 1, kA, vA);
            DL_TILE(j, kB, vB);
            if (j == jmin) break;
            --j;
        }
    }
#undef DL_LOAD
#undef DL_TILE
    TSD(1);
    const float inv = 1.f / l_run;
    bf16_t* orow = OP + (rowb + tq) * op_pitch + h * 64;
#pragma unroll
    for (int g = 0; g < 4; ++g) {
        const int d0 = 8 * g + 4 * hh;
        u32x2 wa, wb; wa.x = cvtpk(o0[4 * g] * inv, o0[4 * g + 1] * inv); wa.y = cvtpk(o0[4 * g + 2] * inv, o0[4 * g + 3] * inv);
        wb.x = cvtpk(o1[4 * g] * inv, o1[4 * g + 1] * inv); wb.y = cvtpk(o1[4 * g + 2] * inv, o1[4 * g + 3] * inv);
        *(u32x2*)(orow + d0) = wa; *(u32x2*)(orow + 32 + d0) = wb;
    }
    if (hh == 0) LSE[(rowb + tq) * 6 + h] = m_run * 0.6931471805599453f + __logf(l_run);
    TSD(2);
}
__device__ __forceinline__ bf16_t* dil_op(unsigned char* ws, int p) { return (p == 0) ? (bf16_t*)(ws + WS_Y) + 256 : ((p == 1) ? (bf16_t*)(ws + WS_OP1) : (bf16_t*)(ws + WS_OP2)); }
__device__ __forceinline__ int dil_pitch(int p) { return p == 0 ? 1024 : 384; }
__device__ __forceinline__ void phase_dil(const Args& a, int l, LAS unsigned char* lds, int gw, int ngw, int wave_, int p_lo, int p_hi) {
    const int lane = lane_id_opaque();
    LAS unsigned char* vl = lds + wave_ * 16384;
    const bf16_t* U = (const bf16_t*)(a.ws + WS_U);
    for (int it = gw; it < (p_hi - p_lo) * NB * 6 * 128; it += ngw) {
        const int qi = it % 128, h = (it / 128) % 6, b = (it / 768) % NB, p = p_lo + it / (768 * NB);
        dil_item(U, dil_op(a.ws, p), dil_pitch(p), (float*)(a.ws + WS_LSE) + (size_t)p * T_TOK * 6, vl, b, h, p, qi, lane,
#ifdef TS_DIL
                 (gw == 77 && lane == 0 && l == 0) ? (unsigned long long*)((unsigned*)(a.ws + WS_CTL) + 12288) + 40 : nullptr
#else
                 nullptr
#endif
                 );
    }
}
__device__ __forceinline__ void phase_dil_merge(const Args& a, int l, int gw, int ngw) {
    const int lane = lane_id_opaque(); const int pr = lane >> 3, ch = lane & 7;
    const bf16_t* O0 = dil_op(a.ws, 0); const bf16_t* O1 = dil_op(a.ws, 1); const bf16_t* O2 = dil_op(a.ws, 2);
    const float* L0 = (const float*)(a.ws + WS_LSE); const float* L1 = L0 + (size_t)T_TOK * 6; const float* L2 = L1 + (size_t)T_TOK * 6;
    bf16_t* Y = (bf16_t*)(a.ws + WS_Y);
    for (int it = gw; it < T_TOK * 6 / 8; it += ngw) {
        const int pi = it * 8 + pr; const int t = pi / 6, hd = pi - 6 * t;
        const float l0 = L0[pi], l1 = L1[pi], l2 = L2[pi];
        const size_t o = (size_t)t * 384 + hd * 64 + ch * 8;
        const u32x4 a0 = *(const u32x4*)(O0 + (size_t)t * 1024 + hd * 64 + ch * 8), a1 = *(const u32x4*)(O1 + o), a2 = *(const u32x4*)(O2 + o);
        const float mx = fmaxf(l0, fmaxf(l1, l2));
        float w0 = __expf(l0 - mx), w1 = __expf(l1 - mx), w2 = __expf(l2 - mx); const float inv = 1.f / (w0 + w1 + w2); w0 *= inv; w1 *= inv; w2 *= inv;
        float v[8]; float ss = 0.f;
#pragma unroll
        for (int q = 0; q < 4; ++q) {
            v[2 * q]     = w0 * __uint_as_float(a0[q] << 16) + w1 * __uint_as_float(a1[q] << 16) + w2 * __uint_as_float(a2[q] << 16);
            v[2 * q + 1] = w0 * __uint_as_float(a0[q] & 0xffff0000u) + w1 * __uint_as_float(a1[q] & 0xffff0000u) + w2 * __uint_as_float(a2[q] & 0xffff0000u);
            ss += v[2 * q] * v[2 * q] + v[2 * q + 1] * v[2 * q + 1];
        }
#pragma unroll
        for (int of = 1; of < 8; of <<= 1) ss += bperm_f(ss, lane ^ of);
        const float rs = rsqrtf(ss * (1.f / 64.f) + EPS);
        const float* gh = a.g_head + l * 1024 + (4 + hd) * 64 + ch * 8;
        const f32x4 ga = *(const f32x4*)gh, gb = *(const f32x4*)(gh + 4);
        u32x4 w; w.x = cvtpk(v[0] * rs * ga[0], v[1] * rs * ga[1]); w.y = cvtpk(v[2] * rs * ga[2], v[3] * rs * ga[3]); w.z = cvtpk(v[4] * rs * gb[0], v[5] * rs * gb[1]); w.w = cvtpk(v[6] * rs * gb[2], v[7] * rs * gb[3]);
        *(u32x4*)(Y + (size_t)t * 1024 + (4 + hd) * 64 + ch * 8) = w;
    }
}

__device__ __forceinline__ float scan_add64(float v, int lane) {
#pragma unroll
    for (int o = 1; o < 64; o <<= 1) { const float t = bperm_f(v, lane - o); v = (lane >= o) ? v + t : v; }
    return v; }
__device__ __forceinline__ float scan_max64(float v, int lane) {
#pragma unroll
    for (int o = 1; o < 64; o <<= 1) { const float t = bperm_f(v, lane - o); v = (lane >= o) ? fmaxf(v, t) : v; }
    return v; }
__device__ __forceinline__ float bcast63(float v) { return __int_as_float(__builtin_amdgcn_readlane(__float_as_int(v), 63)); }

__device__ __forceinline__ void ml_b1_item(const Args& a, int l, LAS unsigned char* wl  , int b, int h, int c, int half) {
    const int bh = b * 4 + h;
    const size_t rowb = (size_t)b * SEQ + 128 * c;
    unsigned char* mls = a.ws + WS_MLS;
    LAS float* cw = (LAS float*)(wl + 9216);
    float w0, w1;
    const bf16_t* U = (const bf16_t*)(a.ws + WS_U);
    bf16_t* Qm = (bf16_t*)(a.ws + WS_QKV); bf16_t* Km = Qm + (size_t)T_TOK * 256; bf16_t* Vm = Km + (size_t)T_TOK * 256;
    { const int lane = lane_id_opaque();
    const float* GATE = (const float*)(a.ws + WS_GATE);
    const float gbi = a.gate_bias[l * 8 + h], gbf = a.gate_bias[l * 8 + 4 + h];
    const size_t t0 = rowb + lane, t1 = t0 + 64;
    const float ig0 = GATE[t0 * 8 + h] + gbi, ig1 = GATE[t1 * 8 + h] + gbi;
    const float lf0 = -softplusf_(-(GATE[t0 * 8 + 4 + h] + gbf)), lf1 = -softplusf_(-(GATE[t1 * 8 + 4 + h] + gbf));
    const float c0 = scan_add64(lf0, lane); const float c1 = scan_add64(lf1, lane) + bcast63(c0);
    const float a0 = ig0 - c0, a1 = ig1 - c1;
    const float p0 = scan_max64(a0, lane); const float p1 = fmaxf(scan_max64(a1, lane), bcast63(p0));
    const float Amax = bcast63(p1), Lsum = bcast63(c1);
    if (half == 0) {
    ((float*)(mls + MLS_CUM))[t0 * 4 + h] = c0; ((float*)(mls + MLS_CUM))[t1 * 4 + h] = c1;
    ((float*)(mls + MLS_AA))[t0 * 4 + h] = a0;  ((float*)(mls + MLS_AA))[t1 * 4 + h] = a1;
    ((float*)(mls + MLS_PM))[t0 * 4 + h] = p0;  ((float*)(mls + MLS_PM))[t1 * 4 + h] = p1;
    if (lane == 0) { ((float*)(mls + MLS_AMAX))[bh * 32 + c] = Amax; ((float*)(mls + MLS_LSUM))[bh * 32 + c] = Lsum; }
    }
    w0 = __expf(a0 - Amax); w1 = __expf(a1 - Amax);
#pragma unroll
    for (int j = 0; j < 4; ++j) cw[j * 64 + lane] = a.conv_w[(l * 4 + j) * 256 + h * 64 + lane];
    cw[256 + lane] = a.conv_b[l * 256 + h * 64 + lane];
    }
    const bf16_t* WT = (const bf16_t*)(mls + MLS_WT) + (size_t)(l * 3 * 4 + h) * 4096;
    LAS unsigned char* vt = wl; LAS unsigned char* kt = wl + 4608;
    f32x16 acc[2][2], nacc[2];
#pragma unroll
    for (int i = 0; i < 16; ++i) { acc[0][0][i] = 0.f; acc[0][1][i] = 0.f; acc[1][0][i] = 0.f; acc[1][1][i] = 0.f; nacc[0][i] = 0.f; nacc[1][i] = 0.f; }
    bf16x8 ones;
#pragma unroll
    for (int j = 0; j < 8; ++j) ones[j] = (short)0x3F80;
#pragma unroll 1
    for (int st = 2 * half; st < 2 * half + 2; ++st) {
        const int lane = lane_id_opaque(); const int r = lane & 31, hh = lane >> 5;
        const int i16 = lane & 15, q4 = i16 >> 2, p4 = i16 & 3, blk = (lane >> 4) & 1;
        const int vtr0 = (4 * hh + q4) * VP + (16 * blk + 4 * p4) * 2;
        const size_t row = rowb + 32 * st + r; const int tt = 128 * c + 32 * st + r;
        const float wt = bperm_f((st < 2) ? w0 : w1, 32 * (st & 1) + r);
        bf16x8 xcf[4], xmf[4];
        bf16x8 xa[4][4];
#pragma unroll
        for (int d0 = 0; d0 < 4; ++d0) {
            const int ch = 16 * d0 + 8 * hh;
#pragma unroll
            for (int j = 0; j < 4; ++j) { const bool ok = (tt - 3 + j >= 0); const bf16x8 ld = *(const bf16x8*)(U + (ok ? row - 3 + j : row) * LDU + OFF_ML_X + h * 64 + ch);
                const u32x4 lu = __builtin_bit_cast(u32x4, ld); u32x4 z; z.x = ok ? lu.x : 0u; z.y = ok ? lu.y : 0u; z.z = ok ? lu.z : 0u; z.w = ok ? lu.w : 0u; xa[d0][j] = __builtin_bit_cast(bf16x8, z); }
        }
#pragma unroll
        for (int d0 = 0; d0 < 4; ++d0) {
            const int ch = 16 * d0 + 8 * hh;
            const bf16x8 (&x)[4] = xa[d0];
            xmf[d0] = x[3];
            float xv[8];
            { const f32x4 ba = *(const LAS f32x4*)(cw + 256 + ch), bb = *(const LAS f32x4*)(cw + 256 + ch + 4);
              xv[0] = ba[0]; xv[1] = ba[1]; xv[2] = ba[2]; xv[3] = ba[3]; xv[4] = bb[0]; xv[5] = bb[1]; xv[6] = bb[2]; xv[7] = bb[3]; }
#pragma unroll
            for (int j = 0; j < 4; ++j) { const f32x4 wa = *(const LAS f32x4*)(cw + j * 64 + ch), wb = *(const LAS f32x4*)(cw + j * 64 + ch + 4);
#pragma unroll
                for (int e = 0; e < 4; ++e) { xv[e] += wa[e] * bf2f((bf16_t)x[j][e]); xv[4 + e] += wb[e] * bf2f((bf16_t)x[j][4 + e]); } }
            u32x4 pk;
            pk.x = cvtpk(xv[0] * sigmoidf_(xv[0]), xv[1] * sigmoidf_(xv[1])); pk.y = cvtpk(xv[2] * sigmoidf_(xv[2]), xv[3] * sigmoidf_(xv[3]));
            pk.z = cvtpk(xv[4] * sigmoidf_(xv[4]), xv[5] * sigmoidf_(xv[5])); pk.w = cvtpk(xv[6] * sigmoidf_(xv[6]), xv[7] * sigmoidf_(xv[7]));
            xcf[d0] = __builtin_bit_cast(bf16x8, pk);
        }
#pragma unroll
        for (int w = 0; w < 3; ++w) {
            bf16x8 wf[2][4];
#pragma unroll
            for (int eb = 0; eb < 2; ++eb)
#pragma unroll
                for (int d0 = 0; d0 < 4; ++d0) wf[eb][d0] = *(const bf16x8*)(WT + (size_t)w * 4 * 4096 + (32 * eb + r) * 64 + 16 * d0 + 8 * hh);
#pragma unroll
            for (int eb = 0; eb < 2; ++eb) {
                f32x16 pr;
#pragma unroll
                for (int i = 0; i < 16; ++i) pr[i] = 0.f;
#pragma unroll
                for (int d0 = 0; d0 < 4; ++d0) pr = MFMA32(wf[eb][d0], (w == 2) ? xmf[d0] : xcf[d0], pr);
                bf16_t* dst = ((w == 0) ? Qm : (w == 1 ? Km : Vm)) + row * 256 + h * 64 + 32 * eb;
#pragma unroll
                for (int g = 0; g < 4; ++g) {
                    const int e0 = 8 * g + 4 * hh;
                    u32x2 o; o.x = cvtpk(pr[4 * g], pr[4 * g + 1]); o.y = cvtpk(pr[4 * g + 2], pr[4 * g + 3]);
                    *(u32x2*)(dst + e0) = o;
                    if (w == 1) { u32x2 k2; k2.x = cvtpk(pr[4 * g] * wt, pr[4 * g + 1] * wt); k2.y = cvtpk(pr[4 * g + 2] * wt, pr[4 * g + 3] * wt); *(LAS u32x2*)(kt + r * VP + (32 * eb + e0) * 2) = k2; }
                    if (w == 2) *(LAS u32x2*)(vt + r * VP + (32 * eb + e0) * 2) = o;
                }
            }
            __builtin_amdgcn_sched_barrier(0);
        }
#pragma unroll
        for (int sk = 0; sk < 2; ++sk) {
            const bf16x8 kb0 = vt_frag(kt, vtr0, sk, 0), kb1 = vt_frag(kt, vtr0, sk, 1), va0 = vt_frag(vt, vtr0, sk, 0), va1 = vt_frag(vt, vtr0, sk, 1);
            acc[0][0] = MFMA32(va0, kb0, acc[0][0]); acc[0][1] = MFMA32(va0, kb1, acc[0][1]);
            acc[1][0] = MFMA32(va1, kb0, acc[1][0]); acc[1][1] = MFMA32(va1, kb1, acc[1][1]);
            nacc[0] = MFMA32(ones, kb0, nacc[0]); nacc[1] = MFMA32(ones, kb1, nacc[1]);
        }
    }
    const int lane = lane_id_opaque(); const int r = lane & 31, hh = lane >> 5;
    float* CL = (float*)(a.ws + WS_CLOC) + ((size_t)half * 1024 + bh * 32 + c) * 4096;
#pragma unroll
    for (int eb = 0; eb < 2; ++eb)
#pragma unroll
        for (int db = 0; db < 2; ++db)
#pragma unroll
            for (int i = 0; i < 16; ++i) CL[(32 * eb + crow(i, hh)) * 64 + 32 * db + r] = acc[eb][db][i];
    if (hh == 0) { float* NL = (float*)(mls + MLS_NLOC) + ((size_t)half * 1024 + bh * 32 + c) * 64; NL[r] = nacc[0][0]; NL[32 + r] = nacc[1][0]; }
}

__device__ __forceinline__ void phase_ml_b2(const Args& a, int gthread, int nthreads) {
    unsigned char* mls = a.ws + WS_MLS;
    const float* AM = (const float*)(mls + MLS_AMAX); const float* LS = (const float*)(mls + MLS_LSUM);
    for (int idx = gthread; idx < 32 * 4096; idx += nthreads) {
        const int bh = idx >> 12, ed = idx & 4095;
        const float* CL = (const float*)(a.ws + WS_CLOC) + (size_t)bh * 32 * 4096 + ed;
        bf16_t* CT = (bf16_t*)(a.ws + WS_CT) + (size_t)bh * 32 * 4096 + ed;
        const bool isn = ed < 64;
        const float* NL = (const float*)(mls + MLS_NLOC) + (size_t)bh * 32 * 64 + (ed & 63);
        float* NCp = (float*)(mls + MLS_NC) + (size_t)bh * 32 * 64 + (ed & 63);
        float C = 0.f, n = 0.f, m = 0.f;
        float cl[32];
#pragma unroll
        for (int c = 0; c < 32; ++c) cl[c] = CL[(size_t)c * 4096] + CL[(size_t)(1024 + c) * 4096];
#pragma unroll
        for (int c = 0; c < 32; ++c) {
            CT[(size_t)c * 4096] = f2bf(C);
            if (isn) NCp[c * 64] = n;
            if (ed == 0) ((float*)(mls + MLS_MC))[bh * 32 + c] = m;
            const float A = AM[bh * 32 + c], L = LS[bh * 32 + c];
            const float M = fmaxf(m, A); const float dec = __expf(m - M), sc = __expf(A - M);
            C = dec * C + sc * cl[c];
            if (isn) n = dec * n + sc * (NL[c * 64] + NL[(1024 + c) * 64]);
            m = L + M;
        }
    }
}

__device__ __forceinline__ void ml_b3_item(const Args& a, int l, LAS unsigned char* wl, int b, int h, int c, int qt, int lane) {
    const int r = lane & 31, hh = lane >> 5, bh = b * 4 + h;
    const size_t rowc = (size_t)b * SEQ + 128 * c, rowq = rowc + 32 * qt + r;
    unsigned char* mls = a.ws + WS_MLS;
    const bf16_t* Qm = (const bf16_t*)(a.ws + WS_QKV); const bf16_t* Km = Qm + (size_t)T_TOK * 256; const bf16_t* Vm = Km + (size_t)T_TOK * 256;
    LAS float* atab = (LAS float*)(wl + 4608);
    atab[lane] = ((const float*)(mls + MLS_AA))[(rowc + lane) * 4 + h]; atab[64 + lane] = ((const float*)(mls + MLS_AA))[(rowc + 64 + lane) * 4 + h];
    const float cum_t = ((const float*)(mls + MLS_CUM))[rowq * 4 + h], pm_t = ((const float*)(mls + MLS_PM))[rowq * 4 + h];
    const float m_c = ((const float*)(mls + MLS_MC))[bh * 32 + c];
    const float M_t = fmaxf(m_c, pm_t), inter = __expf(m_c - M_t), m_t = cum_t + M_t;
    bf16x8 qf[4];
#pragma unroll
    for (int d0 = 0; d0 < 4; ++d0) qf[d0] = *(const bf16x8*)(Qm + rowq * 256 + h * 64 + 16 * d0 + 8 * hh);
    const bf16_t* og = (const bf16_t*)(a.ws + WS_U) + rowq * LDU + OFF_ML_O + h * 64;
    const float* gh = a.g_head + l * 1024 + h * 64;
    u32x2 oga[4], ogb[4]; f32x4 gha[4], ghb[4];
#pragma unroll
    for (int g = 0; g < 4; ++g) { const int d0 = 8 * g + 4 * hh; oga[g] = *(const u32x2*)(og + d0); ogb[g] = *(const u32x2*)(og + 32 + d0); gha[g] = *(const f32x4*)(gh + d0); ghb[g] = *(const f32x4*)(gh + 32 + d0); }
    const float* NCp = (const float*)(mls + MLS_NC) + (size_t)(bh * 32 + c) * 64;
    f32x4 nca[4], ncb[4];
#pragma unroll
    for (int d0 = 0; d0 < 4; ++d0) { nca[d0] = *(const f32x4*)(NCp + 16 * d0 + 8 * hh); ncb[d0] = *(const f32x4*)(NCp + 16 * d0 + 8 * hh + 4); }
    const bf16_t* CT = (const bf16_t*)(a.ws + WS_CT) + (size_t)(bh * 32 + c) * 4096;
    bf16x8 ctf[2][4];
#pragma unroll
    for (int d0 = 0; d0 < 4; ++d0) { ctf[0][d0] = *(const bf16x8*)(CT + (size_t)r * 64 + 16 * d0 + 8 * hh); ctf[1][d0] = *(const bf16x8*)(CT + (size_t)(32 + r) * 64 + 16 * d0 + 8 * hh); }
    f32x16 n0, n1;
#pragma unroll
    for (int i = 0; i < 16; ++i) { n0[i] = 0.f; n1[i] = 0.f; }
#pragma unroll
    for (int d0 = 0; d0 < 4; ++d0) { n0 = MFMA32(ctf[0][d0], qf[d0], n0); n1 = MFMA32(ctf[1][d0], qf[d0], n1); }
    float qn = 0.f;
#pragma unroll
    for (int d0 = 0; d0 < 4; ++d0) { const f32x4 na = nca[d0], nb = ncb[d0];
#pragma unroll
        for (int e = 0; e < 4; ++e) { qn += bf2f((bf16_t)qf[d0][e]) * na[e]; qn += bf2f((bf16_t)qf[d0][4 + e]) * nb[e]; } }
    float qn0, qn1; halves(qn, qn0, qn1); qn = qn0 + qn1;
#pragma unroll
    for (int i = 0; i < 16; ++i) { n0[i] *= inter; n1[i] *= inter; }
    float dsum = 0.f;
    const int vrow = lane >> 3, vseg = lane & 7;
    const int i16 = lane & 15, q4 = i16 >> 2, p4 = i16 & 3, blk = (lane >> 4) & 1;
    const int vtr0 = (4 * hh + q4) * VP + (16 * blk + 4 * p4) * 2;
    LAS unsigned char* vl = wl;
    unsigned loff[4];
#pragma unroll
    for (int i = 0; i < 4; ++i) loff[i] = (unsigned)((vrow + 8 * i) * 256 + 8 * vseg) * 2u;
#define B3_LOAD(KT, KF, VV) do { const size_t tb_ = (rowc + 32 * (KT)) * 256 + h * 64; const char* kb_ = (const char*)(Km + tb_); const char* vb_ = (const char*)(Vm + tb_); \
        _Pragma("unroll") for (int i = 0; i < 4; ++i) { KF[i] = *(const u32x4*)(kb_ + loff[i]); VV[i] = *(const u32x4*)(vb_ + loff[i]); } } while (0)
#define B3_TILE(KT, KF, VV) do { \
        KT_WRITE(kl, KF); \
        _Pragma("unroll") for (int i = 0; i < 4; ++i) *(LAS u32x4*)(vl + (vrow + 8 * i) * VP + vseg * 16) = VV[i]; \
        f32x16 sc; \
        _Pragma("unroll") for (int i = 0; i < 16; ++i) sc[i] = 0.f; \
        _Pragma("unroll") for (int d0 = 0; d0 < 4; ++d0) sc = MFMA32(KT_FRAG(kl, d0), qf[d0], sc); \
        _Pragma("unroll") for (int g = 0; g < 4; ++g) { \
            const f32x4 av = *(const LAS f32x4*)(atab + 32 * (KT) + 8 * g + 4 * hh); \
            _Pragma("unroll") for (int e = 0; e < 4; ++e) { const int i = 4 * g + e; float dm = __expf(av[e] - M_t); if ((KT) == qt && crow(i, hh) > r) dm = 0.f; const float pv = sc[i] * dm; sc[i] = pv; dsum += pv; } } \
        const bf16x8 pb0 = pack8(sc, 0), pb1 = pack8(sc, 1); \
        n0 = MFMA32(vt_frag(vl, vtr0, 0, 0), pb0, n0); n0 = MFMA32(vt_frag(vl, vtr0, 1, 0), pb1, n0); \
        n1 = MFMA32(vt_frag(vl, vtr0, 0, 1), pb0, n1); n1 = MFMA32(vt_frag(vl, vtr0, 1, 1), pb1, n1); } while (0)
    {
        u32x4 kA[4], kB[4], vA[4], vB[4];
        LAS unsigned char* kl = wl + 8192;
        int kt = 0;
        B3_LOAD(kt, kA, vA);
#pragma unroll 1
        for (;;) {
            if (kt < qt) B3_LOAD(kt + 1, kB, vB);
            B3_TILE(kt, kA, vA);
            if (kt == qt) break;
            ++kt;
            if (kt < qt) B3_LOAD(kt + 1, kA, vA);
            B3_TILE(kt, kB, vB);
            if (kt == qt) break;
            ++kt;
        }
    }
#undef B3_LOAD
#undef B3_TILE
    float ds0, ds1; halves(dsum, ds0, ds1);
    const float den = inter * qn + (ds0 + ds1);
    const float hinv = 1.f / fmaxf(fabsf(den), __expf(-m_t));
    float ss = 0.f;
#pragma unroll
    for (int g = 0; g < 4; ++g) {
        const int d0 = 8 * g + 4 * hh;
        const u32x2 ga = oga[g], gb = ogb[g];
        const float oa[4] = {__uint_as_float(ga.x << 16), __uint_as_float(ga.x & 0xffff0000u), __uint_as_float(ga.y << 16), __uint_as_float(ga.y & 0xffff0000u)};
        const float ob[4] = {__uint_as_float(gb.x << 16), __uint_as_float(gb.x & 0xffff0000u), __uint_as_float(gb.y << 16), __uint_as_float(gb.y & 0xffff0000u)};
#pragma unroll
        for (int e = 0; e < 4; ++e) { const float va = sigmoidf_(oa[e]) * n0[4 * g + e] * hinv, vb = sigmoidf_(ob[e]) * n1[4 * g + e] * hinv; n0[4 * g + e] = va; n1[4 * g + e] = vb; ss += va * va + vb * vb; }
    }
    float s0, s1; halves(ss, s0, s1);
    const float rs = rsqrtf((s0 + s1) * (1.f / 64.f) + EPS);
    bf16_t* yr = (bf16_t*)(a.ws + WS_Y) + rowq * 1024 + h * 64;
#pragma unroll
    for (int g = 0; g < 4; ++g) {
        const int d0 = 8 * g + 4 * hh;
        const f32x4 ga = gha[g], gb = ghb[g];
        u32x2 wa, wb; wa.x = cvtpk(n0[4 * g] * rs * ga[0], n0[4 * g + 1] * rs * ga[1]); wa.y = cvtpk(n0[4 * g + 2] * rs * ga[2], n0[4 * g + 3] * rs * ga[3]);
        wb.x = cvtpk(n1[4 * g] * rs * gb[0], n1[4 * g + 1] * rs * gb[1]); wb.y = cvtpk(n1[4 * g + 2] * rs * gb[2], n1[4 * g + 3] * rs * gb[3]);
        *(u32x2*)(yr + d0) = wa; *(u32x2*)(yr + 32 + d0) = wb;
    }
}
__device__ __forceinline__ void phase_ml_b1(const Args& a, int l, LAS unsigned char* lds, int gw, int ngw, int wave_) {
    for (int it = gw; it < NB * 4 * 32 * 2; it += ngw) ml_b1_item(a, l, lds + wave_ * 16384, it / 256, (it / 64) & 3, (it >> 1) & 31, it & 1);
}
__device__ __forceinline__ void phase_ml_b3(const Args& a, int l, LAS unsigned char* lds, int gw, int ngw, int wave_) {
    const int lane = lane_id_opaque();
    for (int it = gw, k = 0; it < NB * 4 * 32 * 4; it += ngw, ++k) ml_b3_item(a, l, lds + wave_ * 16384, it / 512, (it / 128) & 3, (it >> 2) & 31, (k & 1) ? (it & 3) : 3 - (it & 3), lane);
}

__device__ __forceinline__ Args load_args() {
#if defined(__HIP_DEVICE_COMPILE__)
    typedef const __attribute__((address_space(4))) Args* KArgs;
    KArgs p_ = (KArgs)__builtin_amdgcn_kernarg_segment_ptr(); asm volatile("" : "+s"(p_)); return *p_;
#else
    return Args{};
#endif
}
#define KA() load_args()
__global__ void __launch_bounds__(NWAVES * 64, 2) fwd(Args a_unused) {
    extern __shared__ __attribute__((aligned(16))) unsigned char lds_raw[];
    LAS unsigned char* lds = (LAS unsigned char*)lds_raw;
    const int wave = __builtin_amdgcn_readfirstlane((int)threadIdx.x >> 6);
    const int G = gridDim.x, gw = blockIdx.x * NWAVES + wave, ngw = G * NWAVES;
    volatile LAS unsigned* MISC = (volatile LAS unsigned*)(lds + MISC_OFF);
    { const int t0 = wave * 64 + lane_id_opaque(); if (t0 < 32) MISC[t0] = 0u; }
    __syncthreads();
#if defined(MK_SPLIT)
    int lo, hi; unsigned* ctl; { const Args a = KA(); ctl = (unsigned*)(a.ws + WS_CTL); lo = a.ph_lo; hi = a.ph_hi; }
#else
    constexpr int lo = 0, hi = 22; unsigned* ctl; { const Args a = KA(); ctl = (unsigned*)(a.ws + WS_CTL); }
#endif
    XcdBarrier bar; bar.bar = ctl + CW_BAR; bar.x = 0; bar.st = nullptr;
    if (hi - lo > 1) bar = xcd_barrier_post(ctl + CW_BAR, MISC + 8, wave == 0 && lane_id_opaque() == 0);
#define IN(k) (lo <= (k) && (k) < hi)
#ifndef DISMASK
#define DISMASK 0
#endif
#define DIS(k) ((DISMASK >> (k)) & 1)
#ifndef REPMASK
#define REPMASK 0
#endif
#define NREP(k) ((((REPMASK) >> (k)) & 1) ? (1 + opaque_one()) : 1)
#define REPSYNC(k) do { if (rep_ + 1 < nrep_) xcd_barrier(bar, wave); } while (0)
#ifdef TS_PHASE
#define SEAM(k) do { if (IN(k) && IN((k) + 1)) { xcd_barrier(bar, wave); if (blockIdx.x == 0 && wave == 0 && lane_id_opaque() == 0) ((unsigned long long*)(ctl + 12288))[(k) + 1] = __builtin_amdgcn_s_memrealtime(); } } while (0)
#else
#define SEAM(k) do { if (IN(k) && IN((k) + 1)) xcd_barrier(bar, wave); } while (0)
#endif
    if (IN(0) && !DIS(0)) _Pragma("unroll 1") for (int rep_ = 0, nrep_ = NREP(0); rep_ < nrep_; ++rep_) { const Args a = KA(); phase_prologue(a, lds, gw, ngw, wave); REPSYNC(0); }
    SEAM(0);
    for (int l = 0; l < 2; ++l) {
        const int pb = 1 + 10 * l;
        if (IN(pb + 0) && !DIS(1)) _Pragma("unroll 1") for (int rep_ = 0, nrep_ = NREP(1); rep_ < nrep_; ++rep_) { const Args a = KA(); if (l == 0) phase_norm<1, false>(a, l, a.x, lds, gw, ngw, wave); else phase_norm<1, true>(a, l, a.out, lds, gw, ngw, wave); __syncthreads(); REPSYNC(1); }
        SEAM(pb + 0);
        if (IN(pb + 1) && !DIS(2)) _Pragma("unroll 1") for (int rep_ = 0, nrep_ = NREP(2); rep_ < nrep_; ++rep_) { const Args a = KA();
            ProbDense P{(const char*)(a.ws + WS_H), (const char*)(a.ws + WS_WIN) + (size_t)l * LDU * 1024 * 2, 1024};
            pg8::StaticOrder S; S.init(T_TOK / 256, LDU / 256, G, (int)blockIdx.x);
            EpiU E{(bf16_t*)(a.ws + WS_U)};
            pg8::gemm_phase(lds, P, S, E, wave);
            if (l == 0) tp_tail(a, (T_TOK / 256) * (LDU / 256), G, 0, TP_TAIL_INPROJ, lds, wave);
            REPSYNC(2);
        }
        SEAM(pb + 1);
        if (IN(pb + 2) && !DIS(8)) { const Args a = KA();
            _Pragma("unroll 1") for (int rep_ = 0, nrep_ = NREP(11); rep_ < nrep_; ++rep_) { phase_ml_b1(a, l, lds, gw, ngw, wave); REPSYNC(11); }
            _Pragma("unroll 1") for (int rep_ = 0, nrep_ = NREP(12); rep_ < nrep_; ++rep_) { phase_sb(a, l, lds, gw, ngw, wave); REPSYNC(12); }
            phase_dil(a, l, lds, gw, ngw, wave, 0, 1); }
        SEAM(pb + 2);
        if (IN(pb + 3) && !DIS(9)) { const Args a = KA();
            _Pragma("unroll 1") for (int rep_ = 0, nrep_ = NREP(13); rep_ < nrep_; ++rep_) { phase_ml_b2(a, (int)blockIdx.x * (NWAVES * 64) + wave * 64 + lane_id_opaque(), G * NWAVES * 64); REPSYNC(13); }
            _Pragma("unroll 1") for (int rep_ = 0, nrep_ = NREP(14); rep_ < nrep_; ++rep_) { phase_dil(a, l, lds, gw, ngw, wave, 1, 3); REPSYNC(14); } }
        SEAM(pb + 3);
        if (IN(pb + 4) && !DIS(10)) { const Args a = KA();
            _Pragma("unroll 1") for (int rep_ = 0, nrep_ = NREP(15); rep_ < nrep_; ++rep_) { phase_ml_b3(a, l, lds, gw, ngw, wave); REPSYNC(15); }
            _Pragma("unroll 1") for (int rep_ = 0, nrep_ = NREP(16); rep_ < nrep_; ++rep_) { phase_dil_merge(a, l, gw, ngw); REPSYNC(16); } }
        SEAM(pb + 4);
        if (IN(pb + 5) && !DIS(3)) _Pragma("unroll 1") for (int rep_ = 0, nrep_ = ((l == 0) ? NREP(3) : 1); rep_ < nrep_; ++rep_) { const Args a = KA(); const float* xin = (l == 0) ? a.x : a.out; const float* modl = (const float*)(a.ws + WS_MOD) + (size_t)l * 8 * NMOD;
            ProbDense P{(const char*)(a.ws + WS_Y), (const char*)(a.ws + WS_WOUT) + (size_t)l * 1024 * 1024 * 2, 1024};
            pg8::StaticOrder S; S.init(T_TOK / 256, 4, G, (int)blockIdx.x);
            if (l == 0) { EpiOut<false> E{a.x, (bf16_t*)a.out, modl + 2048}; pg8::gemm_phase(lds, P, S, E, wave); }
            else { EpiOut<true> E{a.out, (bf16_t*)a.out, modl + 2048}; pg8::gemm_phase(lds, P, S, E, wave); }
            if (l == 0) REPSYNC(3);
        }
        SEAM(pb + 5);
        if (IN(pb + 6) && !DIS(4)) _Pragma("unroll 1") for (int rep_ = 0, nrep_ = NREP(4); rep_ < nrep_; ++rep_) { const Args a = KA(); phase_norm<2, true>(a, (rep_ + 1 < nrep_) ? l + 2 : l, a.out, lds, gw, ngw, wave); __syncthreads(); REPSYNC(4); }
        SEAM(pb + 6);
        if (IN(pb + 7) && !DIS(5)) _Pragma("unroll 1") for (int rep_ = 0, nrep_ = NREP(5); rep_ < nrep_; ++rep_) { const Args a = KA();
            LAS int* tab = (LAS int*)(lds + TAB_OFF); build_moe_tab(a, l, tab, wave);
            const int nMt = tab[352];
            ProbGU P{(const char*)(a.ws + WS_H), (const char*)(a.ws + WS_WGU) + (size_t)l * 16 * 1024 * 1024 * 2, (const int*)(a.ws + WS_LIST), tab};
            pg8::StaticOrder S; S.init(nMt, 8, G, (int)blockIdx.x);
            EpiGU E{(bf16_t*)(a.ws + WS_U), (const int*)(a.ws + WS_LIST), (const float*)(a.ws + WS_RW), tab};
            pg8::gemm_phase(lds, P, S, E, wave);
            if (l == 0) tp_tail(a, nMt * 8, G, TP_N_MOE / 2, TP_N_MOE / 2 + 5120, lds, wave);
            REPSYNC(5);
        }
        SEAM(pb + 7);
        if (IN(pb + 8) && !DIS(6)) _Pragma("unroll 1") for (int rep_ = 0, nrep_ = NREP(6); rep_ < nrep_; ++rep_) { const Args a = KA(); const float* modl = (const float*)(a.ws + WS_MOD) + (size_t)l * 8 * NMOD;
            LAS int* tab = (LAS int*)(lds + TAB_OFF); build_moe_tab(a, l, tab, wave);
            const int nMt = tab[352];
            ProbDown P{(const char*)(a.ws + WS_U), (const char*)(a.ws + WS_WD) + (size_t)l * 16 * 1024 * 512 * 2, tab};
            pg8::StaticOrder S; S.init(nMt, 4, G, (int)blockIdx.x);
            EpiDown E{(const bf16_t*)a.out, (rep_ + 1 < nrep_) ? (bf16_t*)(a.ws + WS_Y) : ((l == 1) ? (bf16_t*)(a.ws + WS_H) : (bf16_t*)a.out), (const int*)(a.ws + WS_LIST), modl + 5120, tab};
            pg8::gemm_phase(lds, P, S, E, wave);
            if (l == 0) tp_tail(a, nMt * 4, G, TP_N_MOE / 2 + 5120, TP_N_MOE, lds, wave);
            REPSYNC(6);
        }
        SEAM(pb + 8);
    }
#if defined(TS_DIL)
    if (IN(21)) { const Args a = KA(); const unsigned long long* st = (const unsigned long long*)(ctl + 12288);
        const float eps = (float)(long long)st[40] * 0.01f * TS_SCALE; phase_final(a, gw, ngw, 1.f + eps, bar, wave); }
#elif defined(TS_PHASE)
    if (IN(21)) { const Args a = KA(); const unsigned long long* st = (const unsigned long long*)(ctl + 12288);
        const float eps = (float)(long long)(st[TS_PHASE + 1] - st[TS_PHASE]) * 0.01f * TS_SCALE; phase_final(a, gw, ngw, 1.f + eps, bar, wave); }
#else
    if (IN(21) && !DIS(7)) { const Args a = KA(); phase_final(a, gw, ngw, 1.f, bar, wave); }
#endif
#undef IN
#undef SEAM
}

__global__ void __launch_bounds__(256) k_qkvm(const bf16_t* __restrict__ U, const float* __restrict__ conv_w, const float* __restrict__ conv_b,
                                              const float* __restrict__ wq, const float* __restrict__ wk, const float* __restrict__ wv, bf16_t* __restrict__ Q, bf16_t* __restrict__ K, bf16_t* __restrict__ V) {
    __shared__ float xc[4][64], xm[4][64];
    const int tid = threadIdx.x, ti = tid >> 6, e = tid & 63;
    const int nitem = (T_TOK / 4) * 4;
    for (int item = blockIdx.x; item < nitem; item += gridDim.x) {
        const int h = item & 3, t = (item >> 2) * 4 + ti;
        const int ts = t % SEQ; const int ch = h * 64 + e;
        float a = conv_b[ch];
#pragma unroll
        for (int j = 0; j < 4; ++j) { const int tt = ts - 3 + j; if (tt >= 0) a += conv_w[j * 256 + ch] * bf2f(U[(size_t)(t - 3 + j) * LDU + OFF_ML_X + ch]); }
        __syncthreads();
        xc[ti][e] = a * sigmoidf_(a);
        xm[ti][e] = bf2f(U[(size_t)t * LDU + OFF_ML_X + ch]);
        __syncthreads();
        float q = 0.f, k = 0.f, v = 0.f;
        for (int d = 0; d < 64; ++d) { const float c = xc[ti][d]; q += c * wq[(h * 64 + d) * 64 + e]; k += c * wk[(h * 64 + d) * 64 + e]; v += xm[ti][d] * wv[(h * 64 + d) * 64 + e]; }
        Q[(size_t)t * 256 + ch] = f2bf(q); K[(size_t)t * 256 + ch] = f2bf(k * 0.125f); V[(size_t)t * 256 + ch] = f2bf(v);
    }
}
__global__ void __launch_bounds__(256) k_mlstm_seq(const bf16_t* __restrict__ Q, const bf16_t* __restrict__ K, const bf16_t* __restrict__ V, const float* __restrict__ gate, const float* __restrict__ gate_bias,
                                                   const bf16_t* __restrict__ U, const float* __restrict__ g_head, bf16_t* __restrict__ Y) {
    __shared__ float sq[32][64], sk[32][64], sv[32][64], sig[32], slf[32];
    __shared__ float red[2][4][64]; __shared__ float sden[2];
    const int tid = threadIdx.x, e = tid & 63, dg = tid >> 6;
    const int b = blockIdx.x >> 2, h = blockIdx.x & 3;
    float C[16];
#pragma unroll
    for (int i = 0; i < 16; ++i) C[i] = 0.f;
    float nst = 0.f, m = 0.f;
    const float bi = gate_bias[h], bff = gate_bias[4 + h];
    for (int t0 = 0; t0 < SEQ; t0 += 32) {
        __syncthreads();
        for (int i = tid; i < 32 * 64; i += 256) { const int tt = i >> 6, d = i & 63; const size_t r = (size_t)(b * SEQ + t0 + tt) * 256 + h * 64 + d; sq[tt][d] = bf2f(Q[r]); sk[tt][d] = bf2f(K[r]); sv[tt][d] = bf2f(V[r]); }
        if (tid < 32) { const size_t r = (size_t)(b * SEQ + t0 + tid) * 8; sig[tid] = gate[r + h] + bi; const float fp = gate[r + 4 + h] + bff; slf[tid] = -softplusf_(-fp); }
        __syncthreads();
        for (int tt = 0; tt < 32; ++tt) {
            const int pb = tt & 1;
            const float ig = sig[tt], lf = slf[tt];
            const float mn = fmaxf(lf + m, ig);
            const float a = __expf(lf + m - mn), bc = __expf(ig - mn);
            m = mn;
            const float ve = sv[tt][e];
            float part = 0.f;
#pragma unroll
            for (int i = 0; i < 16; ++i) { const int d = dg * 16 + i; C[i] = a * C[i] + bc * sk[tt][d] * ve; part += sq[tt][d] * C[i]; }
            red[pb][dg][e] = part;
            if (tid < 64) { nst = a * nst + bc * sk[tt][tid]; const float qn = wave_sum(sq[tt][tid] * nst); if (tid == 0) sden[pb] = qn; }
            __syncthreads();
            if (tid < 64) {
                const float num = red[pb][0][e] + red[pb][1][e] + red[pb][2][e] + red[pb][3][e];
                const float den = sden[pb];
                const float hv = num / fmaxf(fabsf(den), __expf(-m));
                const size_t row = (size_t)(b * SEQ + t0 + tt);
                const float o = sigmoidf_(bf2f(U[row * LDU + OFF_ML_O + h * 64 + e])) * hv;
                const float ss = wave_sum(o * o);
                Y[row * 1024 + h * 64 + e] = f2bf(o * rsqrtf(ss * (1.f / 64.f) + EPS) * g_head[h * 64 + e]);
            }
        }
    }
}
__global__ void __launch_bounds__(256) k_dil(const bf16_t* __restrict__ U, const float* __restrict__ g_head, bf16_t* __restrict__ Y) {
    const int lane = threadIdx.x & 63;
    const int wave = (blockIdx.x * blockDim.x + threadIdx.x) >> 6, nw = (gridDim.x * blockDim.x) >> 6;
    for (int item = wave; item < NB * 6 * SEQ; item += nw) {
        const int t = item % SEQ, h = (item / SEQ) % 6, b = item / (SEQ * 6);
        const size_t row = (size_t)b * SEQ + t;
        const float q = bf2f(U[row * LDU + OFF_DIL + h * 64 + lane]);
        const float slope = exp2f(-8.f * (float)(h + 1) / 6.f);
        float m = -INFINITY, l = 0.f, acc = 0.f;
        for (int p = 0; p < 3; ++p) {
            const int d = (p == 0) ? 1 : (p == 1 ? 4 : 16);
            for (int j = 0; j <= 128; ++j) {
                const int tk = t - j * d; if (tk < 0) break;
                const size_t kr = ((size_t)b * SEQ + tk) * LDU + OFF_DIL + h * 64 + lane;
                const float kv = bf2f(U[kr + 384]), vv = bf2f(U[kr + 768]);
                const float s = wave_sum(q * kv) * 0.125f - slope * (float)(j * d);
                const float mn = fmaxf(m, s); const float corr = __expf(m - mn), pe = __expf(s - mn);
                l = l * corr + pe; acc = acc * corr + pe * vv; m = mn;
            }
        }
        const float o = acc / l;
        const float ss = wave_sum(o * o);
        Y[row * 1024 + (4 + h) * 64 + lane] = f2bf(o * rsqrtf(ss * (1.f / 64.f) + EPS) * g_head[(4 + h) * 64 + lane]);
    }
}
__global__ void __launch_bounds__(256) k_sb(const bf16_t* __restrict__ U, const float* __restrict__ g_head, bf16_t* __restrict__ Y) {
    const int lane = threadIdx.x & 63;
    const int wave = (blockIdx.x * blockDim.x + threadIdx.x) >> 6, nw = (gridDim.x * blockDim.x) >> 6;
    for (int item = wave; item < NB * 6 * SEQ; item += nw) {
        const int t = item % SEQ, h = (item / SEQ) % 6, b = item / (SEQ * 6);
        const size_t row = (size_t)b * SEQ + t;
        const float q = bf2f(U[row * LDU + OFF_SB + h * 64 + lane]);
        float run = 0.f, acc = 0.f;
        for (int s = t - 1; s >= 0; --s) {
            const size_t kr = ((size_t)b * SEQ + s) * LDU + OFF_SB + h * 64 + lane;
            const float kv = bf2f(U[kr + 384]), vv = bf2f(U[kr + 768]);
            const float z = wave_sum(q * kv) * 0.125f;
            const float lk = -softplusf_(z);
            acc += __expf(z + lk + run) * vv;
            run += lk;
            if (run < -104.f) break;
        }
        const float ss = wave_sum(acc * acc);
        Y[row * 1024 + (10 + h) * 64 + lane] = f2bf(acc * rsqrtf(ss * (1.f / 64.f) + EPS) * g_head[(10 + h) * 64 + lane]);
    }
}

extern "C" void kernel_launch(void* const* d_in, const int* in_sizes, int n_in, void* d_out, int out_size, void* d_ws, size_t ws_size, hipStream_t stream) {
    static int grid = 0;
    if (grid == 0) {
        int dev = 0, cus = 0;
        if (ws_size < WS_END) { fprintf(stderr, "kernel_launch: workspace too small (%zu < %zu)\n", ws_size, (size_t)WS_END); grid = -1; return; }
        if (hipGetDevice(&dev) != hipSuccess || hipDeviceGetAttribute(&cus, hipDeviceAttributeMultiprocessorCount, dev) != hipSuccess) { grid = -1; return; }
        if (hipFuncSetAttribute((const void*)fwd, hipFuncAttributeMaxDynamicSharedMemorySize, LDS_BYTES) != hipSuccess) { fprintf(stderr, "kernel_launch: hipFuncSetAttribute failed\n"); grid = -1; return; }
        (void)hipGetLastError();
        grid = 256;
        if (cus < 256) { fprintf(stderr, "kernel_launch: needs 256 CUs, device has %d\n", cus); grid = -1; return; }
    }
    if (grid < 0) return;
    Args a{};
    a.x = (const float*)d_in[0]; a.c = (const float*)d_in[1]; a.w_in = (const float*)d_in[2]; a.conv_w = (const float*)d_in[3]; a.conv_b = (const float*)d_in[4];
    a.w_mq = (const float*)d_in[5]; a.w_mk = (const float*)d_in[6]; a.w_mv = (const float*)d_in[7]; a.gate_bias = (const float*)d_in[8]; a.g_head = (const float*)d_in[9];
    a.w_out = (const float*)d_in[10]; a.w_ada = (const float*)d_in[11]; a.b_ada = (const float*)d_in[12]; a.w_router = (const float*)d_in[13]; a.router_bias = (const float*)d_in[14];
    a.w_gate_e = (const float*)d_in[15]; a.w_up_e = (const float*)d_in[16]; a.w_down_e = (const float*)d_in[17]; a.g_final = (const float*)d_in[18];
    a.out = (float*)d_out; a.ws = (unsigned char*)d_ws;
    char* ws = (char*)d_ws;
    (void)hipMemsetAsync(ws + WS_CTL, 0, CTL_BYTES, stream);
    float* gate = (float*)(ws + WS_GATE); bf16_t* U = (bf16_t*)(ws + WS_U);
    bf16_t* Y = (bf16_t*)(ws + WS_Y); bf16_t* Qm = (bf16_t*)(ws + WS_QKV); bf16_t* Km = Qm + (size_t)T_TOK * 256; bf16_t* Vm = Km + (size_t)T_TOK * 256;
#define RUN(lo_, hi_) do { a.ph_lo = (lo_); a.ph_hi = (hi_); hipLaunchKernelGGL(fwd, dim3(grid), dim3(NWAVES * 64), LDS_BYTES, stream, a); } while (0)
#if defined(MK_SPLIT)
    RUN(0, 1);
    for (int l = 0; l < 2; ++l) { const int pb = 1 + 10 * l; for (int k = 0; k < 9; ++k) RUN(pb + k, pb + k + 1); }
    RUN(21, 22);
#else
    RUN(0, 22);
#endif
#undef RUN
}
```

```cpp
#include <hip/hip_runtime.h>
#include <stdint.h>
#include <stdio.h>

#define T_TOK 32768
#define SEQ 4096
#define DM 1024
#define NB 8
#define DIN 2824
#define LDU 2816
#define OFF_ML_X 0
#define OFF_ML_O 256
#define OFF_DIL 512
#define OFF_SB 1664
#define NMOD 6144
#define EPS 1e-6f
#define NBUCK 24

#define LAS __attribute__((address_space(3)))
typedef unsigned short bf16_t;
typedef short bf16x8 __attribute__((ext_vector_type(8)));
typedef float f32x4 __attribute__((ext_vector_type(4)));
typedef float f32x2 __attribute__((ext_vector_type(2)));
typedef unsigned u32x4 __attribute__((ext_vector_type(4)));
typedef unsigned u32x2 __attribute__((ext_vector_type(2)));

__device__ __forceinline__ float bf2f(bf16_t v) { return __uint_as_float(((unsigned)v) << 16); }
__device__ __forceinline__ unsigned f2bf_u(float f) { unsigned u = __float_as_uint(f); return (u + 0x7fffu + ((u >> 16) & 1u)) >> 16; }
__device__ __forceinline__ bf16_t f2bf(float f) { return (bf16_t)f2bf_u(f); }
__device__ __forceinline__ unsigned pk2(float lo, float hi) { return f2bf_u(lo) | (f2bf_u(hi) << 16); }
__device__ __forceinline__ float wave_sum(float v) {
#pragma unroll
    for (int o = 32; o > 0; o >>= 1) v += __shfl_xor(v, o, 64);
    return v;
}
__device__ __forceinline__ float bperm_f(float v, int srclane) { return __int_as_float(__builtin_amdgcn_ds_bpermute((srclane & 63) << 2, __float_as_int(v))); }
__device__ __forceinline__ int opaque_one() { int r; asm volatile("s_mov_b32 %0, 1" : "=s"(r)); return r; }
__device__ __forceinline__ int lane_id_opaque() { int r; asm volatile("v_mbcnt_lo_u32_b32 %0, -1, 0\n\tv_mbcnt_hi_u32_b32 %0, -1, %0" : "=v"(r)); return r; }
__device__ __forceinline__ float wave_sum_l(float v, int lane) {
#pragma unroll
    for (int o = 32; o > 0; o >>= 1) v += __int_as_float(__builtin_amdgcn_ds_bpermute((lane ^ o) << 2, __float_as_int(v)));
    return v;
}
__device__ __forceinline__ float sigmoidf_(float x) { return 1.f / (1.f + __expf(-x)); }
__device__ __forceinline__ float softplusf_(float z) { return fmaxf(z, 0.f) + log1pf(__expf(-fabsf(z))); }

constexpr size_t MiB = 1u << 20;
constexpr size_t WS_CTL   = 0;
constexpr size_t CTL_BYTES = 1 * MiB;
constexpr size_t WS_MOD   = 1 * MiB;
constexpr size_t WS_GATE  = WS_MOD + 512 * 1024;
constexpr size_t WS_RW    = WS_GATE + 1 * MiB;
constexpr size_t WS_LIST  = WS_RW + 256 * 1024;
constexpr size_t WS_WIN   = 6 * MiB;
constexpr size_t WS_WOUT  = 17 * MiB;
constexpr size_t WS_WGU   = 21 * MiB;
constexpr size_t WS_WD    = 85 * MiB;
constexpr size_t WS_H     = 117 * MiB;
constexpr size_t WS_U     = 181 * MiB;
constexpr size_t WS_Y     = 357 * MiB;
constexpr size_t WS_QKV   = 421 * MiB;
constexpr size_t WS_OP1   = WS_H;
constexpr size_t WS_CLOC  = WS_H + 24 * MiB;
constexpr size_t WS_OP2   = 469 * MiB;
constexpr size_t WS_LSE   = 493 * MiB;
constexpr size_t WS_CT    = 496 * MiB;
constexpr size_t WS_MLS   = 504 * MiB;
constexpr size_t WS_END   = 507 * MiB;
constexpr size_t MLS_CUM = 0, MLS_AA = 512 * 1024, MLS_PM = 1024 * 1024, MLS_NLOC = 1536 * 1024  , MLS_NC = 2048 * 1024, MLS_AMAX = 2304 * 1024, MLS_LSUM = 2308 * 1024, MLS_MC = 2312 * 1024, MLS_WT = 2560 * 1024;

constexpr int CW_BAR = 4096;
constexpr int CW_CNT = 8192;

namespace pg8 {
constexpr int BM = 256, BK = 64, HALF = 128, HTB = HALF * BK * 2, STAGE_BYTES = 8 * HTB, NXCD = 8, WGM = 8;
__host__ __device__ __forceinline__ int lds_byte(int r, int c) { const int st = (r >> 4) * 2 + (c >> 5), rr = r & 15, cc = c & 31, ob = rr * 64 + cc * 2; return st * 1024 + (ob ^ (((ob >> 9) & 1) << 5)); }
__host__ __device__ __forceinline__ void stage_rc(int b, int& R, int& C) { const int st = b / 1024, sb = b % 1024, swz = sb ^ (((sb >> 9) & 1) << 5); R = (st >> 1) * 16 + swz / 64; C = (st & 1) * 32 + (swz % 64) / 2; }
__host__ __device__ __forceinline__ int perm32(int rho) { const int n = rho >> 4, i = rho & 15; return 8 * (i >> 2) + 4 * n + (i & 3); }
struct Unit { int pm, pn; };
struct StaticOrder {
    int nM, nN, nwg, G, c;
    __device__ void init(int nM_, int nN_, int G_, int c_) { nM = nM_; nN = nN_; nwg = nM * nN; G = G_; c = c_; }
    __device__ bool next(int i, Unit& u) const {
        const long L = (long)i * G + c; if (L >= nwg) return false;
        int wgid = (int)L; { const int q = nwg / NXCD, r = nwg % NXCD, xcd = wgid % NXCD, off = wgid / NXCD; wgid = (xcd < r ? xcd * (q + 1) : r * (q + 1) + (xcd - r) * q) + off; }
        const int nig = WGM * nN, gid = wgid / nig, fm = gid * WGM, gsz = (nM - fm) < WGM ? (nM - fm) : WGM;
        u.pm = fm + ((wgid % nig) % gsz); u.pn = (wgid % nig) / gsz; return true;
    }
};
__device__ __forceinline__ unsigned cvt_pk_bf16(float lo, float hi) { unsigned r; asm volatile("v_cvt_pk_bf16_f32 %0, %1, %2" : "=v"(r) : "v"(lo), "v"(hi)); return r; }

template <class P, class Epi, class Sched>
__device__ __forceinline__ void gemm_phase(LAS unsigned char* lds, const P& pb, const Sched& S, const Epi& E, int wave_) {
    const int tid_ = wave_ * 64 + lane_id_opaque();
    const int tid = tid_, wid = __builtin_amdgcn_readfirstlane(tid >> 6), lane = tid & 63, wr = wid >> 2, wc = wid & 3, fr = lane & 15, fq = lane >> 4;
    const int nt = pb.nt();
    unsigned voffB[2];
#pragma unroll
    for (int i = 0; i < 2; ++i) { int R, C; stage_rc(tid * 16 + i * 8192, R, C); const int Rb = Epi::PERM ? ((R & ~31) + perm32(R & 31)) : R; voffB[i] = (unsigned)(Rb * pb.ldb() + C) * 2u; }
    const size_t hstepB = (size_t)HALF * pb.ldb() * 2;
    const unsigned ldsw = (unsigned)wid * 1024u;
    const int aoff = lds_byte(wr * 64 + fr, fq * 8), boff = lds_byte(wc * 32 + fr, fq * 8);
#define PG8_SA(b, h) (((b) * 2 + (h)) * HTB)
#define PG8_SB(b, h) ((4 + (b) * 2 + (h)) * HTB)
#define PG8_STAGE(bufoff, gbase, voff) do { _Pragma("unroll") for (int _i = 0; _i < 2; ++_i) \
        __builtin_amdgcn_global_load_lds((const unsigned*)((const char*)(gbase) + (voff)[_i]), (LAS unsigned*)(lds + (bufoff) + ldsw + _i * 8192), 16, 0, 0); } while (0)
#define PG8_LDA(dst, b, h) do { _Pragma("unroll") for (int m = 0; m < 4; ++m) _Pragma("unroll") for (int k = 0; k < 2; ++k) dst[m][k] = *(const LAS bf16x8*)(lds + PG8_SA(b, h) + aoff + m * 2048 + k * 1024); } while (0)
#define PG8_LDB(dst, b, h) do { _Pragma("unroll") for (int n = 0; n < 2; ++n) _Pragma("unroll") for (int k = 0; k < 2; ++k) dst[n][k] = *(const LAS bf16x8*)(lds + PG8_SB(b, h) + boff + n * 2048 + k * 1024); } while (0)
#define PG8_MMA(ai, bj, At, Bt) do { __builtin_amdgcn_s_setprio(1); _Pragma("unroll") for (int m = 0; m < 4; ++m) _Pragma("unroll") for (int n = 0; n < 2; ++n) _Pragma("unroll") for (int k = 0; k < 2; ++k) \
        acc[ai][bj][m][n] = __builtin_amdgcn_mfma_f32_16x16x32_bf16(Bt[n][k], At[m][k], acc[ai][bj][m][n], 0, 0, 0); __builtin_amdgcn_s_setprio(0); } while (0)
#define PG8_WAIT_V(n) asm volatile("s_waitcnt vmcnt(" #n ")" ::: "memory")
#define PG8_WAIT_L(n) asm volatile("s_waitcnt lgkmcnt(" #n ")" ::: "memory")
#define PG8_BAR __builtin_amdgcn_s_barrier()
#define PG8_SCHED __builtin_amdgcn_sched_barrier(0)
#define PG8_AOFF(dst, u) do { int _t = tid; asm volatile("" : "+v"(_t)); _Pragma("unroll") for (int _i = 0; _i < 2; ++_i) { int _R, _C; stage_rc(_t * 16 + _i * 8192, _R, _C); \
        _Pragma("unroll") for (int _h = 0; _h < 2; ++_h) dst[_h][_i] = pb.a_row(u, _h * HALF + _R) + (unsigned)_C * 2u; } } while (0)
    Unit cur, nxt; int ui = 0;
    if (!S.next(0, cur)) return;
    f32x4 acc[2][2][4][2];
#pragma unroll
    for (int a = 0; a < 2; ++a)
#pragma unroll
        for (int b = 0; b < 2; ++b)
#pragma unroll
            for (int m = 0; m < 4; ++m)
#pragma unroll
                for (int n = 0; n < 2; ++n) acc[a][b][m][n] = (f32x4){0.f, 0.f, 0.f, 0.f};
    bf16x8 At[4][2], B0[2][2], B1[2][2];
    unsigned ca[2][2], na[2][2];
    PG8_AOFF(ca, cur);
    const char* Ab = pb.a_base();
    {
        const char* b0 = pb.b_tile(cur, 0); const char* b1 = pb.b_tile(cur, 1);
        PG8_STAGE(PG8_SB(0, 0), b0, voffB); PG8_STAGE(PG8_SB(0, 1), b0 + hstepB, voffB); PG8_STAGE(PG8_SA(0, 0), Ab, ca[0]); PG8_STAGE(PG8_SA(0, 1), Ab, ca[1]);
        if (wr == 1) PG8_BAR;
        PG8_WAIT_V(2); PG8_BAR;
        PG8_STAGE(PG8_SB(1, 0), b1, voffB); PG8_STAGE(PG8_SA(1, 0), Ab + 128, ca[0]); PG8_STAGE(PG8_SB(1, 1), b1 + hstepB, voffB);
        PG8_WAIT_V(6); PG8_BAR;
    }
    for (;;) {
        const bool has_next = S.next(ui + 1, nxt);
        if (!has_next) nxt = cur;
        PG8_AOFF(na, nxt);
#define PG8_KPAIR(A2BASE, OFF2, B2, B3, A1P) do { \
              \
            PG8_LDB(B0, 0, 0); PG8_LDB(B1, 0, 1); PG8_SCHED; PG8_LDA(At, 0, 0); PG8_STAGE(PG8_SA(1, 1), A1P, ca[1]); \
            PG8_WAIT_V(8); PG8_WAIT_L(0); PG8_BAR; PG8_MMA(0, 0, At, B0); PG8_MMA(0, 1, At, B1); PG8_BAR; PG8_SCHED; \
              \
            PG8_LDA(At, 0, 1); PG8_STAGE(PG8_SB(0, 0), B2, voffB); PG8_STAGE(PG8_SB(0, 1), (B2) + hstepB, voffB); PG8_STAGE(PG8_SA(0, 0), A2BASE, OFF2[0]); \
            PG8_WAIT_V(8); PG8_WAIT_L(0); PG8_BAR; PG8_MMA(1, 0, At, B0); PG8_MMA(1, 1, At, B1); PG8_BAR; PG8_SCHED; \
              \
            PG8_LDB(B0, 1, 0); PG8_LDB(B1, 1, 1); PG8_SCHED; PG8_LDA(At, 1, 0); PG8_STAGE(PG8_SA(0, 1), A2BASE, OFF2[1]); \
            PG8_WAIT_V(8); PG8_WAIT_L(0); PG8_BAR; PG8_MMA(0, 0, At, B0); PG8_MMA(0, 1, At, B1); PG8_BAR; PG8_SCHED; \
              \
            PG8_LDA(At, 1, 1); PG8_STAGE(PG8_SB(1, 0), B3, voffB); PG8_STAGE(PG8_SB(1, 1), (B3) + hstepB, voffB); PG8_STAGE(PG8_SA(1, 0), (A2BASE) + 128, OFF2[0]); \
            PG8_WAIT_V(8); PG8_WAIT_L(0); PG8_BAR; PG8_MMA(1, 0, At, B0); PG8_MMA(1, 1, At, B1); PG8_BAR; PG8_SCHED; } while (0)
        for (int t = 0; t < nt - 2; t += 2) {
            const char* b2 = pb.b_tile(cur, t + 2); const char* b3 = pb.b_tile(cur, t + 3);
            const char* a1p = Ab + (size_t)(t + 1) * 128; const char* a2p = Ab + (size_t)(t + 2) * 128;
            PG8_KPAIR(a2p, ca, b2, b3, a1p);
        }
        {
            const char* b2 = pb.b_tile(nxt, 0); const char* b3 = pb.b_tile(nxt, 1);
            const char* a1p = Ab + (size_t)(nt - 1) * 128;
            PG8_KPAIR(Ab, na, b2, b3, a1p);
        }
#undef PG8_KPAIR
        if (wr == 0) PG8_BAR;
        E(acc, cur, wr, wc, fr, fq);
        if (!has_next) break;
#pragma unroll
        for (int a = 0; a < 2; ++a)
#pragma unroll
            for (int b = 0; b < 2; ++b)
#pragma unroll
                for (int m = 0; m < 4; ++m)
#pragma unroll
                    for (int n = 0; n < 2; ++n) acc[a][b][m][n] = (f32x4){0.f, 0.f, 0.f, 0.f};
        cur = nxt;
#pragma unroll
        for (int h = 0; h < 2; ++h)
#pragma unroll
            for (int i = 0; i < 2; ++i) ca[h][i] = na[h][i];
        ++ui;
        if (wr == 1) PG8_BAR;
    }
    PG8_WAIT_V(0);
    PG8_BAR;
#undef PG8_SA
#undef PG8_SB
#undef PG8_STAGE
#undef PG8_LDA
#undef PG8_LDB
#undef PG8_MMA
#undef PG8_WAIT_V
#undef PG8_WAIT_L
#undef PG8_BAR
#undef PG8_SCHED
#undef PG8_AOFF
}
}
using pg8::Unit;

struct ProbDense {
    const char* A; const char* B; int K;
    __device__ __forceinline__ int nt() const { return K / 64; }
    __device__ __forceinline__ int ldb() const { return K; }
    __device__ __forceinline__ const char* a_base() const { return A; }
    __device__ __forceinline__ unsigned a_row(const Unit& u, int r) const { return (unsigned)((u.pm * 256 + r) * K) * 2u; }
    __device__ __forceinline__ const char* b_tile(const Unit& u, int t) const { return B + (size_t)u.pn * 256 * K * 2 + (size_t)t * 128; }
};
__device__ __forceinline__ int bucket_e0(int k) { const int g = k / 6, p = k % 6; return 4 * g + (p < 3 ? 0 : (p < 5 ? 1 : 2)); }
__device__ __forceinline__ int bucket_e1(int k) { const int g = k / 6, p = k % 6; return 4 * g + (p < 3 ? p + 1 : (p < 5 ? p - 1 : 3)); }
struct ProbGU {
    const char* H; const char* W; const int* list; const LAS int* tab;
    __device__ __forceinline__ int nt() const { return 16; }
    __device__ __forceinline__ int ldb() const { return 1024; }
    __device__ __forceinline__ const char* a_base() const { return H; }
    __device__ __forceinline__ unsigned a_row(const Unit& u, int r) const {
        const int k = tab[32 + u.pm], rr = tab[192 + u.pm] + r; int tok = 0; if (rr < tab[k]) tok = list[(size_t)k * T_TOK + rr]; return (unsigned)tok * 2048u; }
    __device__ __forceinline__ const char* b_tile(const Unit& u, int t) const {
        const int k = __builtin_amdgcn_readfirstlane(tab[32 + u.pm]); const int e = (u.pn < 4) ? bucket_e0(k) : bucket_e1(k);
        return W + (size_t)e * (1024 * 1024 * 2) + (size_t)(u.pn & 3) * 256 * 2048 + (size_t)t * 128; }
};
struct ProbDown {
    const char* HE; const char* W; const LAS int* tab;
    __device__ __forceinline__ int nt() const { return 16; }
    __device__ __forceinline__ int ldb() const { return 512; }
    __device__ __forceinline__ const char* a_base() const { return HE; }
    __device__ __forceinline__ unsigned a_row(const Unit& u, int r) const { return (unsigned)(u.pm * 256 + r) * 2048u; }
    __device__ __forceinline__ const char* b_tile(const Unit& u, int t) const {
        const int k = __builtin_amdgcn_readfirstlane(tab[32 + u.pm]); const int e = (t < 8) ? bucket_e0(k) : bucket_e1(k);
        return W + (size_t)e * (1024 * 512 * 2) + (size_t)u.pn * 256 * 1024 + (size_t)(t & 7) * 128; }
};

__device__ __forceinline__ f32x4 bf4_lo(const u32x4& v) { return (f32x4){__uint_as_float(v.x << 16), __uint_as_float(v.x & 0xffff0000u), __uint_as_float(v.y << 16), __uint_as_float(v.y & 0xffff0000u)}; }
__device__ __forceinline__ f32x4 bf4_hi(const u32x4& v) { return (f32x4){__uint_as_float(v.z << 16), __uint_as_float(v.z & 0xffff0000u), __uint_as_float(v.w << 16), __uint_as_float(v.w & 0xffff0000u)}; }
struct EpiU {
    static constexpr bool PERM = true;
    bf16_t* O;
    __device__ __forceinline__ void operator()(const f32x4 (&acc)[2][2][4][2], const Unit& u, int wr, int wc, int fr, int fq) const {
        const int row0 = u.pm * 256 + wr * 64 + fr, col0 = u.pn * 256 + wc * 32 + 8 * fq;
#pragma unroll
        for (int ai = 0; ai < 2; ++ai)
#pragma unroll
            for (int m = 0; m < 4; ++m) { bf16_t* rowp = O + (size_t)(row0 + ai * 128 + m * 16) * LDU + col0;
#pragma unroll
                for (int bj = 0; bj < 2; ++bj) { const f32x4 v0 = acc[ai][bj][m][0], v1 = acc[ai][bj][m][1];
                    u32x4 w; w.x = pg8::cvt_pk_bf16(v0[0], v0[1]); w.y = pg8::cvt_pk_bf16(v0[2], v0[3]); w.z = pg8::cvt_pk_bf16(v1[0], v1[1]); w.w = pg8::cvt_pk_bf16(v1[2], v1[3]);
                    *(u32x4*)(rowp + bj * 128) = w; } }
    }
};
template <bool XINBF> struct EpiOut {
    static constexpr bool PERM = true;
    const void* xin; bf16_t* XB; const float* gate;
    __device__ __forceinline__ void operator()(const f32x4 (&acc)[2][2][4][2], const Unit& u, int wr, int wc, int fr, int fq) const {
        const int b = (u.pm * 256) / SEQ; const int col0 = u.pn * 256 + wc * 32 + 8 * fq;
        f32x4 gv[2][2];
#pragma unroll
        for (int bj = 0; bj < 2; ++bj)
#pragma unroll
            for (int n = 0; n < 2; ++n) gv[bj][n] = *(const f32x4*)(gate + (size_t)b * NMOD + col0 + bj * 128 + n * 4);
#pragma unroll
        for (int ai = 0; ai < 2; ++ai)
#pragma unroll
            for (int m = 0; m < 4; ++m) { const size_t off = (size_t)(u.pm * 256 + ai * 128 + wr * 64 + m * 16 + fr) * DM + col0;
#pragma unroll
                for (int bj = 0; bj < 2; ++bj) {
                    f32x4 x0, x1;
                    if (XINBF) { const u32x4 xv = *(const u32x4*)((const bf16_t*)xin + off + bj * 128); x0 = bf4_lo(xv); x1 = bf4_hi(xv); }
                    else { x0 = *(const f32x4*)((const float*)xin + off + bj * 128); x1 = *(const f32x4*)((const float*)xin + off + bj * 128 + 4); }
                    const f32x4 y0 = x0 + gv[bj][0] * acc[ai][bj][m][0], y1 = x1 + gv[bj][1] * acc[ai][bj][m][1];
                    u32x4 w; w.x = pg8::cvt_pk_bf16(y0[0], y0[1]); w.y = pg8::cvt_pk_bf16(y0[2], y0[3]); w.z = pg8::cvt_pk_bf16(y1[0], y1[1]); w.w = pg8::cvt_pk_bf16(y1[2], y1[3]);
                    *(u32x4*)(XB + off + bj * 128) = w; } }
    }
};
struct EpiGU {
    static constexpr bool PERM = true;
    bf16_t* HE; const int* list; const float* rw; const LAS int* tab;
    __device__ __forceinline__ void operator()(const f32x4 (&acc)[2][2][4][2], const Unit& u, int wr, int wc, int fr, int fq) const {
        const int k = tab[32 + u.pm], r0 = tab[192 + u.pm], cnt = tab[k]; const int part = u.pn >> 2;
        const int hcol0 = part * 512 + ((u.pn & 3) * 256 + wc * 32 + 8 * fq) / 2;
#pragma unroll
        for (int ai = 0; ai < 2; ++ai)
#pragma unroll
            for (int m = 0; m < 4; ++m) { const int r = ai * 128 + wr * 64 + m * 16 + fr; const int rr = r0 + r;
                if (rr < cnt) { const int tok = list[(size_t)k * T_TOK + rr]; const float w = rw[tok * 2 + part];
                    bf16_t* rowp = HE + (size_t)(u.pm * 256 + r) * 1024 + hcol0;
#pragma unroll
                    for (int bj = 0; bj < 2; ++bj) { const f32x4 v0 = acc[ai][bj][m][0], v1 = acc[ai][bj][m][1];
                        const float h0 = v0[0] * sigmoidf_(v0[0]) * v0[1] * w, h1 = v0[2] * sigmoidf_(v0[2]) * v0[3] * w, h2 = v1[0] * sigmoidf_(v1[0]) * v1[1] * w, h3 = v1[2] * sigmoidf_(v1[2]) * v1[3] * w;
                        u32x2 o; o.x = pg8::cvt_pk_bf16(h0, h1); o.y = pg8::cvt_pk_bf16(h2, h3);
                        *(u32x2*)(rowp + bj * 64) = o; } } }
    }
};
struct EpiDown {
    static constexpr bool PERM = true;
    const bf16_t* XS; bf16_t* XB; const int* list; const float* gate; const LAS int* tab;
    __device__ __forceinline__ void operator()(const f32x4 (&acc)[2][2][4][2], const Unit& u, int wr, int wc, int fr, int fq) const {
        const int k = tab[32 + u.pm], r0 = tab[192 + u.pm], cnt = tab[k]; const int col0 = u.pn * 256 + wc * 32 + 8 * fq;
        int tok[2][4];
#pragma unroll
        for (int ai = 0; ai < 2; ++ai)
#pragma unroll
            for (int m = 0; m < 4; ++m) { const int rr = r0 + ai * 128 + wr * 64 + m * 16 + fr; tok[ai][m] = (rr < cnt) ? list[(size_t)k * T_TOK + rr] : -1; }
#pragma unroll
        for (int ai = 0; ai < 2; ++ai)
#pragma unroll
            for (int mp = 0; mp < 4; mp += 2) {
                u32x4 xi[2][2]; f32x4 gv[2][2][2];
#pragma unroll
                for (int mm = 0; mm < 2; ++mm) { const int tk = tok[ai][mp + mm]; const int tks = tk < 0 ? 0 : tk; const bf16_t* xr = XS + (size_t)tks * DM + col0; const float* gr = gate + (size_t)(tks / SEQ) * NMOD + col0;
#pragma unroll
                    for (int bj = 0; bj < 2; ++bj) { xi[mm][bj] = *(const u32x4*)(xr + bj * 128); gv[mm][bj][0] = *(const f32x4*)(gr + bj * 128); gv[mm][bj][1] = *(const f32x4*)(gr + bj * 128 + 4); } }
#pragma unroll
                for (int mm = 0; mm < 2; ++mm) { const int tk = tok[ai][mp + mm];
                    if (tk >= 0) { bf16_t* xr = XB + (size_t)tk * DM + col0;
#pragma unroll
                        for (int bj = 0; bj < 2; ++bj) { const f32x4 y0 = bf4_lo(xi[mm][bj]) + gv[mm][bj][0] * acc[ai][bj][mp + mm][0], y1 = bf4_hi(xi[mm][bj]) + gv[mm][bj][1] * acc[ai][bj][mp + mm][1];
                            u32x4 w; w.x = pg8::cvt_pk_bf16(y0[0], y0[1]); w.y = pg8::cvt_pk_bf16(y0[2], y0[3]); w.z = pg8::cvt_pk_bf16(y1[0], y1[1]); w.w = pg8::cvt_pk_bf16(y1[2], y1[3]);
                            *(u32x4*)(xr + bj * 128) = w; } } }
            }
    }
};

#define XB_TMO      128
#define XB_XCNT(j)  (256  + 64 * (j))
#define XB_XSUB(j)  (1280 + 64 * (j))
#define XB_XGEN(j)  (2304 + 64 * (j))
#define XB_TOP      3328
#define XB_TOPGEN   3392
#define XCD_BAR_WORDS 3456
#define XB_SPIN_CAP (1u << 18)
__device__ __forceinline__ unsigned xb_ld(unsigned* p)              { return __hip_atomic_load(p, __ATOMIC_RELAXED, __HIP_MEMORY_SCOPE_AGENT); }
__device__ __forceinline__ unsigned xb_add(unsigned* p, unsigned v) { return __hip_atomic_fetch_add(p, v, __ATOMIC_RELAXED, __HIP_MEMORY_SCOPE_AGENT); }
__device__ __forceinline__ unsigned xb_xcc_id() { return (unsigned)__builtin_amdgcn_s_getreg((3 << 11) | 20) & 0xFu; }
#define XB_SPIN(cond, bar) do { unsigned _sp = 0; while (cond) { __builtin_amdgcn_s_sleep(1); \
    if ((++_sp & 255u) == 0u) { if (xb_ld(&(bar)[XB_TMO])) break; if (_sp > XB_SPIN_CAP) { atomicAdd(&(bar)[XB_TMO], 1u); break; } } } } while (0)
struct XcdBarrier { unsigned* bar; unsigned x; volatile LAS unsigned* st; };
__device__ __forceinline__ XcdBarrier xcd_barrier_post(unsigned* bar, volatile LAS unsigned* st, bool leader) {
    XcdBarrier b; b.bar = bar; b.x = xb_xcc_id(); b.st = st;
    if (leader) (void)xb_add(&bar[XB_XCNT(b.x)], 1u);
    return b;
}
__device__ __forceinline__ void xcd_barrier_complete(unsigned* bar, unsigned x, unsigned& nloc, unsigned& nx) {
    const unsigned G = gridDim.x * gridDim.y * gridDim.z;
    unsigned sum, cnt, mine, sp = 0u;
    for (;;) {
        sum = 0u; cnt = 0u; mine = 0u;
#pragma unroll
        for (unsigned j = 0; j < 16; ++j) { const unsigned c = xb_ld(&bar[XB_XCNT(j)]); sum += c; cnt += (c > 0u) ? 1u : 0u; mine = (j == x) ? c : mine; }
        if (sum == G) break;
        __builtin_amdgcn_s_sleep(1);
        if ((++sp & 255u) == 0u) { if (xb_ld(&bar[XB_TMO])) break; if (sp > XB_SPIN_CAP) { atomicAdd(&bar[XB_TMO], 1u); break; } }
    }
    nloc = mine > 0u ? mine : 1u; nx = cnt > 0u ? cnt : 1u;
}
__device__ __forceinline__ void xcd_barrier(const XcdBarrier& b, int wave_) {
    asm volatile("s_waitcnt vmcnt(0)" ::: "memory");
    __syncthreads();
    if (wave_ == 0 && lane_id_opaque() == 0) {
        unsigned* bar = b.bar; asm volatile("" : "+s"(bar));
        __builtin_amdgcn_s_waitcnt(0);
        unsigned nloc = b.st[0], nx = b.st[1];
        if (nloc == 0u) { xcd_barrier_complete(bar, b.x, nloc, nx); b.st[0] = nloc; b.st[1] = nx; }
        const unsigned old = xb_add(&bar[XB_XSUB(b.x)], 1u);
        const unsigned gen = old / nloc;
        if (old + 1u == (gen + 1u) * nloc) {
            __builtin_amdgcn_fence(__ATOMIC_RELEASE, "agent");
            asm volatile("s_waitcnt vmcnt(0)" ::: "memory");
            const unsigned og = xb_add(&bar[XB_TOP], 1u);
            const unsigned tg = og / nx;
            if (og + 1u == (tg + 1u) * nx) xb_add(&bar[XB_TOPGEN], 1u);
            else XB_SPIN(xb_ld(&bar[XB_TOPGEN]) == tg, bar);
            __builtin_amdgcn_fence(__ATOMIC_ACQUIRE, "agent");
            xb_add(&bar[XB_XGEN(b.x)], 1u);
            asm volatile("s_waitcnt vmcnt(0)" ::: "memory");
        } else {
            XB_SPIN(xb_ld(&bar[XB_XGEN(b.x)]) == gen, bar);
            __builtin_amdgcn_fence(__ATOMIC_ACQUIRE, "agent");
            asm volatile("s_waitcnt vmcnt(0)" ::: "memory");
        }
    }
    __syncthreads();
}

constexpr int NWAVES = 8;
constexpr int RING_BYTES = 131072;
constexpr int TAB_OFF = RING_BYTES;
constexpr int MISC_OFF = TAB_OFF + 2048;
constexpr int LDS_BYTES = 147456;

struct Args {
    const float* x; const float* c; const float* w_in; const float* conv_w; const float* conv_b; const float* w_mq; const float* w_mk; const float* w_mv;
    const float* gate_bias; const float* g_head; const float* w_out; const float* w_ada; const float* b_ada; const float* w_router; const float* router_bias;
    const float* w_gate_e; const float* w_up_e; const float* w_down_e; const float* g_final;
    float* out; unsigned char* ws; int ph_lo, ph_hi;
};

struct TpItem { const float* src0; long long dsrc; int ldw; int inter; bf16_t* dst; int Kd; };
__device__ __forceinline__ void tp_load(const TpItem& t, float (&v)[32], int lane) {
    const int c = lane & 31;
    const float* p = t.inter ? (t.src0 + ((c & 1) ? t.dsrc : 0ll) + (c >> 1)) : (t.src0 + c);
#pragma unroll
    for (int i = 0; i < 32; ++i) v[i] = p[(size_t)(2 * i + (lane >> 5)) * t.ldw];
}
__device__ __forceinline__ void tp_finish(const TpItem& t, const float (&v)[32], LAS float* scr, int lane) {
#pragma unroll
    for (int i = 0; i < 32; ++i) scr[(2 * i + (lane >> 5)) * 33 + (lane & 31)] = v[i];
    asm volatile("s_waitcnt lgkmcnt(0)" ::: "memory");
    const int c = lane & 7;
#pragma unroll
    for (int j = 0; j < 4; ++j) { const int n = (lane >> 3) + 8 * j; const LAS float* s = scr + (8 * c) * 33 + n;
        u32x4 o; o.x = pk2(s[0 * 33], s[1 * 33]); o.y = pk2(s[2 * 33], s[3 * 33]); o.z = pk2(s[4 * 33], s[5 * 33]); o.w = pk2(s[6 * 33], s[7 * 33]);
        *(u32x4*)(t.dst + (size_t)n * t.Kd + 8 * c) = o; }
    asm volatile("s_waitcnt lgkmcnt(0)" ::: "memory");
}
constexpr int TP_N_DENSE = 2 * (16 * 88 + 16 * 32), TP_N_MOE = 2 * (16 * 16 * 32 + 16 * 8 * 32);
constexpr int TP_TAIL_INPROJ = 8192;
__device__ __forceinline__ TpItem tp_decode(const Args& a, int it, bool moe) {
    constexpr int I_IN = 16 * 88, I_OUT = 16 * 32, I_GU = 16 * 16 * 32, I_D = 16 * 8 * 32;
    TpItem t; t.inter = 0; t.dsrc = 0;
    if (!moe) {
        const int l = it / (I_IN + I_OUT); int r = it % (I_IN + I_OUT);
        if (r < I_IN) { const int kb = r / 88, nb = r % 88, n0 = nb * 32, k0 = kb * 64; const int ns = n0 < 512 ? n0 : n0 + 8;
            t.src0 = a.w_in + (size_t)l * 1024 * DIN + (size_t)k0 * DIN + ns; t.ldw = DIN; t.Kd = 1024; t.dst = (bf16_t*)(a.ws + WS_WIN) + (size_t)l * LDU * 1024 + (size_t)n0 * 1024 + k0; return t; }
        r -= I_IN;
        { const int kb = r / 32, nb = r % 32, n0 = nb * 32, k0 = kb * 64;
            t.src0 = a.w_out + (size_t)l * 1024 * 1024 + (size_t)k0 * 1024 + n0; t.ldw = 1024; t.Kd = 1024; t.dst = (bf16_t*)(a.ws + WS_WOUT) + (size_t)l * 1024 * 1024 + (size_t)n0 * 1024 + k0; return t; }
    }
    const int l = it / (I_GU + I_D); int r = it % (I_GU + I_D);
    if (r < I_GU) { const int e = r / 512, rr = r % 512, kb = rr / 32, nb = rr % 32, n0 = nb * 32, k0 = kb * 64;
        t.src0 = a.w_gate_e + ((size_t)l * 16 + e) * 1024 * 512 + (size_t)k0 * 512 + n0 / 2; t.dsrc = (long long)(((uintptr_t)a.w_up_e - (uintptr_t)a.w_gate_e) / 4); t.inter = 1;
        t.ldw = 512; t.Kd = 1024; t.dst = (bf16_t*)(a.ws + WS_WGU) + ((size_t)l * 16 + e) * 1024 * 1024 + (size_t)n0 * 1024 + k0; return t; }
    r -= I_GU;
    { const int e = r / 256, rr = r % 256, kb = rr / 32, nb = rr % 32, n0 = nb * 32, k0 = kb * 64;
        t.src0 = a.w_down_e + ((size_t)l * 16 + e) * 512 * 1024 + (size_t)k0 * 1024 + n0; t.ldw = 1024; t.Kd = 512; t.dst = (bf16_t*)(a.ws + WS_WD) + ((size_t)l * 16 + e) * 1024 * 512 + (size_t)n0 * 512 + k0; return t; }
}
__device__ __forceinline__ void tp_run(const Args& a, bool moe, int lo, int hi, LAS float* scr, int gw, int ngw) {
    const int lane = lane_id_opaque();
    asm volatile("" : "+s"(gw));
    float va[32], vb[32]; TpItem ta, tb;
    int it = lo + gw;
    if (it < hi) { ta = tp_decode(a, it, moe); tp_load(ta, va, lane); }
#pragma unroll 1
    for (;;) {
        if (it >= hi) break;
        if (it + ngw < hi) { tb = tp_decode(a, it + ngw, moe); tp_load(tb, vb, lane); }
        tp_finish(ta, va, scr, lane);
        it += ngw; if (it >= hi) break;
        if (it + ngw < hi) { ta = tp_decode(a, it + ngw, moe); tp_load(ta, va, lane); }
        tp_finish(tb, vb, scr, lane);
        it += ngw;
    }
}

__device__ __forceinline__ void phase_prologue(const Args& a, LAS unsigned char* lds, int gw, int ngw, int wave_) {
    const int lane = lane_id_opaque(), tid = wave_ * 64 + lane;
    LAS float* cact = (LAS float*)(lds + 98304);
    for (int i = tid; i < 8192; i += NWAVES * 64) { const float cv = a.c[i]; cact[i] = cv * sigmoidf_(cv); }
    __syncthreads();
    float* mod = (float*)(a.ws + WS_MOD);
    {
        LAS float* part = (LAS float*)(lds + 69632);
        for (int it = (int)blockIdx.x; it < 2 * 96; it += (int)gridDim.x) {
            const int l = it / 96, j = (it % 96) * 64 + lane;
            const float* w = a.w_ada + (size_t)l * 1024 * NMOD + j + (size_t)(wave_ * 128) * NMOD;
            float acc[8];
#pragma unroll
            for (int b = 0; b < 8; ++b) acc[b] = 0.f;
#pragma unroll 1
            for (int k = 0; k < 128; k += 32) {
                float wv[32];
#pragma unroll
                for (int kk = 0; kk < 32; ++kk) wv[kk] = w[(size_t)(k + kk) * NMOD];
#pragma unroll
                for (int b = 0; b < 8; ++b)
#pragma unroll
                    for (int k4 = 0; k4 < 32; k4 += 4) { const f32x4 cv = *(const LAS f32x4*)(cact + b * 1024 + wave_ * 128 + k + k4);
                        acc[b] += (cv[0] * wv[k4] + cv[1] * wv[k4 + 1]) + (cv[2] * wv[k4 + 2] + cv[3] * wv[k4 + 3]); }
            }
#pragma unroll
            for (int b = 0; b < 8; ++b) part[(wave_ * 8 + b) * 64 + lane] = acc[b];
            __syncthreads();
            { const int b = wave_; float sum = a.b_ada[l * NMOD + j];
#pragma unroll
              for (int w8 = 0; w8 < 8; ++w8) sum += part[(w8 * 8 + b) * 64 + lane];
              mod[((size_t)l * 8 + b) * NMOD + j] = sum; }
            __syncthreads();
        }
    }
    { bf16_t* WT = (bf16_t*)(a.ws + WS_MLS + MLS_WT);
      for (int i = gw * 64 + lane; i < 2 * 3 * 4 * 4096; i += ngw * 64) {
          const int d = i & 63, e = (i >> 6) & 63, h = (i >> 12) & 3, w = (i >> 14) % 3, l = i / (3 * 4 * 4096);
          const float* src = (w == 0) ? a.w_mq : (w == 1 ? a.w_mk : a.w_mv);
          const float v = src[((size_t)(l * 4 + h) * 64 + d) * 64 + e];
          WT[i] = f2bf(w == 1 ? v * 0.125f : v); } }
    tp_run(a, false, 0, TP_N_DENSE, (LAS float*)(lds + (tid >> 6) * 8704), gw, ngw);
    tp_run(a, true, TP_TAIL_INPROJ, TP_N_MOE / 2, (LAS float*)(lds + (tid >> 6) * 8704), gw, ngw);
}

__device__ __forceinline__ void tp_tail(const Args& a, int nunits, int G, int lo, int hi, LAS unsigned char* lds, int wave_) {
    const int rem = nunits % G;
    if ((int)blockIdx.x < rem || lo >= hi) return;
    tp_run(a, true, lo, hi, (LAS float*)(lds + wave_ * 8704), ((int)blockIdx.x - rem) * NWAVES + wave_, (G - rem) * NWAVES);
}
template <int HALF, int OFF, int N> __device__ __forceinline__ void reduce_tr_step(float (&v)[N], int lane) {
    const bool up = (lane & OFF) != 0;
#pragma unroll
    for (int i = 0; i < HALF; ++i) { const float snd = up ? v[i] : v[i + HALF], kep = up ? v[i + HALF] : v[i]; v[i] = kep + bperm_f(snd, lane ^ OFF); }
}
template <int N> __device__ __forceinline__ float reduce_tr(float (&v)[N], int lane);
template <> __device__ __forceinline__ float reduce_tr<16>(float (&v)[16], int lane) {
    reduce_tr_step<8, 32>(v, lane); reduce_tr_step<4, 16>(v, lane); reduce_tr_step<2, 8>(v, lane); reduce_tr_step<1, 4>(v, lane);
    float r = v[0]; r += bperm_f(r, lane ^ 2); r += bperm_f(r, lane ^ 1); return r; }
template <> __device__ __forceinline__ float reduce_tr<8>(float (&v)[8], int lane) {
    reduce_tr_step<4, 32>(v, lane); reduce_tr_step<2, 16>(v, lane); reduce_tr_step<1, 8>(v, lane);
    float r = v[0]; r += bperm_f(r, lane ^ 4); r += bperm_f(r, lane ^ 2); r += bperm_f(r, lane ^ 1); return r; }
template <int MODE, bool XBF>
__device__ __forceinline__ void phase_norm(const Args& a, int l, const void* xin, LAS unsigned char* lds, int gw, int ngw, int wave_) {
    const int lane = lane_id_opaque(), tid = wave_ * 64 + lane;
    constexpr int NC = (MODE == 1) ? 8 : 16;
    LAS float* wl = (LAS float*)lds;
    LAS int* hist = (LAS int*)(lds + 65536); LAS int* basek = hist + 32; LAS int* rowinfo = hist + 64;
    const int lc = l; l &= 1;
    const float* modl = (const float*)(a.ws + WS_MOD) + (size_t)l * 8 * NMOD;
    const int shift_off = (MODE == 1) ? 0 : 3072, scale_off = (MODE == 1) ? 1024 : 4096;
    if (MODE == 1) { const float* W = a.w_in + (size_t)l * 1024 * DIN + 512; for (int i = tid; i < 1024 * 8; i += NWAVES * 64) wl[(i & 7) * 1024 + (i >> 3)] = W[(size_t)(i >> 3) * DIN + (i & 7)]; }
    else { for (int i = tid; i < 1024 * 16; i += NWAVES * 64) wl[(i & 15) * 1024 + (i >> 4)] = a.w_router[i]; if (tid < 32) hist[tid] = 0; }
    __syncthreads();
    bf16_t* H = (bf16_t*)(a.ws + WS_H);
    float* gate = (float*)(a.ws + WS_GATE); float* rw = (float*)(a.ws + WS_RW); int* list = (int*)(a.ws + WS_LIST);
    int* cnt = (int*)(a.ws + WS_CTL) + CW_CNT + lc * 32;
    const int rows_per = (T_TOK + ngw - 1) / ngw;
    const int row0 = gw * rows_per;
    f32x4 msc[4], msh[4];
    { const int b = row0 / SEQ;
#pragma unroll
      for (int j = 0; j < 4; ++j) { const int k0 = XBF ? (8 * lane + 512 * (j >> 1) + 4 * (j & 1)) : (4 * lane + 256 * j); msc[j] = *(const f32x4*)(modl + (size_t)b * NMOD + scale_off + k0); msh[j] = *(const f32x4*)(modl + (size_t)b * NMOD + shift_off + k0);
#pragma unroll
          for (int q = 0; q < 4; ++q) msc[j][q] += 1.f; } }
    f32x4 nx0[4], nx1[4];
#define NORM_LOAD(T0, LN) do { \
        if (XBF) { _Pragma("unroll") for (int jj = 0; jj < 2; ++jj) { const u32x4 q0 = *((const u32x4*)((const bf16_t*)xin + (size_t)(T0) * DM) + (LN) + 64 * jj), q1 = *((const u32x4*)((const bf16_t*)xin + (size_t)((T0) + 1) * DM) + (LN) + 64 * jj); \
                nx0[2 * jj] = bf4_lo(q0); nx0[2 * jj + 1] = bf4_hi(q0); nx1[2 * jj] = bf4_lo(q1); nx1[2 * jj + 1] = bf4_hi(q1); } } \
        else { _Pragma("unroll") for (int j = 0; j < 4; ++j) { nx0[j] = *((const f32x4*)((const float*)xin + (size_t)(T0) * DM) + (LN) + 64 * j); nx1[j] = *((const f32x4*)((const float*)xin + (size_t)((T0) + 1) * DM) + (LN) + 64 * j); } } } while (0)
    NORM_LOAD(row0, lane);
#pragma unroll 1
    for (int i = 0; i < rows_per; i += 2) {
        const int lane = lane_id_opaque();
        const int t0 = row0 + i; if (t0 >= T_TOK) break;
        constexpr bool has1 = true; const int t1 = t0 + 1;
        f32x4 v0[4], v1[4]; float ss0 = 0.f, ss1 = 0.f;
#pragma unroll
        for (int j = 0; j < 4; ++j) { v0[j] = nx0[j]; v1[j] = nx1[j]; }
        { const int tn = (i + 2 < rows_per) ? t0 + 2 : t0;
          NORM_LOAD(tn, lane); }
#pragma unroll
        for (int j = 0; j < 4; ++j) { ss0 += (v0[j][0] * v0[j][0] + v0[j][1] * v0[j][1]) + (v0[j][2] * v0[j][2] + v0[j][3] * v0[j][3]); ss1 += (v1[j][0] * v1[j][0] + v1[j][1] * v1[j][1]) + (v1[j][2] * v1[j][2] + v1[j][3] * v1[j][3]); }
#pragma unroll
        for (int o = 32; o > 0; o >>= 1) { ss0 += bperm_f(ss0, lane ^ o); ss1 += bperm_f(ss1, lane ^ o); }
        const float rs0 = rsqrtf(ss0 * (1.f / 1024.f) + EPS), rs1 = rsqrtf(ss1 * (1.f / 1024.f) + EPS);
        float lg0[NC], lg1[NC];
#pragma unroll
        for (int e = 0; e < NC; ++e) { lg0[e] = 0.f; lg1[e] = 0.f; }
#pragma unroll
        for (int j = 0; j < 4; ++j) {
            const int k0 = XBF ? (8 * lane + 512 * (j >> 1) + 4 * (j & 1)) : (4 * lane + 256 * j);
            f32x4 h0, h1;
#pragma unroll
            for (int q = 0; q < 4; ++q) { h0[q] = v0[j][q] * rs0 * msc[j][q] + msh[j][q]; h1[q] = v1[j][q] * rs1 * msc[j][q] + msh[j][q]; }
            u32x2 o0; o0.x = pk2(h0[0], h0[1]); o0.y = pk2(h0[2], h0[3]); *(u32x2*)(H + (size_t)t0 * DM + k0) = o0;
            if (has1) { u32x2 o1; o1.x = pk2(h1[0], h1[1]); o1.y = pk2(h1[2], h1[3]); *(u32x2*)(H + (size_t)t1 * DM + k0) = o1; }
#pragma unroll
            for (int e8 = 0; e8 < NC; e8 += 8) {
#pragma unroll
                for (int e = e8; e < e8 + 8; ++e) { const f32x4 w = *(const LAS f32x4*)(wl + e * 1024 + k0);
                    lg0[e] += (h0[0] * w[0] + h0[1] * w[1]) + (h0[2] * w[2] + h0[3] * w[3]); lg1[e] += (h1[0] * w[0] + h1[1] * w[1]) + (h1[2] * w[2] + h1[3] * w[3]); }
                __builtin_amdgcn_sched_barrier(0);
            }
        }
        const float r0 = reduce_tr<NC>(lg0, lane), r1 = reduce_tr<NC>(lg1, lane);
        if (MODE == 1) {
            if ((lane & 7) == 0) { gate[(size_t)t0 * 8 + (lane >> 3)] = r0; if (has1) gate[(size_t)t1 * 8 + (lane >> 3)] = r1; }
        } else {
#pragma unroll
            for (int rr = 0; rr < 2; ++rr) {
                if (rr == 1 && !has1) break;
                const float rv = rr ? r1 : r0; const int t = rr ? t1 : t0;
                float sc[16], bs[16];
#pragma unroll
                for (int e = 0; e < 16; ++e) { const float lgt = __int_as_float(__builtin_amdgcn_readlane(__float_as_int(rv), 4 * e)); sc[e] = sigmoidf_(lgt); bs[e] = sc[e] + a.router_bias[e]; }
                float best_gs = -1e30f; int bk = 0; float bw0 = 0.f, bw1 = 0.f;
#pragma unroll
                for (int g = 0; g < 4; ++g) {
                    int i0 = 0; float q0 = bs[4 * g]; float s0 = sc[4 * g];
#pragma unroll
                    for (int j = 1; j < 4; ++j) if (bs[4 * g + j] > q0) { q0 = bs[4 * g + j]; i0 = j; s0 = sc[4 * g + j]; }
                    int i1 = -1; float q1 = -1e30f; float s1 = 0.f;
#pragma unroll
                    for (int j = 0; j < 4; ++j) if (j != i0 && bs[4 * g + j] > q1) { q1 = bs[4 * g + j]; i1 = j; s1 = sc[4 * g + j]; }
                    const float gs = q0 + q1;
                    if (gs > best_gs) { best_gs = gs;
                        const int lo = i0 < i1 ? i0 : i1, hi = i0 < i1 ? i1 : i0; const float wlo = i0 < i1 ? s0 : s1, whi = i0 < i1 ? s1 : s0;
                        const int pq = (lo == 0) ? (hi - 1) : (lo == 1 ? hi + 1 : 5);
                        bk = 6 * g + pq; bw0 = wlo; bw1 = whi; }
                }
                if (lane == 0) {
                    const float inv = 1.f / (bw0 + bw1);
                    *(f32x2*)(rw + (size_t)t * 2) = (f32x2){bw0 * inv, bw1 * inv};
                    const int pos = __hip_atomic_fetch_add(&hist[bk], 1, __ATOMIC_RELAXED, __HIP_MEMORY_SCOPE_WORKGROUP);
                    rowinfo[t - (int)blockIdx.x * (NWAVES * rows_per)] = bk | (pos << 8);
                }
            }
        }
    }
#undef NORM_LOAD
    if (MODE == 2) {
        __syncthreads();
        if (tid < NBUCK) { const int n = hist[tid]; basek[tid] = n ? atomicAdd(&cnt[tid], n) : 0; }
        __syncthreads();
        const int nrows = NWAVES * rows_per, brow0 = (int)blockIdx.x * nrows;
        for (int i = tid; i < nrows; i += NWAVES * 64) { const int t = brow0 + i; if (t < T_TOK) { const int ri = rowinfo[i]; const int k = ri & 255; list[(size_t)k * T_TOK + basek[k] + (ri >> 8)] = t; } }
    }
}

__device__ __forceinline__ void build_moe_tab(const Args& a, int l, LAS int* tab, int wave_) {
    const int tid = wave_ * 64 + lane_id_opaque();
    const int* cnt = (const int*)(a.ws + WS_CTL) + CW_CNT + l * 32;
    if (tid < 32) tab[tid] = (tid < NBUCK) ? cnt[tid] : 0;
    __syncthreads();
    if (tid < NBUCK) {
        int base = 0;
#pragma unroll 1
        for (int j = 0; j < tid; ++j) base += (tab[j] + 255) >> 8;
        const int mine = (tab[tid] + 255) >> 8;
#pragma unroll 1
        for (int i = 0; i < mine; ++i) { tab[32 + base + i] = tid; tab[192 + base + i] = i * 256; }
        if (tid == NBUCK - 1) tab[352] = base + mine;
    }
    __syncthreads();
}

__device__ __forceinline__ void phase_final(const Args& a, int gw, int ngw, float oscale, const XcdBarrier& bar, int wave_) {
    const int lane = lane_id_opaque();
    const bf16_t* XB = (const bf16_t*)(a.ws + WS_H);
    const int rows_per = (T_TOK + ngw - 1) / ngw, row0 = gw * rows_per;
    f32x4 g[4];
#pragma unroll
    for (int j = 0; j < 4; ++j) g[j] = *(const f32x4*)(a.g_final + 8 * lane + 512 * (j >> 1) + 4 * (j & 1));
    u32x4 nx[2][2];
#pragma unroll
    for (int rr = 0; rr < 2; ++rr)
#pragma unroll
        for (int jj = 0; jj < 2; ++jj) nx[rr][jj] = *((const u32x4*)(XB + (size_t)(row0 + rr) * DM) + lane + 64 * jj);
#pragma unroll 1
    for (int i = 0; i < rows_per; i += 2) {
        const int t0 = row0 + i; if (t0 >= T_TOK) break;
        u32x4 xv[2][2];
#pragma unroll
        for (int rr = 0; rr < 2; ++rr)
#pragma unroll
            for (int jj = 0; jj < 2; ++jj) xv[rr][jj] = nx[rr][jj];
        { const int tn = (i + 2 < rows_per) ? t0 + 2 : t0;
#pragma unroll
          for (int rr = 0; rr < 2; ++rr)
#pragma unroll
              for (int jj = 0; jj < 2; ++jj) nx[rr][jj] = *((const u32x4*)(XB + (size_t)(tn + rr) * DM) + lane + 64 * jj); }
#pragma unroll
        for (int rr = 0; rr < 2; ++rr) {
            const f32x4 v[4] = {bf4_lo(xv[rr][0]), bf4_hi(xv[rr][0]), bf4_lo(xv[rr][1]), bf4_hi(xv[rr][1])};
            float ss = 0.f;
#pragma unroll
            for (int j = 0; j < 4; ++j) ss += (v[j][0] * v[j][0] + v[j][1] * v[j][1]) + (v[j][2] * v[j][2] + v[j][3] * v[j][3]);
            ss = wave_sum_l(ss, lane);
            const float rstd = rsqrtf(ss * (1.f / 1024.f) + EPS) * oscale;
            float* orow = a.out + (size_t)(t0 + rr) * DM;
#pragma unroll
            for (int j = 0; j < 4; ++j) *(f32x4*)(orow + 8 * lane + 512 * (j >> 1) + 4 * (j & 1)) = v[j] * rstd * g[j];
        }
    }
}

typedef float f32x16 __attribute__((ext_vector_type(16)));
typedef short s16x4 __attribute__((ext_vector_type(4)));
typedef short v4i16_t __attribute__((ext_vector_type(4)));
#define MFMA32(a, b, c) __builtin_amdgcn_mfma_f32_32x32x16_bf16((a), (b), (c), 0, 0, 0)
__device__ __forceinline__ int crow(int i, int h) { return (i & 3) + 8 * (i >> 2) + 4 * h; }
__device__ __forceinline__ unsigned cvtpk(float lo, float hi) { typedef float f2_t __attribute__((ext_vector_type(2))); typedef __bf16 b2_t __attribute__((ext_vector_type(2)));
    f2_t v = {lo, hi}; b2_t b = __builtin_convertvector(v, b2_t); return __builtin_bit_cast(unsigned, b); }
__device__ __forceinline__ bf16x8 pack8(const f32x16& x, int s) { u32x4 p; p.x = cvtpk(x[8 * s], x[8 * s + 1]); p.y = cvtpk(x[8 * s + 2], x[8 * s + 3]); p.z = cvtpk(x[8 * s + 4], x[8 * s + 5]); p.w = cvtpk(x[8 * s + 6], x[8 * s + 7]); return __builtin_bit_cast(bf16x8, p); }
__device__ __forceinline__ void halves(float v, float& v0, float& v1) { auto rr = __builtin_amdgcn_permlane32_swap(__float_as_uint(v), __float_as_uint(v), false, false); v0 = __uint_as_float(rr[0]); v1 = __uint_as_float(rr[1]); }
__device__ __forceinline__ s16x4 vtr(const LAS unsigned char* p) { return __builtin_bit_cast(s16x4, __builtin_amdgcn_ds_read_tr16_b64_v4i16((LAS v4i16_t*)p)); }
constexpr int VP = 144;
__device__ __forceinline__ bf16x8 vt_frag(const LAS unsigned char* vl, int vtr0, int s, int db) {
    const s16x4 lo = vtr(vl + vtr0 + s * (16 * VP) + db * 64), hi = vtr(vl + vtr0 + s * (16 * VP) + 8 * VP + db * 64);
    return __builtin_shufflevector(lo, hi, 0, 1, 2, 3, 4, 5, 6, 7); }

#define KT_WRITE(KL, KV) do { _Pragma("unroll") for (int i = 0; i < 4; ++i) *(LAS u32x4*)((KL) + (vrow + 8 * i) * 144 + vseg * 16) = KV[i]; } while (0)
#define KT_FRAG(KL, D0) (*(const LAS bf16x8*)((KL) + r * 144 + 32 * (D0) + 16 * hh))
#ifndef SB_EARLY_EXIT
#define SB_EARLY_EXIT 1
#endif
__device__ __forceinline__ void sb_item(const bf16_t* U, const float* gh  , bf16_t* Y, LAS unsigned char* vl, int b, int h, int qt, int lane) {
    const int r = lane & 31, hh = lane >> 5;
    const size_t rowb = (size_t)b * SEQ;
    const bf16_t* Qp = U + (rowb + 32 * qt + r) * LDU + OFF_SB + h * 64 + 8 * hh;
    bf16x8 qf[4];
#pragma unroll
    for (int d0 = 0; d0 < 4; ++d0) qf[d0] = *(const bf16x8*)(Qp + 16 * d0);
    f32x16 o0, o1;
#pragma unroll
    for (int i = 0; i < 16; ++i) { o0[i] = 0.f; o1[i] = 0.f; }
    float carry = 1.f;
    f32x4 gha[4], ghb[4];
#pragma unroll
    for (int g = 0; g < 4; ++g) { gha[g] = *(const f32x4*)(gh + 8 * g + 4 * hh); ghb[g] = *(const f32x4*)(gh + 32 + 8 * g + 4 * hh); }
    const bf16_t* Kb = U + rowb * LDU + OFF_SB + 384 + h * 64; const bf16_t* Vb = Kb + 384;
    const int vrow = lane >> 3, vseg = lane & 7;
    const int i16 = lane & 15, q4 = i16 >> 2, p4 = i16 & 3, blk = (lane >> 4) & 1;
    const int vtr0 = (4 * hh + q4) * VP + (16 * blk + 4 * p4) * 2;
    unsigned loff[4];
#pragma unroll
    for (int i = 0; i < 4; ++i) loff[i] = (unsigned)((vrow + 8 * i) * LDU + 8 * vseg) * 2u;
#define SB_LOAD(KT, KF, VV) do { const char* kb_ = (const char*)(Kb + (size_t)(32 * (KT)) * LDU); \
        _Pragma("unroll") for (int i = 0; i < 4; ++i) { KF[i] = *(const u32x4*)(kb_ + loff[i]); VV[i] = *(const u32x4*)(kb_ + 768 + loff[i]); } } while (0)
#define SB_TILE(KT, KF, VV) do { \
        KT_WRITE(kl, KF); \
        _Pragma("unroll") for (int i = 0; i < 4; ++i) *(LAS u32x4*)(vl + (vrow + 8 * i) * VP + vseg * 16) = VV[i]; \
        f32x16 sc; \
        _Pragma("unroll") for (int i = 0; i < 16; ++i) sc[i] = 0.f; \
        _Pragma("unroll") for (int d0 = 0; d0 < 4; ++d0) sc = MFMA32(KT_FRAG(kl, d0), qf[d0], sc); \
        float sg[16], kp[16]; \
        _Pragma("unroll") for (int i = 0; i < 16; ++i) { \
            const float z2 = fminf(sc[i] * (-0.125f * 1.4426950408889634f), 115.f); \
            const float e = __builtin_amdgcn_exp2f(z2); float sig = __builtin_amdgcn_rcpf(1.f + e); float keep = e * sig; \
            if ((KT) == qt) { const bool valid = crow(i, hh) < r; sig = valid ? sig : 0.f; keep = valid ? keep : 1.f; } \
            sg[i] = sig; kp[i] = keep; } \
        float G0[4], G1[4], PP[4]; \
        _Pragma("unroll") for (int g = 0; g < 4; ++g) { const float G = (kp[4 * g] * kp[4 * g + 1]) * (kp[4 * g + 2] * kp[4 * g + 3]); halves(G, G0[g], G1[g]); PP[g] = G0[g] * G1[g]; } \
        float SP[4]; SP[3] = 1.f; SP[2] = PP[3]; SP[1] = PP[3] * PP[2]; SP[0] = SP[1] * PP[1]; \
        const float total = SP[0] * PP[0]; \
        _Pragma("unroll") for (int g = 0; g < 4; ++g) { \
            const float r3 = carry * SP[g] * (hh ? 1.f : G1[g]); \
            const float r2 = r3 * kp[4 * g + 3], r1 = r2 * kp[4 * g + 2], r0 = r1 * kp[4 * g + 1]; \
            sc[4 * g + 3] = sg[4 * g + 3] * r3; sc[4 * g + 2] = sg[4 * g + 2] * r2; sc[4 * g + 1] = sg[4 * g + 1] * r1; sc[4 * g] = sg[4 * g] * r0; } \
        carry *= total; \
        const bf16x8 pb0 = pack8(sc, 0), pb1 = pack8(sc, 1); \
        o0 = MFMA32(vt_frag(vl, vtr0, 0, 0), pb0, o0); o0 = MFMA32(vt_frag(vl, vtr0, 1, 0), pb1, o0); \
        o1 = MFMA32(vt_frag(vl, vtr0, 0, 1), pb0, o1); o1 = MFMA32(vt_frag(vl, vtr0, 1, 1), pb1, o1); } while (0)
#define SB_DONE() (SB_EARLY_EXIT && __builtin_amdgcn_ballot_w64(carry >= 1e-37f) == 0ull)
    {
        u32x4 kA[4], kB[4], vA[4], vB[4];
        LAS unsigned char* kl = vl + 4608;
        int kt = qt;
        SB_LOAD(kt, kA, vA);
#pragma unroll 1
        for (;;) {
            if (kt > 0) SB_LOAD(kt - 1, kB, vB);
            SB_TILE(kt, kA, vA);
            if (kt == 0 || SB_DONE()) break;
            --kt;
            if (kt > 0) SB_LOAD(kt - 1, kA, vA);
            SB_TILE(kt, kB, vB);
            if (kt == 0 || SB_DONE()) break;
            --kt;
        }
    }
#undef SB_LOAD
#undef SB_TILE
#undef SB_DONE
    float ss = 0.f;
#pragma unroll
    for (int i = 0; i < 16; ++i) ss += o0[i] * o0[i] + o1[i] * o1[i];
    float s0, s1; halves(ss, s0, s1);
    const float rs = rsqrtf((s0 + s1) * (1.f / 64.f) + EPS);
    bf16_t* yr = Y + (rowb + 32 * qt + r) * 1024 + (10 + h) * 64;
#pragma unroll
    for (int g = 0; g < 4; ++g) {
        const int d0 = 8 * g + 4 * hh;
        const f32x4 ga = gha[g], gb = ghb[g];
        u32x2 wa, wb; wa.x = cvtpk(o0[4 * g] * rs * ga[0], o0[4 * g + 1] * rs * ga[1]); wa.y = cvtpk(o0[4 * g + 2] * rs * ga[2], o0[4 * g + 3] * rs * ga[3]);
        wb.x = cvtpk(o1[4 * g] * rs * gb[0], o1[4 * g + 1] * rs * gb[1]); wb.y = cvtpk(o1[4 * g + 2] * rs * gb[2], o1[4 * g + 3] * rs * gb[3]);
        *(u32x2*)(yr + d0) = wa; *(u32x2*)(yr + 32 + d0) = wb;
    }
}
__device__ __forceinline__ void phase_sb(const Args& a, int l, LAS unsigned char* lds, int gw, int ngw, int wave_) {
    const int lane = lane_id_opaque();
    LAS unsigned char* vl = lds + wave_ * 16384;
    const bf16_t* U = (const bf16_t*)(a.ws + WS_U); bf16_t* Y = (bf16_t*)(a.ws + WS_Y);
    for (int it = gw; it < NB * 6 * 128; it += ngw) {
        const int qt = 127 - (it % 128), h = (it / 128) % 6, b = it / 768;
        sb_item(U, a.g_head + l * 1024 + (10 + h) * 64, Y, vl, b, h, qt, lane);
    }
}


#ifdef TS_DIL
#define TSD(k) do { if (tsacc) { const unsigned long long t_ = __builtin_amdgcn_s_memrealtime(); if (TS_DIL == (k)) *tsacc += t_ - tsd_; tsd_ = t_; } } while (0)
#else
#define TSD(k) do { } while (0)
#endif
__device__ __forceinline__ void dil_item(const bf16_t* U, bf16_t* OP, int op_pitch, float* LSE, LAS unsigned char* vl, int b, int h, int p, int qi, int lane, unsigned long long* tsacc) {
#ifdef TS_DIL
    unsigned long long tsd_ = __builtin_amdgcn_s_memrealtime();
#endif
    const int r = lane & 31, hh = lane >> 5;
    const int sh = 2 * p, d = 1 << sh, nblk = (SEQ >> sh) / 32, c = qi / nblk, m0 = 32 * (qi % nblk);
    const size_t rowb = (size_t)b * SEQ;
    const int tq = ((m0 + r) << sh) + c;
    const bf16_t* Qp = U + (rowb + tq) * LDU + OFF_DIL + h * 64 + 8 * hh;
    bf16x8 qf[4];
#pragma unroll
    for (int d0 = 0; d0 < 4; ++d0) qf[d0] = *(const bf16x8*)(Qp + 16 * d0);
    const float sb = exp2f(-8.f * (float)(h + 1) / 6.f) * (float)d * 1.4426950408889634f;
    f32x16 o0, o1;
#pragma unroll
    for (int i = 0; i < 16; ++i) { o0[i] = 0.f; o1[i] = 0.f; }
    float m_run = -1e30f, l_run = 0.f;
    const bf16_t* Kb = U + rowb * LDU + OFF_DIL + 384 + h * 64; const bf16_t* Vb = Kb + 384;
    const int vrow = lane >> 3, vseg = lane & 7;
    const int i16 = lane & 15, q4 = i16 >> 2, p4 = i16 & 3, blk = (lane >> 4) & 1;
    const int vtr0 = (4 * hh + q4) * VP + (16 * blk + 4 * p4) * 2;
    unsigned loff[4];
#pragma unroll
    for (int i = 0; i < 4; ++i) loff[i] = (unsigned)(((vrow + 8 * i) << sh) * LDU + 8 * vseg) * 2u;
#define DL_LOAD(J, KF, VV) do { const int mk0_ = m0 - 128 + 32 * (J); const char* kb_ = (const char*)(Kb + (size_t)((mk0_ << sh) + c) * LDU); \
        _Pragma("unroll") for (int i = 0; i < 4; ++i) { KF[i] = *(const u32x4*)(kb_ + loff[i]); VV[i] = *(const u32x4*)(kb_ + 768 + loff[i]); } } while (0)
#define DL_TILE(J, KF, VV) do { \
        KT_WRITE(kl, KF); \
        _Pragma("unroll") for (int i = 0; i < 4; ++i) *(LAS u32x4*)(vl + (vrow + 8 * i) * VP + vseg * 16) = VV[i]; \
        f32x16 sc; \
        _Pragma("unroll") for (int i = 0; i < 16; ++i) sc[i] = 0.f; \
        _Pragma("unroll") for (int d0 = 0; d0 < 4; ++d0) sc = MFMA32(KT_FRAG(kl, d0), qf[d0], sc); \
        float mx = -1e30f; \
        const float base2 = -sb * (float)(r + 128 - 32 * (J) - 4 * hh); \
        _Pragma("unroll") for (int i = 0; i < 16; ++i) { \
            const int cr = crow(i, hh); \
            float v = fmaf(sb, (float)((i & 3) + 8 * (i >> 2)), fmaf(sc[i], 0.125f * 1.4426950408889634f, base2)); \
            if ((J) == 4) v = (cr <= r) ? v : -1e30f; \
            if ((J) == 0) v = (cr >= r) ? v : -1e30f; \
            sc[i] = v; mx = fmaxf(mx, v); } \
        float mx0, mx1; halves(mx, mx0, mx1); \
        const float m_new = fmaxf(m_run, fmaxf(mx0, mx1)); \
        const float corr = __builtin_amdgcn_exp2f(m_run - m_new); \
        float ps = 0.f; \
        _Pragma("unroll") for (int i = 0; i < 16; ++i) { const float pe = __builtin_amdgcn_exp2f(sc[i] - m_new); sc[i] = pe; ps += pe; } \
        float ps0, ps1; halves(ps, ps0, ps1); \
        l_run = l_run * corr + (ps0 + ps1); \
        if (__builtin_amdgcn_ballot_w64(m_new != m_run) != 0ull) { _Pragma("unroll") for (int i = 0; i < 16; ++i) { o0[i] *= corr; o1[i] *= corr; } } \
        m_run = m_new; \
        const bf16x8 pb0 = pack8(sc, 0), pb1 = pack8(sc, 1); \
        o0 = MFMA32(vt_frag(vl, vtr0, 0, 0), pb0, o0); o0 = MFMA32(vt_frag(vl, vtr0, 1, 0), pb1, o0); \
        o1 = MFMA32(vt_frag(vl, vtr0, 0, 1), pb0, o1); o1 = MFMA32(vt_frag(vl, vtr0, 1, 1), pb1, o1); } while (0)
    {
        TSD(0);
        const int jmin = (m0 >= 128) ? 0 : (4 - m0 / 32);
        u32x4 kA[4], kB[4], vA[4], vB[4];
        LAS unsigned char* kl = vl + 4608;
        int j = 4;
        DL_LOAD(j, kA, vA);
#pragma unroll 1
        for (;;) {
            if (j > jmin) DL_LOAD(j - 1, kB, vB);
            DL_TILE(j, kA, vA);
            if (j == jmin) break;
            --j;
            if (j > jmin) DL_LOAD(j - 1, kA, vA);
            DL_TILE(j, kB, vB);
            if (j == jmin) break;
            --j;
        }
    }
#undef DL_LOAD
#undef DL_TILE
    TSD(1);
    const float inv = 1.f / l_run;
    bf16_t* orow = OP + (rowb + tq) * op_pitch + h * 64;
#pragma unroll
    for (int g = 0; g < 4; ++g) {
        const int d0 = 8 * g + 4 * hh;
        u32x2 wa, wb; wa.x = cvtpk(o0[4 * g] * inv, o0[4 * g + 1] * inv); wa.y = cvtpk(o0[4 * g + 2] * inv, o0[4 * g + 3] * inv);
        wb.x = cvtpk(o1[4 * g] * inv, o1[4 * g + 1] * inv); wb.y = cvtpk(o1[4 * g + 2] * inv, o1[4 * g + 3] * inv);
        *(u32x2*)(orow + d0) = wa; *(u32x2*)(orow + 32 + d0) = wb;
    }
    if (hh == 0) LSE[(rowb + tq) * 6 + h] = m_run * 0.6931471805599453f + __logf(l_run);
    TSD(2);
}
__device__ __forceinline__ bf16_t* dil_op(unsigned char* ws, int p) { return (p == 0) ? (bf16_t*)(ws + WS_Y) + 256 : ((p == 1) ? (bf16_t*)(ws + WS_OP1) : (bf16_t*)(ws + WS_OP2)); }
__device__ __forceinline__ int dil_pitch(int p) { return p == 0 ? 1024 : 384; }
__device__ __forceinline__ void phase_dil(const Args& a, int l, LAS unsigned char* lds, int gw, int ngw, int wave_, int p_lo, int p_hi) {
    const int lane = lane_id_opaque();
    LAS unsigned char* vl = lds + wave_ * 16384;
    const bf16_t* U = (const bf16_t*)(a.ws + WS_U);
    for (int it = gw; it < (p_hi - p_lo) * NB * 6 * 128; it += ngw) {
        const int qi = it % 128, h = (it / 128) % 6, b = (it / 768) % NB, p = p_lo + it / (768 * NB);
        dil_item(U, dil_op(a.ws, p), dil_pitch(p), (float*)(a.ws + WS_LSE) + (size_t)p * T_TOK * 6, vl, b, h, p, qi, lane,
#ifdef TS_DIL
                 (gw == 77 && lane == 0 && l == 0) ? (unsigned long long*)((unsigned*)(a.ws + WS_CTL) + 12288) + 40 : nullptr
#else
                 nullptr
#endif
                 );
    }
}
__device__ __forceinline__ void phase_dil_merge(const Args& a, int l, int gw, int ngw) {
    const int lane = lane_id_opaque(); const int pr = lane >> 3, ch = lane & 7;
    const bf16_t* O0 = dil_op(a.ws, 0); const bf16_t* O1 = dil_op(a.ws, 1); const bf16_t* O2 = dil_op(a.ws, 2);
    const float* L0 = (const float*)(a.ws + WS_LSE); const float* L1 = L0 + (size_t)T_TOK * 6; const float* L2 = L1 + (size_t)T_TOK * 6;
    bf16_t* Y = (bf16_t*)(a.ws + WS_Y);
    for (int it = gw; it < T_TOK * 6 / 8; it += ngw) {
        const int pi = it * 8 + pr; const int t = pi / 6, hd = pi - 6 * t;
        const float l0 = L0[pi], l1 = L1[pi], l2 = L2[pi];
        const size_t o = (size_t)t * 384 + hd * 64 + ch * 8;
        const u32x4 a0 = *(const u32x4*)(O0 + (size_t)t * 1024 + hd * 64 + ch * 8), a1 = *(const u32x4*)(O1 + o), a2 = *(const u32x4*)(O2 + o);
        const float mx = fmaxf(l0, fmaxf(l1, l2));
        float w0 = __expf(l0 - mx), w1 = __expf(l1 - mx), w2 = __expf(l2 - mx); const float inv = 1.f / (w0 + w1 + w2); w0 *= inv; w1 *= inv; w2 *= inv;
        float v[8]; float ss = 0.f;
#pragma unroll
        for (int q = 0; q < 4; ++q) {
            v[2 * q]     = w0 * __uint_as_float(a0[q] << 16) + w1 * __uint_as_float(a1[q] << 16) + w2 * __uint_as_float(a2[q] << 16);
            v[2 * q + 1] = w0 * __uint_as_float(a0[q] & 0xffff0000u) + w1 * __uint_as_float(a1[q] & 0xffff0000u) + w2 * __uint_as_float(a2[q] & 0xffff0000u);
            ss += v[2 * q] * v[2 * q] + v[2 * q + 1] * v[2 * q + 1];
        }
#pragma unroll
        for (int of = 1; of < 8; of <<= 1) ss += bperm_f(ss, lane ^ of);
        const float rs = rsqrtf(ss * (1.f / 64.f) + EPS);
        const float* gh = a.g_head + l * 1024 + (4 + hd) * 64 + ch * 8;
        const f32x4 ga = *(const f32x4*)gh, gb = *(const f32x4*)(gh + 4);
        u32x4 w; w.x = cvtpk(v[0] * rs * ga[0], v[1] * rs * ga[1]); w.y = cvtpk(v[2] * rs * ga[2], v[3] * rs * ga[3]); w.z = cvtpk(v[4] * rs * gb[0], v[5] * rs * gb[1]); w.w = cvtpk(v[6] * rs * gb[2], v[7] * rs * gb[3]);
        *(u32x4*)(Y + (size_t)t * 1024 + (4 + hd) * 64 + ch * 8) = w;
    }
}

__device__ __forceinline__ float scan_add64(float v, int lane) {
#pragma unroll
    for (int o = 1; o < 64; o <<= 1) { const float t = bperm_f(v, lane - o); v = (lane >= o) ? v + t : v; }
    return v; }
__device__ __forceinline__ float scan_max64(float v, int lane) {
#pragma unroll
    for (int o = 1; o < 64; o <<= 1) { const float t = bperm_f(v, lane - o); v = (lane >= o) ? fmaxf(v, t) : v; }
    return v; }
__device__ __forceinline__ float bcast63(float v) { return __int_as_float(__builtin_amdgcn_readlane(__float_as_int(v), 63)); }

__device__ __forceinline__ void ml_b1_item(const Args& a, int l, LAS unsigned char* wl  , int b, int h, int c, int half) {
    const int bh = b * 4 + h;
    const size_t rowb = (size_t)b * SEQ + 128 * c;
    unsigned char* mls = a.ws + WS_MLS;
    LAS float* cw = (LAS float*)(wl + 9216);
    float w0, w1;
    const bf16_t* U = (const bf16_t*)(a.ws + WS_U);
    bf16_t* Qm = (bf16_t*)(a.ws + WS_QKV); bf16_t* Km = Qm + (size_t)T_TOK * 256; bf16_t* Vm = Km + (size_t)T_TOK * 256;
    { const int lane = lane_id_opaque();
    const float* GATE = (const float*)(a.ws + WS_GATE);
    const float gbi = a.gate_bias[l * 8 + h], gbf = a.gate_bias[l * 8 + 4 + h];
    const size_t t0 = rowb + lane, t1 = t0 + 64;
    const float ig0 = GATE[t0 * 8 + h] + gbi, ig1 = GATE[t1 * 8 + h] + gbi;
    const float lf0 = -softplusf_(-(GATE[t0 * 8 + 4 + h] + gbf)), lf1 = -softplusf_(-(GATE[t1 * 8 + 4 + h] + gbf));
    const float c0 = scan_add64(lf0, lane); const float c1 = scan_add64(lf1, lane) + bcast63(c0);
    const float a0 = ig0 - c0, a1 = ig1 - c1;
    const float p0 = scan_max64(a0, lane); const float p1 = fmaxf(scan_max64(a1, lane), bcast63(p0));
    const float Amax = bcast63(p1), Lsum = bcast63(c1);
    if (half == 0) {
    ((float*)(mls + MLS_CUM))[t0 * 4 + h] = c0; ((float*)(mls + MLS_CUM))[t1 * 4 + h] = c1;
    ((float*)(mls + MLS_AA))[t0 * 4 + h] = a0;  ((float*)(mls + MLS_AA))[t1 * 4 + h] = a1;
    ((float*)(mls + MLS_PM))[t0 * 4 + h] = p0;  ((float*)(mls + MLS_PM))[t1 * 4 + h] = p1;
    if (lane == 0) { ((float*)(mls + MLS_AMAX))[bh * 32 + c] = Amax; ((float*)(mls + MLS_LSUM))[bh * 32 + c] = Lsum; }
    }
    w0 = __expf(a0 - Amax); w1 = __expf(a1 - Amax);
#pragma unroll
    for (int j = 0; j < 4; ++j) cw[j * 64 + lane] = a.conv_w[(l * 4 + j) * 256 + h * 64 + lane];
    cw[256 + lane] = a.conv_b[l * 256 + h * 64 + lane];
    }
    const bf16_t* WT = (const bf16_t*)(mls + MLS_WT) + (size_t)(l * 3 * 4 + h) * 4096;
    LAS unsigned char* vt = wl; LAS unsigned char* kt = wl + 4608;
    f32x16 acc[2][2], nacc[2];
#pragma unroll
    for (int i = 0; i < 16; ++i) { acc[0][0][i] = 0.f; acc[0][1][i] = 0.f; acc[1][0][i] = 0.f; acc[1][1][i] = 0.f; nacc[0][i] = 0.f; nacc[1][i] = 0.f; }
    bf16x8 ones;
#pragma unroll
    for (int j = 0; j < 8; ++j) ones[j] = (short)0x3F80;
#pragma unroll 1
    for (int st = 2 * half; st < 2 * half + 2; ++st) {
        const int lane = lane_id_opaque(); const int r = lane & 31, hh = lane >> 5;
        const int i16 = lane & 15, q4 = i16 >> 2, p4 = i16 & 3, blk = (lane >> 4) & 1;
        const int vtr0 = (4 * hh + q4) * VP + (16 * blk + 4 * p4) * 2;
        const size_t row = rowb + 32 * st + r; const int tt = 128 * c + 32 * st + r;
        const float wt = bperm_f((st < 2) ? w0 : w1, 32 * (st & 1) + r);
        bf16x8 xcf[4], xmf[4];
        bf16x8 xa[4][4];
#pragma unroll
        for (int d0 = 0; d0 < 4; ++d0) {
            const int ch = 16 * d0 + 8 * hh;
#pragma unroll
            for (int j = 0; j < 4; ++j) { const bool ok = (tt - 3 + j >= 0); const bf16x8 ld = *(const bf16x8*)(U + (ok ? row - 3 + j : row) * LDU + OFF_ML_X + h * 64 + ch);
                const u32x4 lu = __builtin_bit_cast(u32x4, ld); u32x4 z; z.x = ok ? lu.x : 0u; z.y = ok ? lu.y : 0u; z.z = ok ? lu.z : 0u; z.w = ok ? lu.w : 0u; xa[d0][j] = __builtin_bit_cast(bf16x8, z); }
        }
#pragma unroll
        for (int d0 = 0; d0 < 4; ++d0) {
            const int ch = 16 * d0 + 8 * hh;
            const bf16x8 (&x)[4] = xa[d0];
            xmf[d0] = x[3];
            float xv[8];
            { const f32x4 ba = *(const LAS f32x4*)(cw + 256 + ch), bb = *(const LAS f32x4*)(cw + 256 + ch + 4);
              xv[0] = ba[0]; xv[1] = ba[1]; xv[2] = ba[2]; xv[3] = ba[3]; xv[4] = bb[0]; xv[5] = bb[1]; xv[6] = bb[2]; xv[7] = bb[3]; }
#pragma unroll
            for (int j = 0; j < 4; ++j) { const f32x4 wa = *(const LAS f32x4*)(cw + j * 64 + ch), wb = *(const LAS f32x4*)(cw + j * 64 + ch + 4);
#pragma unroll
                for (int e = 0; e < 4; ++e) { xv[e] += wa[e] * bf2f((bf16_t)x[j][e]); xv[4 + e] += wb[e] * bf2f((bf16_t)x[j][4 + e]); } }
            u32x4 pk;
            pk.x = cvtpk(xv[0] * sigmoidf_(xv[0]), xv[1] * sigmoidf_(xv[1])); pk.y = cvtpk(xv[2] * sigmoidf_(xv[2]), xv[3] * sigmoidf_(xv[3]));
            pk.z = cvtpk(xv[4] * sigmoidf_(xv[4]), xv[5] * sigmoidf_(xv[5])); pk.w = cvtpk(xv[6] * sigmoidf_(xv[6]), xv[7] * sigmoidf_(xv[7]));
            xcf[d0] = __builtin_bit_cast(bf16x8, pk);
        }
#pragma unroll
        for (int w = 0; w < 3; ++w) {
            bf16x8 wf[2][4];
#pragma unroll
            for (int eb = 0; eb < 2; ++eb)
#pragma unroll
                for (int d0 = 0; d0 < 4; ++d0) wf[eb][d0] = *(const bf16x8*)(WT + (size_t)w * 4 * 4096 + (32 * eb + r) * 64 + 16 * d0 + 8 * hh);
#pragma unroll
            for (int eb = 0; eb < 2; ++eb) {
                f32x16 pr;
#pragma unroll
                for (int i = 0; i < 16; ++i) pr[i] = 0.f;
#pragma unroll
                for (int d0 = 0; d0 < 4; ++d0) pr = MFMA32(wf[eb][d0], (w == 2) ? xmf[d0] : xcf[d0], pr);
                bf16_t* dst = ((w == 0) ? Qm : (w == 1 ? Km : Vm)) + row * 256 + h * 64 + 32 * eb;
#pragma unroll
                for (int g = 0; g < 4; ++g) {
                    const int e0 = 8 * g + 4 * hh;
                    u32x2 o; o.x = cvtpk(pr[4 * g], pr[4 * g + 1]); o.y = cvtpk(pr[4 * g + 2], pr[4 * g + 3]);
                    *(u32x2*)(dst + e0) = o;
                    if (w == 1) { u32x2 k2; k2.x = cvtpk(pr[4 * g] * wt, pr[4 * g + 1] * wt); k2.y = cvtpk(pr[4 * g + 2] * wt, pr[4 * g + 3] * wt); *(LAS u32x2*)(kt + r * VP + (32 * eb + e0) * 2) = k2; }
                    if (w == 2) *(LAS u32x2*)(vt + r * VP + (32 * eb + e0) * 2) = o;
                }
            }
            __builtin_amdgcn_sched_barrier(0);
        }
#pragma unroll
        for (int sk = 0; sk < 2; ++sk) {
            const bf16x8 kb0 = vt_frag(kt, vtr0, sk, 0), kb1 = vt_frag(kt, vtr0, sk, 1), va0 = vt_frag(vt, vtr0, sk, 0), va1 = vt_frag(vt, vtr0, sk, 1);
            acc[0][0] = MFMA32(va0, kb0, acc[0][0]); acc[0][1] = MFMA32(va0, kb1, acc[0][1]);
            acc[1][0] = MFMA32(va1, kb0, acc[1][0]); acc[1][1] = MFMA32(va1, kb1, acc[1][1]);
            nacc[0] = MFMA32(ones, kb0, nacc[0]); nacc[1] = MFMA32(ones, kb1, nacc[1]);
        }
    }
    const int lane = lane_id_opaque(); const int r = lane & 31, hh = lane >> 5;
    float* CL = (float*)(a.ws + WS_CLOC) + ((size_t)half * 1024 + bh * 32 + c) * 4096;
#pragma unroll
    for (int eb = 0; eb < 2; ++eb)
#pragma unroll
        for (int db = 0; db < 2; ++db)
#pragma unroll
            for (int i = 0; i < 16; ++i) CL[(32 * eb + crow(i, hh)) * 64 + 32 * db + r] = acc[eb][db][i];
    if (hh == 0) { float* NL = (float*)(mls + MLS_NLOC) + ((size_t)half * 1024 + bh * 32 + c) * 64; NL[r] = nacc[0][0]; NL[32 + r] = nacc[1][0]; }
}

__device__ __forceinline__ void phase_ml_b2(const Args& a, int gthread, int nthreads) {
    unsigned char* mls = a.ws + WS_MLS;
    const float* AM = (const float*)(mls + MLS_AMAX); const float* LS = (const float*)(mls + MLS_LSUM);
    for (int idx = gthread; idx < 32 * 4096; idx += nthreads) {
        const int bh = idx >> 12, ed = idx & 4095;
        const float* CL = (const float*)(a.ws + WS_CLOC) + (size_t)bh * 32 * 4096 + ed;
        bf16_t* CT = (bf16_t*)(a.ws + WS_CT) + (size_t)bh * 32 * 4096 + ed;
        const bool isn = ed < 64;
        const float* NL = (const float*)(mls + MLS_NLOC) + (size_t)bh * 32 * 64 + (ed & 63);
        float* NCp = (float*)(mls + MLS_NC) + (size_t)bh * 32 * 64 + (ed & 63);
        float C = 0.f, n = 0.f, m = 0.f;
        float cl[32];
#pragma unroll
        for (int c = 0; c < 32; ++c) cl[c] = CL[(size_t)c * 4096] + CL[(size_t)(1024 + c) * 4096];
#pragma unroll
        for (int c = 0; c < 32; ++c) {
            CT[(size_t)c * 4096] = f2bf(C);
            if (isn) NCp[c * 64] = n;
            if (ed == 0) ((float*)(mls + MLS_MC))[bh * 32 + c] = m;
            const float A = AM[bh * 32 + c], L = LS[bh * 32 + c];
            const float M = fmaxf(m, A); const float dec = __expf(m - M), sc = __expf(A - M);
            C = dec * C + sc * cl[c];
            if (isn) n = dec * n + sc * (NL[c * 64] + NL[(1024 + c) * 64]);
            m = L + M;
        }
    }
}

__device__ __forceinline__ void ml_b3_item(const Args& a, int l, LAS unsigned char* wl, int b, int h, int c, int qt, int lane) {
    const int r = lane & 31, hh = lane >> 5, bh = b * 4 + h;
    const size_t rowc = (size_t)b * SEQ + 128 * c, rowq = rowc + 32 * qt + r;
    unsigned char* mls = a.ws + WS_MLS;
    const bf16_t* Qm = (const bf16_t*)(a.ws + WS_QKV); const bf16_t* Km = Qm + (size_t)T_TOK * 256; const bf16_t* Vm = Km + (size_t)T_TOK * 256;
    LAS float* atab = (LAS float*)(wl + 4608);
    atab[lane] = ((const float*)(mls + MLS_AA))[(rowc + lane) * 4 + h]; atab[64 + lane] = ((const float*)(mls + MLS_AA))[(rowc + 64 + lane) * 4 + h];
    const float cum_t = ((const float*)(mls + MLS_CUM))[rowq * 4 + h], pm_t = ((const float*)(mls + MLS_PM))[rowq * 4 + h];
    const float m_c = ((const float*)(mls + MLS_MC))[bh * 32 + c];
    const float M_t = fmaxf(m_c, pm_t), inter = __expf(m_c - M_t), m_t = cum_t + M_t;
    bf16x8 qf[4];
#pragma unroll
    for (int d0 = 0; d0 < 4; ++d0) qf[d0] = *(const bf16x8*)(Qm + rowq * 256 + h * 64 + 16 * d0 + 8 * hh);
    const bf16_t* og = (const bf16_t*)(a.ws + WS_U) + rowq * LDU + OFF_ML_O + h * 64;
    const float* gh = a.g_head + l * 1024 + h * 64;
    u32x2 oga[4], ogb[4]; f32x4 gha[4], ghb[4];
#pragma unroll
    for (int g = 0; g < 4; ++g) { const int d0 = 8 * g + 4 * hh; oga[g] = *(const u32x2*)(og + d0); ogb[g] = *(const u32x2*)(og + 32 + d0); gha[g] = *(const f32x4*)(gh + d0); ghb[g] = *(const f32x4*)(gh + 32 + d0); }
    const float* NCp = (const float*)(mls + MLS_NC) + (size_t)(bh * 32 + c) * 64;
    f32x4 nca[4], ncb[4];
#pragma unroll
    for (int d0 = 0; d0 < 4; ++d0) { nca[d0] = *(const f32x4*)(NCp + 16 * d0 + 8 * hh); ncb[d0] = *(const f32x4*)(NCp + 16 * d0 + 8 * hh + 4); }
    const bf16_t* CT = (const bf16_t*)(a.ws + WS_CT) + (size_t)(bh * 32 + c) * 4096;
    bf16x8 ctf[2][4];
#pragma unroll
    for (int d0 = 0; d0 < 4; ++d0) { ctf[0][d0] = *(const bf16x8*)(CT + (size_t)r * 64 + 16 * d0 + 8 * hh); ctf[1][d0] = *(const bf16x8*)(CT + (size_t)(32 + r) * 64 + 16 * d0 + 8 * hh); }
    f32x16 n0, n1;
#pragma unroll
    for (int i = 0; i < 16; ++i) { n0[i] = 0.f; n1[i] = 0.f; }
#pragma unroll
    for (int d0 = 0; d0 < 4; ++d0) { n0 = MFMA32(ctf[0][d0], qf[d0], n0); n1 = MFMA32(ctf[1][d0], qf[d0], n1); }
    float qn = 0.f;
#pragma unroll
    for (int d0 = 0; d0 < 4; ++d0) { const f32x4 na = nca[d0], nb = ncb[d0];
#pragma unroll
        for (int e = 0; e < 4; ++e) { qn += bf2f((bf16_t)qf[d0][e]) * na[e]; qn += bf2f((bf16_t)qf[d0][4 + e]) * nb[e]; } }
    float qn0, qn1; halves(qn, qn0, qn1); qn = qn0 + qn1;
#pragma unroll
    for (int i = 0; i < 16; ++i) { n0[i] *= inter; n1[i] *= inter; }
    float dsum = 0.f;
    const int vrow = lane >> 3, vseg = lane & 7;
    const int i16 = lane & 15, q4 = i16 >> 2, p4 = i16 & 3, blk = (lane >> 4) & 1;
    const int vtr0 = (4 * hh + q4) * VP + (16 * blk + 4 * p4) * 2;
    LAS unsigned char* vl = wl;
    unsigned loff[4];
#pragma unroll
    for (int i = 0; i < 4; ++i) loff[i] = (unsigned)((vrow + 8 * i) * 256 + 8 * vseg) * 2u;
#define B3_LOAD(KT, KF, VV) do { const size_t tb_ = (rowc + 32 * (KT)) * 256 + h * 64; const char* kb_ = (const char*)(Km + tb_); const char* vb_ = (const char*)(Vm + tb_); \
        _Pragma("unroll") for (int i = 0; i < 4; ++i) { KF[i] = *(const u32x4*)(kb_ + loff[i]); VV[i] = *(const u32x4*)(vb_ + loff[i]); } } while (0)
#define B3_TILE(KT, KF, VV) do { \
        KT_WRITE(kl, KF); \
        _Pragma("unroll") for (int i = 0; i < 4; ++i) *(LAS u32x4*)(vl + (vrow + 8 * i) * VP + vseg * 16) = VV[i]; \
        f32x16 sc; \
        _Pragma("unroll") for (int i = 0; i < 16; ++i) sc[i] = 0.f; \
        _Pragma("unroll") for (int d0 = 0; d0 < 4; ++d0) sc = MFMA32(KT_FRAG(kl, d0), qf[d0], sc); \
        _Pragma("unroll") for (int g = 0; g < 4; ++g) { \
            const f32x4 av = *(const LAS f32x4*)(atab + 32 * (KT) + 8 * g + 4 * hh); \
            _Pragma("unroll") for (int e = 0; e < 4; ++e) { const int i = 4 * g + e; float dm = __expf(av[e] - M_t); if ((KT) == qt && crow(i, hh) > r) dm = 0.f; const float pv = sc[i] * dm; sc[i] = pv; dsum += pv; } } \
        const bf16x8 pb0 = pack8(sc, 0), pb1 = pack8(sc, 1); \
        n0 = MFMA32(vt_frag(vl, vtr0, 0, 0), pb0, n0); n0 = MFMA32(vt_frag(vl, vtr0, 1, 0), pb1, n0); \
        n1 = MFMA32(vt_frag(vl, vtr0, 0, 1), pb0, n1); n1 = MFMA32(vt_frag(vl, vtr0, 1, 1), pb1, n1); } while (0)
    {
        u32x4 kA[4], kB[4], vA[4], vB[4];
        LAS unsigned char* kl = wl + 8192;
        int kt = 0;
        B3_LOAD(kt, kA, vA);
#pragma unroll 1
        for (;;) {
            if (kt < qt) B3_LOAD(kt + 1, kB, vB);
            B3_TILE(kt, kA, vA);
            if (kt == qt) break;
            ++kt;
            if (kt < qt) B3_LOAD(kt + 1, kA, vA);
            B3_TILE(kt, kB, vB);
            if (kt == qt) break;
            ++kt;
        }
    }
#undef B3_LOAD
#undef B3_TILE
    float ds0, ds1; halves(dsum, ds0, ds1);
    const float den = inter * qn + (ds0 + ds1);
    const float hinv = 1.f / fmaxf(fabsf(den), __expf(-m_t));
    float ss = 0.f;
#pragma unroll
    for (int g = 0; g < 4; ++g) {
        const int d0 = 8 * g + 4 * hh;
        const u32x2 ga = oga[g], gb = ogb[g];
        const float oa[4] = {__uint_as_float(ga.x << 16), __uint_as_float(ga.x & 0xffff0000u), __uint_as_float(ga.y << 16), __uint_as_float(ga.y & 0xffff0000u)};
        const float ob[4] = {__uint_as_float(gb.x << 16), __uint_as_float(gb.x & 0xffff0000u), __uint_as_float(gb.y << 16), __uint_as_float(gb.y & 0xffff0000u)};
#pragma unroll
        for (int e = 0; e < 4; ++e) { const float va = sigmoidf_(oa[e]) * n0[4 * g + e] * hinv, vb = sigmoidf_(ob[e]) * n1[4 * g + e] * hinv; n0[4 * g + e] = va; n1[4 * g + e] = vb; ss += va * va + vb * vb; }
    }
    float s0, s1; halves(ss, s0, s1);
    const float rs = rsqrtf((s0 + s1) * (1.f / 64.f) + EPS);
    bf16_t* yr = (bf16_t*)(a.ws + WS_Y) + rowq * 1024 + h * 64;
#pragma unroll
    for (int g = 0; g < 4; ++g) {
        const int d0 = 8 * g + 4 * hh;
        const f32x4 ga = gha[g], gb = ghb[g];
        u32x2 wa, wb; wa.x = cvtpk(n0[4 * g] * rs * ga[0], n0[4 * g + 1] * rs * ga[1]); wa.y = cvtpk(n0[4 * g + 2] * rs * ga[2], n0[4 * g + 3] * rs * ga[3]);
        wb.x = cvtpk(n1[4 * g] * rs * gb[0], n1[4 * g + 1] * rs * gb[1]); wb.y = cvtpk(n1[4 * g + 2] * rs * gb[2], n1[4 * g + 3] * rs * gb[3]);
        *(u32x2*)(yr + d0) = wa; *(u32x2*)(yr + 32 + d0) = wb;
    }
}
__device__ __forceinline__ void phase_ml_b1(const Args& a, int l, LAS unsigned char* lds, int gw, int ngw, int wave_) {
    for (int it = gw; it < NB * 4 * 32 * 2; it += ngw) ml_b1_item(a, l, lds + wave_ * 16384, it / 256, (it / 64) & 3, (it >> 1) & 31, it & 1);
}
__device__ __forceinline__ void phase_ml_b3(const Args& a, int l, LAS unsigned char* lds, int gw, int ngw, int wave_) {
    const int lane = lane_id_opaque();
    for (int it = gw, k = 0; it < NB * 4 * 32 * 4; it += ngw, ++k) ml_b3_item(a, l, lds + wave_ * 16384, it / 512, (it / 128) & 3, (it >> 2) & 31, (k & 1) ? (it & 3) : 3 - (it & 3), lane);
}

__device__ __forceinline__ Args load_args() {
#if defined(__HIP_DEVICE_COMPILE__)
    typedef const __attribute__((address_space(4))) Args* KArgs;
    KArgs p_ = (KArgs)__builtin_amdgcn_kernarg_segment_ptr(); asm volatile("" : "+s"(p_)); return *p_;
#else
    return Args{};
#endif
}
#define KA() load_args()
__global__ void __launch_bounds__(NWAVES * 64, 2) fwd(Args a_unused) {
    extern __shared__ __attribute__((aligned(16))) unsigned char lds_raw[];
    LAS unsigned char* lds = (LAS unsigned char*)lds_raw;
    const int wave = __builtin_amdgcn_readfirstlane((int)threadIdx.x >> 6);
    const int G = gridDim.x, gw = blockIdx.x * NWAVES + wave, ngw = G * NWAVES;
    volatile LAS unsigned* MISC = (volatile LAS unsigned*)(lds + MISC_OFF);
    { const int t0 = wave * 64 + lane_id_opaque(); if (t0 < 32) MISC[t0] = 0u; }
    __syncthreads();
#if defined(MK_SPLIT)
    int lo, hi; unsigned* ctl; { const Args a = KA(); ctl = (unsigned*)(a.ws + WS_CTL); lo = a.ph_lo; hi = a.ph_hi; }
#else
    constexpr int lo = 0, hi = 22; unsigned* ctl; { const Args a = KA(); ctl = (unsigned*)(a.ws + WS_CTL); }
#endif
    XcdBarrier bar; bar.bar = ctl + CW_BAR; bar.x = 0; bar.st = nullptr;
    if (hi - lo > 1) bar = xcd_barrier_post(ctl + CW_BAR, MISC + 8, wave == 0 && lane_id_opaque() == 0);
#define IN(k) (lo <= (k) && (k) < hi)
#ifndef DISMASK
#define DISMASK 0
#endif
#define DIS(k) ((DISMASK >> (k)) & 1)
#ifndef REPMASK
#define REPMASK 0
#endif
#define NREP(k) ((((REPMASK) >> (k)) & 1) ? (1 + opaque_one()) : 1)
#define REPSYNC(k) do { if (rep_ + 1 < nrep_) xcd_barrier(bar, wave); } while (0)
#ifdef TS_PHASE
#define SEAM(k) do { if (IN(k) && IN((k) + 1)) { xcd_barrier(bar, wave); if (blockIdx.x == 0 && wave == 0 && lane_id_opaque() == 0) ((unsigned long long*)(ctl + 12288))[(k) + 1] = __builtin_amdgcn_s_memrealtime(); } } while (0)
#else
#define SEAM(k) do { if (IN(k) && IN((k) + 1)) xcd_barrier(bar, wave); } while (0)
#endif
    if (IN(0) && !DIS(0)) _Pragma("unroll 1") for (int rep_ = 0, nrep_ = NREP(0); rep_ < nrep_; ++rep_) { const Args a = KA(); phase_prologue(a, lds, gw, ngw, wave); REPSYNC(0); }
    SEAM(0);
    for (int l = 0; l < 2; ++l) {
        const int pb = 1 + 10 * l;
        if (IN(pb + 0) && !DIS(1)) _Pragma("unroll 1") for (int rep_ = 0, nrep_ = NREP(1); rep_ < nrep_; ++rep_) { const Args a = KA(); if (l == 0) phase_norm<1, false>(a, l, a.x, lds, gw, ngw, wave); else phase_norm<1, true>(a, l, a.out, lds, gw, ngw, wave); __syncthreads(); REPSYNC(1); }
        SEAM(pb + 0);
        if (IN(pb + 1) && !DIS(2)) _Pragma("unroll 1") for (int rep_ = 0, nrep_ = NREP(2); rep_ < nrep_; ++rep_) { const Args a = KA();
            ProbDense P{(const char*)(a.ws + WS_H), (const char*)(a.ws + WS_WIN) + (size_t)l * LDU * 1024 * 2, 1024};
            pg8::StaticOrder S; S.init(T_TOK / 256, LDU / 256, G, (int)blockIdx.x);
            EpiU E{(bf16_t*)(a.ws + WS_U)};
            pg8::gemm_phase(lds, P, S, E, wave);
            if (l == 0) tp_tail(a, (T_TOK / 256) * (LDU / 256), G, 0, TP_TAIL_INPROJ, lds, wave);
            REPSYNC(2);
        }
        SEAM(pb + 1);
        if (IN(pb + 2) && !DIS(8)) { const Args a = KA();
            _Pragma("unroll 1") for (int rep_ = 0, nrep_ = NREP(11); rep_ < nrep_; ++rep_) { phase_ml_b1(a, l, lds, gw, ngw, wave); REPSYNC(11); }
            _Pragma("unroll 1") for (int rep_ = 0, nrep_ = NREP(12); rep_ < nrep_; ++rep_) { phase_sb(a, l, lds, gw, ngw, wave); REPSYNC(12); }
            phase_dil(a, l, lds, gw, ngw, wave, 0, 1); }
        SEAM(pb + 2);
        if (IN(pb + 3) && !DIS(9)) { const Args a = KA();
            _Pragma("unroll 1") for (int rep_ = 0, nrep_ = NREP(13); rep_ < nrep_; ++rep_) { phase_ml_b2(a, (int)blockIdx.x * (NWAVES * 64) + wave * 64 + lane_id_opaque(), G * NWAVES * 64); REPSYNC(13); }
            _Pragma("unroll 1") for (int rep_ = 0, nrep_ = NREP(14); rep_ < nrep_; ++rep_) { phase_dil(a, l, lds, gw, ngw, wave, 1, 3); REPSYNC(14); } }
        SEAM(pb + 3);
        if (IN(pb + 4) && !DIS(10)) { const Args a = KA();
            _Pragma("unroll 1") for (int rep_ = 0, nrep_ = NREP(15); rep_ < nrep_; ++rep_) { phase_ml_b3(a, l, lds, gw, ngw, wave); REPSYNC(15); }
            _Pragma("unroll 1") for (int rep_ = 0, nrep_ = NREP(16); rep_ < nrep_; ++rep_) { phase_dil_merge(a, l, gw, ngw); REPSYNC(16); } }
        SEAM(pb + 4);
        if (IN(pb + 5) && !DIS(3)) _Pragma("unroll 1") for (int rep_ = 0, nrep_ = ((l == 0) ? NREP(3) : 1); rep_ < nrep_; ++rep_) { const Args a = KA(); const float* xin = (l == 0) ? a.x : a.out; const float* modl = (const float*)(a.ws + WS_MOD) + (size_t)l * 8 * NMOD;
            ProbDense P{(const char*)(a.ws + WS_Y), (const char*)(a.ws + WS_WOUT) + (size_t)l * 1024 * 1024 * 2, 1024};
            pg8::StaticOrder S; S.init(T_TOK / 256, 4, G, (int)blockIdx.x);
            if (l == 0) { EpiOut<false> E{a.x, (bf16_t*)a.out, modl + 2048}; pg8::gemm_phase(lds, P, S, E, wave); }
            else { EpiOut<true> E{a.out, (bf16_t*)a.out, modl + 2048}; pg8::gemm_phase(lds, P, S, E, wave); }
            if (l == 0) REPSYNC(3);
        }
        SEAM(pb + 5);
        if (IN(pb + 6) && !DIS(4)) _Pragma("unroll 1") for (int rep_ = 0, nrep_ = NREP(4); rep_ < nrep_; ++rep_) { const Args a = KA(); phase_norm<2, true>(a, (rep_ + 1 < nrep_) ? l + 2 : l, a.out, lds, gw, ngw, wave); __syncthreads(); REPSYNC(4); }
        SEAM(pb + 6);
        if (IN(pb + 7) && !DIS(5)) _Pragma("unroll 1") for (int rep_ = 0, nrep_ = NREP(5); rep_ < nrep_; ++rep_) { const Args a = KA();
            LAS int* tab = (LAS int*)(lds + TAB_OFF); build_moe_tab(a, l, tab, wave);
            const int nMt = tab[352];
            ProbGU P{(const char*)(a.ws + WS_H), (const char*)(a.ws + WS_WGU) + (size_t)l * 16 * 1024 * 1024 * 2, (const int*)(a.ws + WS_LIST), tab};
            pg8::StaticOrder S; S.init(nMt, 8, G, (int)blockIdx.x);
            EpiGU E{(bf16_t*)(a.ws + WS_U), (const int*)(a.ws + WS_LIST), (const float*)(a.ws + WS_RW), tab};
            pg8::gemm_phase(lds, P, S, E, wave);
            if (l == 0) tp_tail(a, nMt * 8, G, TP_N_MOE / 2, TP_N_MOE / 2 + 5120, lds, wave);
            REPSYNC(5);
        }
        SEAM(pb + 7);
        if (IN(pb + 8) && !DIS(6)) _Pragma("unroll 1") for (int rep_ = 0, nrep_ = NREP(6); rep_ < nrep_; ++rep_) { const Args a = KA(); const float* modl = (const float*)(a.ws + WS_MOD) + (size_t)l * 8 * NMOD;
            LAS int* tab = (LAS int*)(lds + TAB_OFF); build_moe_tab(a, l, tab, wave);
            const int nMt = tab[352];
            ProbDown P{(const char*)(a.ws + WS_U), (const char*)(a.ws + WS_WD) + (size_t)l * 16 * 1024 * 512 * 2, tab};
            pg8::StaticOrder S; S.init(nMt, 4, G, (int)blockIdx.x);
            EpiDown E{(const bf16_t*)a.out, (rep_ + 1 < nrep_) ? (bf16_t*)(a.ws + WS_Y) : ((l == 1) ? (bf16_t*)(a.ws + WS_H) : (bf16_t*)a.out), (const int*)(a.ws + WS_LIST), modl + 5120, tab};
            pg8::gemm_phase(lds, P, S, E, wave);
            if (l == 0) tp_tail(a, nMt * 4, G, TP_N_MOE / 2 + 5120, TP_N_MOE, lds, wave);
            REPSYNC(6);
        }
        SEAM(pb + 8);
    }
#if defined(TS_DIL)
    if (IN(21)) { const Args a = KA(); const unsigned long long* st = (const unsigned long long*)(ctl + 12288);
        const float eps = (float)(long long)st[40] * 0.01f * TS_SCALE; phase_final(a, gw, ngw, 1.f + eps, bar, wave); }
#elif defined(TS_PHASE)
    if (IN(21)) { const Args a = KA(); const unsigned long long* st = (const unsigned long long*)(ctl + 12288);
        const float eps = (float)(long long)(st[TS_PHASE + 1] - st[TS_PHASE]) * 0.01f * TS_SCALE; phase_final(a, gw, ngw, 1.f + eps, bar, wave); }
#else
    if (IN(21) && !DIS(7)) { const Args a = KA(); phase_final(a, gw, ngw, 1.f, bar, wave); }
#endif
#undef IN
#undef SEAM
}

__global__ void __launch_bounds__(256) k_qkvm(const bf16_t* __restrict__ U, const float* __restrict__ conv_w, const float* __restrict__ conv_b,
                                              const float* __restrict__ wq, const float* __restrict__ wk, const float* __restrict__ wv, bf16_t* __restrict__ Q, bf16_t* __restrict__ K, bf16_t* __restrict__ V) {
    __shared__ float xc[4][64], xm[4][64];
    const int tid = threadIdx.x, ti = tid >> 6, e = tid & 63;
    const int nitem = (T_TOK / 4) * 4;
    for (int item = blockIdx.x; item < nitem; item += gridDim.x) {
        const int h = item & 3, t = (item >> 2) * 4 + ti;
        const int ts = t % SEQ; const int ch = h * 64 + e;
        float a = conv_b[ch];
#pragma unroll
        for (int j = 0; j < 4; ++j) { const int tt = ts - 3 + j; if (tt >= 0) a += conv_w[j * 256 + ch] * bf2f(U[(size_t)(t - 3 + j) * LDU + OFF_ML_X + ch]); }
        __syncthreads();
        xc[ti][e] = a * sigmoidf_(a);
        xm[ti][e] = bf2f(U[(size_t)t * LDU + OFF_ML_X + ch]);
        __syncthreads();
        float q = 0.f, k = 0.f, v = 0.f;
        for (int d = 0; d < 64; ++d) { const float c = xc[ti][d]; q += c * wq[(h * 64 + d) * 64 + e]; k += c * wk[(h * 64 + d) * 64 + e]; v += xm[ti][d] * wv[(h * 64 + d) * 64 + e]; }
        Q[(size_t)t * 256 + ch] = f2bf(q); K[(size_t)t * 256 + ch] = f2bf(k * 0.125f); V[(size_t)t * 256 + ch] = f2bf(v);
    }
}
__global__ void __launch_bounds__(256) k_mlstm_seq(const bf16_t* __restrict__ Q, const bf16_t* __restrict__ K, const bf16_t* __restrict__ V, const float* __restrict__ gate, const float* __restrict__ gate_bias,
                                                   const bf16_t* __restrict__ U, const float* __restrict__ g_head, bf16_t* __restrict__ Y) {
    __shared__ float sq[32][64], sk[32][64], sv[32][64], sig[32], slf[32];
    __shared__ float red[2][4][64]; __shared__ float sden[2];
    const int tid = threadIdx.x, e = tid & 63, dg = tid >> 6;
    const int b = blockIdx.x >> 2, h = blockIdx.x & 3;
    float C[16];
#pragma unroll
    for (int i = 0; i < 16; ++i) C[i] = 0.f;
    float nst = 0.f, m = 0.f;
    const float bi = gate_bias[h], bff = gate_bias[4 + h];
    for (int t0 = 0; t0 < SEQ; t0 += 32) {
        __syncthreads();
        for (int i = tid; i < 32 * 64; i += 256) { const int tt = i >> 6, d = i & 63; const size_t r = (size_t)(b * SEQ + t0 + tt) * 256 + h * 64 + d; sq[tt][d] = bf2f(Q[r]); sk[tt][d] = bf2f(K[r]); sv[tt][d] = bf2f(V[r]); }
        if (tid < 32) { const size_t r = (size_t)(b * SEQ + t0 + tid) * 8; sig[tid] = gate[r + h] + bi; const float fp = gate[r + 4 + h] + bff; slf[tid] = -softplusf_(-fp); }
        __syncthreads();
        for (int tt = 0; tt < 32; ++tt) {
            const int pb = tt & 1;
            const float ig = sig[tt], lf = slf[tt];
            const float mn = fmaxf(lf + m, ig);
            const float a = __expf(lf + m - mn), bc = __expf(ig - mn);
            m = mn;
            const float ve = sv[tt][e];
            float part = 0.f;
#pragma unroll
            for (int i = 0; i < 16; ++i) { const int d = dg * 16 + i; C[i] = a * C[i] + bc * sk[tt][d] * ve; part += sq[tt][d] * C[i]; }
            red[pb][dg][e] = part;
            if (tid < 64) { nst = a * nst + bc * sk[tt][tid]; const float qn = wave_sum(sq[tt][tid] * nst); if (tid == 0) sden[pb] = qn; }
            __syncthreads();
            if (tid < 64) {
                const float num = red[pb][0][e] + red[pb][1][e] + red[pb][2][e] + red[pb][3][e];
                const float den = sden[pb];
                const float hv = num / fmaxf(fabsf(den), __expf(-m));
                const size_t row = (size_t)(b * SEQ + t0 + tt);
                const float o = sigmoidf_(bf2f(U[row * LDU + OFF_ML_O + h * 64 + e])) * hv;
                const float ss = wave_sum(o * o);
                Y[row * 1024 + h * 64 + e] = f2bf(o * rsqrtf(ss * (1.f / 64.f) + EPS) * g_head[h * 64 + e]);
            }
        }
    }
}
__global__ void __launch_bounds__(256) k_dil(const bf16_t* __restrict__ U, const float* __restrict__ g_head, bf16_t* __restrict__ Y) {
    const int lane = threadIdx.x & 63;
    const int wave = (blockIdx.x * blockDim.x + threadIdx.x) >> 6, nw = (gridDim.x * blockDim.x) >> 6;
    for (int item = wave; item < NB * 6 * SEQ; item += nw) {
        const int t = item % SEQ, h = (item / SEQ) % 6, b = item / (SEQ * 6);
        const size_t row = (size_t)b * SEQ + t;
        const float q = bf2f(U[row * LDU + OFF_DIL + h * 64 + lane]);
        const float slope = exp2f(-8.f * (float)(h + 1) / 6.f);
        float m = -INFINITY, l = 0.f, acc = 0.f;
        for (int p = 0; p < 3; ++p) {
            const int d = (p == 0) ? 1 : (p == 1 ? 4 : 16);
            for (int j = 0; j <= 128; ++j) {
                const int tk = t - j * d; if (tk < 0) break;
                const size_t kr = ((size_t)b * SEQ + tk) * LDU + OFF_DIL + h * 64 + lane;
                const float kv = bf2f(U[kr + 384]), vv = bf2f(U[kr + 768]);
                const float s = wave_sum(q * kv) * 0.125f - slope * (float)(j * d);
                const float mn = fmaxf(m, s); const float corr = __expf(m - mn), pe = __expf(s - mn);
                l = l * corr + pe; acc = acc * corr + pe * vv; m = mn;
            }
        }
        const float o = acc / l;
        const float ss = wave_sum(o * o);
        Y[row * 1024 + (4 + h) * 64 + lane] = f2bf(o * rsqrtf(ss * (1.f / 64.f) + EPS) * g_head[(4 + h) * 64 + lane]);
    }
}
__global__ void __launch_bounds__(256) k_sb(const bf16_t* __restrict__ U, const float* __restrict__ g_head, bf16_t* __restrict__ Y) {
    const int lane = threadIdx.x & 63;
    const int wave = (blockIdx.x * blockDim.x + threadIdx.x) >> 6, nw = (gridDim.x * blockDim.x) >> 6;
    for (int item = wave; item < NB * 6 * SEQ; item += nw) {
        const int t = item % SEQ, h = (item / SEQ) % 6, b = item / (SEQ * 6);
        const size_t row = (size_t)b * SEQ + t;
        const float q = bf2f(U[row * LDU + OFF_SB + h * 64 + lane]);
        float run = 0.f, acc = 0.f;
        for (int s = t - 1; s >= 0; --s) {
            const size_t kr = ((size_t)b * SEQ + s) * LDU + OFF_SB + h * 64 + lane;
            const float kv = bf2f(U[kr + 384]), vv = bf2f(U[kr + 768]);
            const float z = wave_sum(q * kv) * 0.125f;
            const float lk = -softplusf_(z);
            acc += __expf(z + lk + run) * vv;
            run += lk;
            if (run < -104.f) break;
        }
        const float ss = wave_sum(acc * acc);
        Y[row * 1024 + (10 + h) * 64 + lane] = f2bf(acc * rsqrtf(ss * (1.f / 64.f) + EPS) * g_head[(10 + h) * 64 + lane]);
    }
}

extern "C" void kernel_launch(void* const* d_in, const int* in_sizes, int n_in, void* d_out, int out_size, void* d_ws, size_t ws_size, hipStream_t stream) {
    static int grid = 0;
    if (grid == 0) {
        int dev = 0, cus = 0;
        if (ws_size < WS_END) { fprintf(stderr, "kernel_launch: workspace too small (%zu < %zu)\n", ws_size, (size_t)WS_END); grid = -1; return; }
        if (hipGetDevice(&dev) != hipSuccess || hipDeviceGetAttribute(&cus, hipDeviceAttributeMultiprocessorCount, dev) != hipSuccess) { grid = -1; return; }
        if (hipFuncSetAttribute((const void*)fwd, hipFuncAttributeMaxDynamicSharedMemorySize, LDS_BYTES) != hipSuccess) { fprintf(stderr, "kernel_launch: hipFuncSetAttribute failed\n"); grid = -1; return; }
        (void)hipGetLastError();
        grid = 256;
        if (cus < 256) { fprintf(stderr, "kernel_launch: needs 256 CUs, device has %d\n", cus); grid = -1; return; }
    }
    if (grid < 0) return;
    Args a{};
    a.x = (const float*)d_in[0]; a.c = (const float*)d_in[1]; a.w_in = (const float*)d_in[2]; a.conv_w = (const float*)d_in[3]; a.conv_b = (const float*)d_in[4];
    a.w_mq = (const float*)d_in[5]; a.w_mk = (const float*)d_in[6]; a.w_mv = (const float*)d_in[7]; a.gate_bias = (const float*)d_in[8]; a.g_head = (const float*)d_in[9];
    a.w_out = (const float*)d_in[10]; a.w_ada = (const float*)d_in[11]; a.b_ada = (const float*)d_in[12]; a.w_router = (const float*)d_in[13]; a.router_bias = (const float*)d_in[14];
    a.w_gate_e = (const float*)d_in[15]; a.w_up_e = (const float*)d_in[16]; a.w_down_e = (const float*)d_in[17]; a.g_final = (const float*)d_in[18];
    a.out = (float*)d_out; a.ws = (unsigned char*)d_ws;
    char* ws = (char*)d_ws;
    (void)hipMemsetAsync(ws + WS_CTL, 0, CTL_BYTES, stream);
    float* gate = (float*)(ws + WS_GATE); bf16_t* U = (bf16_t*)(ws + WS_U);
    bf16_t* Y = (bf16_t*)(ws + WS_Y); bf16_t* Qm = (bf16_t*)(ws + WS_QKV); bf16_t* Km = Qm + (size_t)T_TOK * 256; bf16_t* Vm = Km + (size_t)T_TOK * 256;
#define RUN(lo_, hi_) do { a.ph_lo = (lo_); a.ph_hi = (hi_); hipLaunchKernelGGL(fwd, dim3(grid), dim3(NWAVES * 64), LDS_BYTES, stream, a); } while (0)
#if defined(MK_SPLIT)
    RUN(0, 1);
    for (int l = 0; l < 2; ++l) { const int pb = 1 + 10 * l; for (int k = 0; k < 9; ++k) RUN(pb + k, pb + k + 1); }
    RUN(21, 22);
#else
    RUN(0, 22);
#endif
#undef RUN
}
```

```cpp
#include <hip/hip_runtime.h>
#include <stdint.h>
#include <stdio.h>

#define T_TOK 32768
#define SEQ 4096
#define DM 1024
#define NB 8
#define DIN 2824
#define LDU 2816
#define OFF_ML_X 0
#define OFF_ML_O 256
#define OFF_DIL 512
#define OFF_SB 1664
#define NMOD 6144
#define EPS 1e-6f
#define NBUCK 24

#define LAS __attribute__((address_space(3)))
typedef unsigned short bf16_t;
typedef short bf16x8 __attribute__((ext_vector_type(8)));
typedef float f32x4 __attribute__((ext_vector_type(4)));
typedef float f32x2 __attribute__((ext_vector_type(2)));
typedef unsigned u32x4 __attribute__((ext_vector_type(4)));
typedef unsigned u32x2 __attribute__((ext_vector_type(2)));

__device__ __forceinline__ float bf2f(bf16_t v) { return __uint_as_float(((unsigned)v) << 16); }
__device__ __forceinline__ unsigned f2bf_u(float f) { unsigned u = __float_as_uint(f); return (u + 0x7fffu + ((u >> 16) & 1u)) >> 16; }
__device__ __forceinline__ bf16_t f2bf(float f) { return (bf16_t)f2bf_u(f); }
__device__ __forceinline__ unsigned pk2(float lo, float hi) { return f2bf_u(lo) | (f2bf_u(hi) << 16); }
__device__ __forceinline__ float wave_sum(float v) {
#pragma unroll
    for (int o = 32; o > 0; o >>= 1) v += __shfl_xor(v, o, 64);
    return v;
}
__device__ __forceinline__ float bperm_f(float v, int srclane) { return __int_as_float(__builtin_amdgcn_ds_bpermute((srclane & 63) << 2, __float_as_int(v))); }
__device__ __forceinline__ int opaque_one() { int r; asm volatile("s_mov_b32 %0, 1" : "=s"(r)); return r; }
__device__ __forceinline__ int lane_id_opaque() { int r; asm volatile("v_mbcnt_lo_u32_b32 %0, -1, 0\n\tv_mbcnt_hi_u32_b32 %0, -1, %0" : "=v"(r)); return r; }
__device__ __forceinline__ float wave_sum_l(float v, int lane) {
#pragma unroll
    for (int o = 32; o > 0; o >>= 1) v += __int_as_float(__builtin_amdgcn_ds_bpermute((lane ^ o) << 2, __float_as_int(v)));
    return v;
}
__device__ __forceinline__ float sigmoidf_(float x) { return 1.f / (1.f + __expf(-x)); }
__device__ __forceinline__ float softplusf_(float z) { return fmaxf(z, 0.f) + log1pf(__expf(-fabsf(z))); }

constexpr size_t MiB = 1u << 20;
constexpr size_t WS_CTL   = 0;
constexpr size_t CTL_BYTES = 1 * MiB;
constexpr size_t WS_MOD   = 1 * MiB;
constexpr size_t WS_GATE  = WS_MOD + 512 * 1024;
constexpr size_t WS_RW    = WS_GATE + 1 * MiB;
constexpr size_t WS_LIST  = WS_RW + 256 * 1024;
constexpr size_t WS_WIN   = 6 * MiB;
constexpr size_t WS_WOUT  = 17 * MiB;
constexpr size_t WS_WGU   = 21 * MiB;
constexpr size_t WS_WD    = 85 * MiB;
constexpr size_t WS_H     = 117 * MiB;
constexpr size_t WS_U     = 181 * MiB;
constexpr size_t WS_Y     = 357 * MiB;
constexpr size_t WS_QKV   = 421 * MiB;
constexpr size_t WS_OP1   = WS_H;
constexpr size_t WS_CLOC  = WS_H + 24 * MiB;
constexpr size_t WS_OP2   = 469 * MiB;
constexpr size_t WS_LSE   = 493 * MiB;
constexpr size_t WS_CT    = 496 * MiB;
constexpr size_t WS_MLS   = 504 * MiB;
constexpr size_t WS_END   = 507 * MiB;
constexpr size_t MLS_CUM = 0, MLS_AA = 512 * 1024, MLS_PM = 1024 * 1024, MLS_NLOC = 1536 * 1024  , MLS_NC = 2048 * 1024, MLS_AMAX = 2304 * 1024, MLS_LSUM = 2308 * 1024, MLS_MC = 2312 * 1024, MLS_WT = 2560 * 1024;

constexpr int CW_BAR = 4096;
constexpr int CW_CNT = 8192;

namespace pg8 {
constexpr int BM = 256, BK = 64, HALF = 128, HTB = HALF * BK * 2, STAGE_BYTES = 8 * HTB, NXCD = 8, WGM = 8;
__host__ __device__ __forceinline__ int lds_byte(int r, int c) { const int st = (r >> 4) * 2 + (c >> 5), rr = r & 15, cc = c & 31, ob = rr * 64 + cc * 2; return st * 1024 + (ob ^ (((ob >> 9) & 1) << 5)); }
__host__ __device__ __forceinline__ void stage_rc(int b, int& R, int& C) { const int st = b / 1024, sb = b % 1024, swz = sb ^ (((sb >> 9) & 1) << 5); R = (st >> 1) * 16 + swz / 64; C = (st & 1) * 32 + (swz % 64) / 2; }
__host__ __device__ __forceinline__ int perm32(int rho) { const int n = rho >> 4, i = rho & 15; return 8 * (i >> 2) + 4 * n + (i & 3); }
struct Unit { int pm, pn; };
struct StaticOrder {
    int nM, nN, nwg, G, c;
    __device__ void init(int nM_, int nN_, int G_, int c_) { nM = nM_; nN = nN_; nwg = nM * nN; G = G_; c = c_; }
    __device__ bool next(int i, Unit& u) const {
        const long L = (long)i * G + c; if (L >= nwg) return false;
        int wgid = (int)L; { const int q = nwg / NXCD, r = nwg % NXCD, xcd = wgid % NXCD, off = wgid / NXCD; wgid = (xcd < r ? xcd * (q + 1) : r * (q + 1) + (xcd - r) * q) + off; }
        const int nig = WGM * nN, gid = wgid / nig, fm = gid * WGM, gsz = (nM - fm) < WGM ? (nM - fm) : WGM;
        u.pm = fm + ((wgid % nig) % gsz); u.pn = (wgid % nig) / gsz; return true;
    }
};
__device__ __forceinline__ unsigned cvt_pk_bf16(float lo, float hi) { unsigned r; asm volatile("v_cvt_pk_bf16_f32 %0, %1, %2" : "=v"(r) : "v"(lo), "v"(hi)); return r; }

template <class P, class Epi, class Sched>
__device__ __forceinline__ void gemm_phase(LAS unsigned char* lds, const P& pb, const Sched& S, const Epi& E, int wave_) {
    const int tid_ = wave_ * 64 + lane_id_opaque();
    const int tid = tid_, wid = __builtin_amdgcn_readfirstlane(tid >> 6), lane = tid & 63, wr = wid >> 2, wc = wid & 3, fr = lane & 15, fq = lane >> 4;
    const int nt = pb.nt();
    unsigned voffB[2];
#pragma unroll
    for (int i = 0; i < 2; ++i) { int R, C; stage_rc(tid * 16 + i * 8192, R, C); const int Rb = Epi::PERM ? ((R & ~31) + perm32(R & 31)) : R; voffB[i] = (unsigned)(Rb * pb.ldb() + C) * 2u; }
    const size_t hstepB = (size_t)HALF * pb.ldb() * 2;
    const unsigned ldsw = (unsigned)wid * 1024u;
    const int aoff = lds_byte(wr * 64 + fr, fq * 8), boff = lds_byte(wc * 32 + fr, fq * 8);
#define PG8_SA(b, h) (((b) * 2 + (h)) * HTB)
#define PG8_SB(b, h) ((4 + (b) * 2 + (h)) * HTB)
#define PG8_STAGE(bufoff, gbase, voff) do { _Pragma("unroll") for (int _i = 0; _i < 2; ++_i) \
        __builtin_amdgcn_global_load_lds((const unsigned*)((const char*)(gbase) + (voff)[_i]), (LAS unsigned*)(lds + (bufoff) + ldsw + _i * 8192), 16, 0, 0); } while (0)
#define PG8_LDA(dst, b, h) do { _Pragma("unroll") for (int m = 0; m < 4; ++m) _Pragma("unroll") for (int k = 0; k < 2; ++k) dst[m][k] = *(const LAS bf16x8*)(lds + PG8_SA(b, h) + aoff + m * 2048 + k * 1024); } while (0)
#define PG8_LDB(dst, b, h) do { _Pragma("unroll") for (int n = 0; n < 2; ++n) _Pragma("unroll") for (int k = 0; k < 2; ++k) dst[n][k] = *(const LAS bf16x8*)(lds + PG8_SB(b, h) + boff + n * 2048 + k * 1024); } while (0)
#define PG8_MMA(ai, bj, At, Bt) do { __builtin_amdgcn_s_setprio(1); _Pragma("unroll") for (int m = 0; m < 4; ++m) _Pragma("unroll") for (int n = 0; n < 2; ++n) _Pragma("unroll") for (int k = 0; k < 2; ++k) \
        acc[ai][bj][m][n] = __builtin_amdgcn_mfma_f32_16x16x32_bf16(Bt[n][k], At[m][k], acc[ai][bj][m][n], 0, 0, 0); __builtin_amdgcn_s_setprio(0); } while (0)
#define PG8_WAIT_V(n) asm volatile("s_waitcnt vmcnt(" #n ")" ::: "memory")
#define PG8_WAIT_L(n) asm volatile("s_waitcnt lgkmcnt(" #n ")" ::: "memory")
#define PG8_BAR __builtin_amdgcn_s_barrier()
#define PG8_SCHED __builtin_amdgcn_sched_barrier(0)
#define PG8_AOFF(dst, u) do { int _t = tid; asm volatile("" : "+v"(_t)); _Pragma("unroll") for (int _i = 0; _i < 2; ++_i) { int _R, _C; stage_rc(_t * 16 + _i * 8192, _R, _C); \
        _Pragma("unroll") for (int _h = 0; _h < 2; ++_h) dst[_h][_i] = pb.a_row(u, _h * HALF + _R) + (unsigned)_C * 2u; } } while (0)
    Unit cur, nxt; int ui = 0;
    if (!S.next(0, cur)) return;
    f32x4 acc[2][2][4][2];
#pragma unroll
    for (int a = 0; a < 2; ++a)
#pragma unroll
        for (int b = 0; b < 2; ++b)
#pragma unroll
            for (int m = 0; m < 4; ++m)
#pragma unroll
                for (int n = 0; n < 2; ++n) acc[a][b][m][n] = (f32x4){0.f, 0.f, 0.f, 0.f};
    bf16x8 At[4][2], B0[2][2], B1[2][2];
    unsigned ca[2][2], na[2][2];
    PG8_AOFF(ca, cur);
    const char* Ab = pb.a_base();
    {
        const char* b0 = pb.b_tile(cur, 0); const char* b1 = pb.b_tile(cur, 1);
        PG8_STAGE(PG8_SB(0, 0), b0, voffB); PG8_STAGE(PG8_SB(0, 1), b0 + hstepB, voffB); PG8_STAGE(PG8_SA(0, 0), Ab, ca[0]); PG8_STAGE(PG8_SA(0, 1), Ab, ca[1]);
        if (wr == 1) PG8_BAR;
        PG8_WAIT_V(2); PG8_BAR;
        PG8_STAGE(PG8_SB(1, 0), b1, voffB); PG8_STAGE(PG8_SA(1, 0), Ab + 128, ca[0]); PG8_STAGE(PG8_SB(1, 1), b1 + hstepB, voffB);
        PG8_WAIT_V(6); PG8_BAR;
    }
    for (;;) {
        const bool has_next = S.next(ui + 1, nxt);
        if (!has_next) nxt = cur;
        PG8_AOFF(na, nxt);
#define PG8_KPAIR(A2BASE, OFF2, B2, B3, A1P) do { \
              \
            PG8_LDB(B0, 0, 0); PG8_LDB(B1, 0, 1); PG8_SCHED; PG8_LDA(At, 0, 0); PG8_STAGE(PG8_SA(1, 1), A1P, ca[1]); \
            PG8_WAIT_V(8); PG8_WAIT_L(0); PG8_BAR; PG8_MMA(0, 0, At, B0); PG8_MMA(0, 1, At, B1); PG8_BAR; PG8_SCHED; \
              \
            PG8_LDA(At, 0, 1); PG8_STAGE(PG8_SB(0, 0), B2, voffB); PG8_STAGE(PG8_SB(0, 1), (B2) + hstepB, voffB); PG8_STAGE(PG8_SA(0, 0), A2BASE, OFF2[0]); \
            PG8_WAIT_V(8); PG8_WAIT_L(0); PG8_BAR; PG8_MMA(1, 0, At, B0); PG8_MMA(1, 1, At, B1); PG8_BAR; PG8_SCHED; \
              \
            PG8_LDB(B0, 1, 0); PG8_LDB(B1, 1, 1); PG8_SCHED; PG8_LDA(At, 1, 0); PG8_STAGE(PG8_SA(0, 1), A2BASE, OFF2[1]); \
            PG8_WAIT_V(8); PG8_WAIT_L(0); PG8_BAR; PG8_MMA(0, 0, At, B0); PG8_MMA(0, 1, At, B1); PG8_BAR; PG8_SCHED; \
              \
            PG8_LDA(At, 1, 1); PG8_STAGE(PG8_SB(1, 0), B3, voffB); PG8_STAGE(PG8_SB(1, 1), (B3) + hstepB, voffB); PG8_STAGE(PG8_SA(1, 0), (A2BASE) + 128, OFF2[0]); \
            PG8_WAIT_V(8); PG8_WAIT_L(0); PG8_BAR; PG8_MMA(1, 0, At, B0); PG8_MMA(1, 1, At, B1); PG8_BAR; PG8_SCHED; } while (0)
        for (int t = 0; t < nt - 2; t += 2) {
            const char* b2 = pb.b_tile(cur, t + 2); const char* b3 = pb.b_tile(cur, t + 3);
            const char* a1p = Ab + (size_t)(t + 1) * 128; const char* a2p = Ab + (size_t)(t + 2) * 128;
            PG8_KPAIR(a2p, ca, b2, b3, a1p);
        }
        {
            const char* b2 = pb.b_tile(nxt, 0); const char* b3 = pb.b_tile(nxt, 1);
            const char* a1p = Ab + (size_t)(nt - 1) * 128;
            PG8_KPAIR(Ab, na, b2, b3, a1p);
        }
#undef PG8_KPAIR
        if (wr == 0) PG8_BAR;
        E(acc, cur, wr, wc, fr, fq);
        if (!has_next) break;
#pragma unroll
        for (int a = 0; a < 2; ++a)
#pragma unroll
            for (int b = 0; b < 2; ++b)
#pragma unroll
                for (int m = 0; m < 4; ++m)
#pragma unroll
                    for (int n = 0; n < 2; ++n) acc[a][b][m][n] = (f32x4){0.f, 0.f, 0.f, 0.f};
        cur = nxt;
#pragma unroll
        for (int h = 0; h < 2; ++h)
#pragma unroll
            for (int i = 0; i < 2; ++i) ca[h][i] = na[h][i];
        ++ui;
        if (wr == 1) PG8_BAR;
    }
    PG8_WAIT_V(0);
    PG8_BAR;
#undef PG8_SA
#undef PG8_SB
#undef PG8_STAGE
#undef PG8_LDA
#undef PG8_LDB
#undef PG8_MMA
#undef PG8_WAIT_V
#undef PG8_WAIT_L
#undef PG8_BAR
#undef PG8_SCHED
#undef PG8_AOFF
}
}
using pg8::Unit;

struct ProbDense {
    const char* A; const char* B; int K;
    __device__ __forceinline__ int nt() const { return K / 64; }
    __device__ __forceinline__ int ldb() const { return K; }
    __device__ __forceinline__ const char* a_base() const { return A; }
    __device__ __forceinline__ unsigned a_row(const Unit& u, int r) const { return (unsigned)((u.pm * 256 + r) * K) * 2u; }
    __device__ __forceinline__ const char* b_tile(const Unit& u, int t) const { return B + (size_t)u.pn * 256 * K * 2 + (size_t)t * 128; }
};
__device__ __forceinline__ int bucket_e0(int k) { const int g = k / 6, p = k % 6; return 4 * g + (p < 3 ? 0 : (p < 5 ? 1 : 2)); }
__device__ __forceinline__ int bucket_e1(int k) { const int g = k / 6, p = k % 6; return 4 * g + (p < 3 ? p + 1 : (p < 5 ? p - 1 : 3)); }
struct ProbGU {
    const char* H; const char* W; const int* list; const LAS int* tab;
    __device__ __forceinline__ int nt() const { return 16; }
    __device__ __forceinline__ int ldb() const { return 1024; }
    __device__ __forceinline__ const char* a_base() const { return H; }
    __device__ __forceinline__ unsigned a_row(const Unit& u, int r) const {
        const int k = tab[32 + u.pm], rr = tab[192 + u.pm] + r; int tok = 0; if (rr < tab[k]) tok = list[(size_t)k * T_TOK + rr]; return (unsigned)tok * 2048u; }
    __device__ __forceinline__ const char* b_tile(const Unit& u, int t) const {
        const int k = __builtin_amdgcn_readfirstlane(tab[32 + u.pm]); const int e = (u.pn < 4) ? bucket_e0(k) : bucket_e1(k);
        return W + (size_t)e * (1024 * 1024 * 2) + (size_t)(u.pn & 3) * 256 * 2048 + (size_t)t * 128; }
};
struct ProbDown {
    const char* HE; const char* W; const LAS int* tab;
    __device__ __forceinline__ int nt() const { return 16; }
    __device__ __forceinline__ int ldb() const { return 512; }
    __device__ __forceinline__ const char* a_base() const { return HE; }
    __device__ __forceinline__ unsigned a_row(const Unit& u, int r) const { return (unsigned)(u.pm * 256 + r) * 2048u; }
    __device__ __forceinline__ const char* b_tile(const Unit& u, int t) const {
        const int k = __builtin_amdgcn_readfirstlane(tab[32 + u.pm]); const int e = (t < 8) ? bucket_e0(k) : bucket_e1(k);
        return W + (size_t)e * (1024 * 512 * 2) + (size_t)u.pn * 256 * 1024 + (size_t)(t & 7) * 128; }
};

__device__ __forceinline__ f32x4 bf4_lo(const u32x4& v) { return (f32x4){__uint_as_float(v.x << 16), __uint_as_float(v.x & 0xffff0000u), __uint_as_float(v.y << 16), __uint_as_float(v.y & 0xffff0000u)}; }
__device__ __forceinline__ f32x4 bf4_hi(const u32x4& v) { return (f32x4){__uint_as_float(v.z << 16), __uint_as_float(v.z & 0xffff0000u), __uint_as_float(v.w << 16), __uint_as_float(v.w & 0xffff0000u)}; }
struct EpiU {
    static constexpr bool PERM = true;
    bf16_t* O;
    __device__ __forceinline__ void operator()(const f32x4 (&acc)[2][2][4][2], const Unit& u, int wr, int wc, int fr, int fq) const {
        const int row0 = u.pm * 256 + wr * 64 + fr, col0 = u.pn * 256 + wc * 32 + 8 * fq;
#pragma unroll
        for (int ai = 0; ai < 2; ++ai)
#pragma unroll
            for (int m = 0; m < 4; ++m) { bf16_t* rowp = O + (size_t)(row0 + ai * 128 + m * 16) * LDU + col0;
#pragma unroll
                for (int bj = 0; bj < 2; ++bj) { const f32x4 v0 = acc[ai][bj][m][0], v1 = acc[ai][bj][m][1];
                    u32x4 w; w.x = pg8::cvt_pk_bf16(v0[0], v0[1]); w.y = pg8::cvt_pk_bf16(v0[2], v0[3]); w.z = pg8::cvt_pk_bf16(v1[0], v1[1]); w.w = pg8::cvt_pk_bf16(v1[2], v1[3]);
                    *(u32x4*)(rowp + bj * 128) = w; } }
    }
};
template <bool XINBF> struct EpiOut {
    static constexpr bool PERM = true;
    const void* xin; bf16_t* XB; const float* gate;
    __device__ __forceinline__ void operator()(const f32x4 (&acc)[2][2][4][2], const Unit& u, int wr, int wc, int fr, int fq) const {
        const int b = (u.pm * 256) / SEQ; const int col0 = u.pn * 256 + wc * 32 + 8 * fq;
        f32x4 gv[2][2];
#pragma unroll
        for (int bj = 0; bj < 2; ++bj)
#pragma unroll
            for (int n = 0; n < 2; ++n) gv[bj][n] = *(const f32x4*)(gate + (size_t)b * NMOD + col0 + bj * 128 + n * 4);
#pragma unroll
        for (int ai = 0; ai < 2; ++ai)
#pragma unroll
            for (int m = 0; m < 4; ++m) { const size_t off = (size_t)(u.pm * 256 + ai * 128 + wr * 64 + m * 16 + fr) * DM + col0;
#pragma unroll
                for (int bj = 0; bj < 2; ++bj) {
                    f32x4 x0, x1;
                    if (XINBF) { const u32x4 xv = *(const u32x4*)((const bf16_t*)xin + off + bj * 128); x0 = bf4_lo(xv); x1 = bf4_hi(xv); }
                    else { x0 = *(const f32x4*)((const float*)xin + off + bj * 128); x1 = *(const f32x4*)((const float*)xin + off + bj * 128 + 4); }
                    const f32x4 y0 = x0 + gv[bj][0] * acc[ai][bj][m][0], y1 = x1 + gv[bj][1] * acc[ai][bj][m][1];
                    u32x4 w; w.x = pg8::cvt_pk_bf16(y0[0], y0[1]); w.y = pg8::cvt_pk_bf16(y0[2], y0[3]); w.z = pg8::cvt_pk_bf16(y1[0], y1[1]); w.w = pg8::cvt_pk_bf16(y1[2], y1[3]);
                    *(u32x4*)(XB + off + bj * 128) = w; } }
    }
};
struct EpiGU {
    static constexpr bool PERM = true;
    bf16_t* HE; const int* list; const float* rw; const LAS int* tab;
    __device__ __forceinline__ void operator()(const f32x4 (&acc)[2][2][4][2], const Unit& u, int wr, int wc, int fr, int fq) const {
        const int k = tab[32 + u.pm], r0 = tab[192 + u.pm], cnt = tab[k]; const int part = u.pn >> 2;
        const int hcol0 = part * 512 + ((u.pn & 3) * 256 + wc * 32 + 8 * fq) / 2;
#pragma unroll
        for (int ai = 0; ai < 2; ++ai)
#pragma unroll
            for (int m = 0; m < 4; ++m) { const int r = ai * 128 + wr * 64 + m * 16 + fr; const int rr = r0 + r;
                if (rr < cnt) { const int tok = list[(size_t)k * T_TOK + rr]; const float w = rw[tok * 2 + part];
                    bf16_t* rowp = HE + (size_t)(u.pm * 256 + r) * 1024 + hcol0;
#pragma unroll
                    for (int bj = 0; bj < 2; ++bj) { const f32x4 v0 = acc[ai][bj][m][0], v1 = acc[ai][bj][m][1];
                        const float h0 = v0[0] * sigmoidf_(v0[0]) * v0[1] * w, h1 = v0[2] * sigmoidf_(v0[2]) * v0[3] * w, h2 = v1[0] * sigmoidf_(v1[0]) * v1[1] * w, h3 = v1[2] * sigmoidf_(v1[2]) * v1[3] * w;
                        u32x2 o; o.x = pg8::cvt_pk_bf16(h0, h1); o.y = pg8::cvt_pk_bf16(h2, h3);
                        *(u32x2*)(rowp + bj * 64) = o; } } }
    }
};
struct EpiDown {
    static constexpr bool PERM = true;
    const bf16_t* XS; bf16_t* XB; const int* list; const float* gate; const LAS int* tab;
    __device__ __forceinline__ void operator()(const f32x4 (&acc)[2][2][4][2], const Unit& u, int wr, int wc, int fr, int fq) const {
        const int k = tab[32 + u.pm], r0 = tab[192 + u.pm], cnt = tab[k]; const int col0 = u.pn * 256 + wc * 32 + 8 * fq;
        int tok[2][4];
#pragma unroll
        for (int ai = 0; ai < 2; ++ai)
#pragma unroll
            for (int m = 0; m < 4; ++m) { const int rr = r0 + ai * 128 + wr * 64 + m * 16 + fr; tok[ai][m] = (rr < cnt) ? list[(size_t)k * T_TOK + rr] : -1; }
#pragma unroll
        for (int ai = 0; ai < 2; ++ai)
#pragma unroll
            for (int mp = 0; mp < 4; mp += 2) {
                u32x4 xi[2][2]; f32x4 gv[2][2][2];
#pragma unroll
                for (int mm = 0; mm < 2; ++mm) { const int tk = tok[ai][mp + mm]; const int tks = tk < 0 ? 0 : tk; const bf16_t* xr = XS + (size_t)tks * DM + col0; const float* gr = gate + (size_t)(tks / SEQ) * NMOD + col0;
#pragma unroll
                    for (int bj = 0; bj < 2; ++bj) { xi[mm][bj] = *(const u32x4*)(xr + bj * 128); gv[mm][bj][0] = *(const f32x4*)(gr + bj * 128); gv[mm][bj][1] = *(const f32x4*)(gr + bj * 128 + 4); } }
#pragma unroll
                for (int mm = 0; mm < 2; ++mm) { const int tk = tok[ai][mp + mm];
                    if (tk >= 0) { bf16_t* xr = XB + (size_t)tk * DM + col0;
#pragma unroll
                        for (int bj = 0; bj < 2; ++bj) { const f32x4 y0 = bf4_lo(xi[mm][bj]) + gv[mm][bj][0] * acc[ai][bj][mp + mm][0], y1 = bf4_hi(xi[mm][bj]) + gv[mm][bj][1] * acc[ai][bj][mp + mm][1];
                            u32x4 w; w.x = pg8::cvt_pk_bf16(y0[0], y0[1]); w.y = pg8::cvt_pk_bf16(y0[2], y0[3]); w.z = pg8::cvt_pk_bf16(y1[0], y1[1]); w.w = pg8::cvt_pk_bf16(y1[2], y1[3]);
                            *(u32x4*)(xr + bj * 128) = w; } } }
            }
    }
};

#define XB_TMO      128
#define XB_XCNT(j)  (256  + 64 * (j))
#define XB_XSUB(j)  (1280 + 64 * (j))
#define XB_XGEN(j)  (2304 + 64 * (j))
#define XB_TOP      3328
#define XB_TOPGEN   3392
#define XCD_BAR_WORDS 3456
#define XB_SPIN_CAP (1u << 18)
__device__ __forceinline__ unsigned xb_ld(unsigned* p)              { return __hip_atomic_load(p, __ATOMIC_RELAXED, __HIP_MEMORY_SCOPE_AGENT); }
__device__ __forceinline__ unsigned xb_add(unsigned* p, unsigned v) { return __hip_atomic_fetch_add(p, v, __ATOMIC_RELAXED, __HIP_MEMORY_SCOPE_AGENT); }
__device__ __forceinline__ unsigned xb_xcc_id() { return (unsigned)__builtin_amdgcn_s_getreg((3 << 11) | 20) & 0xFu; }
#define XB_SPIN(cond, bar) do { unsigned _sp = 0; while (cond) { __builtin_amdgcn_s_sleep(1); \
    if ((++_sp & 255u) == 0u) { if (xb_ld(&(bar)[XB_TMO])) break; if (_sp > XB_SPIN_CAP) { atomicAdd(&(bar)[XB_TMO], 1u); break; } } } } while (0)
struct XcdBarrier { unsigned* bar; unsigned x; volatile LAS unsigned* st; };
__device__ __forceinline__ XcdBarrier xcd_barrier_post(unsigned* bar, volatile LAS unsigned* st, bool leader) {
    XcdBarrier b; b.bar = bar; b.x = xb_xcc_id(); b.st = st;
    if (leader) (void)xb_add(&bar[XB_XCNT(b.x)], 1u);
    return b;
}
__device__ __forceinline__ void xcd_barrier_complete(unsigned* bar, unsigned x, unsigned& nloc, unsigned& nx) {
    const unsigned G = gridDim.x * gridDim.y * gridDim.z;
    unsigned sum, cnt, mine, sp = 0u;
    for (;;) {
        sum = 0u; cnt = 0u; mine = 0u;
#pragma unroll
        for (unsigned j = 0; j < 16; ++j) { const unsigned c = xb_ld(&bar[XB_XCNT(j)]); sum += c; cnt += (c > 0u) ? 1u : 0u; mine = (j == x) ? c : mine; }
        if (sum == G) break;
        __builtin_amdgcn_s_sleep(1);
        if ((++sp & 255u) == 0u) { if (xb_ld(&bar[XB_TMO])) break; if (sp > XB_SPIN_CAP) { atomicAdd(&bar[XB_TMO], 1u); break; } }
    }
    nloc = mine > 0u ? mine : 1u; nx = cnt > 0u ? cnt : 1u;
}
__device__ __forceinline__ void xcd_barrier(const XcdBarrier& b, int wave_) {
    asm volatile("s_waitcnt vmcnt(0)" ::: "memory");
    __syncthreads();
    if (wave_ == 0 && lane_id_opaque() == 0) {
        unsigned* bar = b.bar; asm volatile("" : "+s"(bar));
        __builtin_amdgcn_s_waitcnt(0);
        unsigned nloc = b.st[0], nx = b.st[1];
        if (nloc == 0u) { xcd_barrier_complete(bar, b.x, nloc, nx); b.st[0] = nloc; b.st[1] = nx; }
        const unsigned old = xb_add(&bar[XB_XSUB(b.x)], 1u);
        const unsigned gen = old / nloc;
        if (old + 1u == (gen + 1u) * nloc) {
            __builtin_amdgcn_fence(__ATOMIC_RELEASE, "agent");
            asm volatile("s_waitcnt vmcnt(0)" ::: "memory");
            const unsigned og = xb_add(&bar[XB_TOP], 1u);
            const unsigned tg = og / nx;
            if (og + 1u == (tg + 1u) * nx) xb_add(&bar[XB_TOPGEN], 1u);
            else XB_SPIN(xb_ld(&bar[XB_TOPGEN]) == tg, bar);
            __builtin_amdgcn_fence(__ATOMIC_ACQUIRE, "agent");
            xb_add(&bar[XB_XGEN(b.x)], 1u);
            asm volatile("s_waitcnt vmcnt(0)" ::: "memory");
        } else {
            XB_SPIN(xb_ld(&bar[XB_XGEN(b.x)]) == gen, bar);
            __builtin_amdgcn_fence(__ATOMIC_ACQUIRE, "agent");
            asm volatile("s_waitcnt vmcnt(0)" ::: "memory");
        }
    }
    __syncthreads();
}

constexpr int NWAVES = 8;
constexpr int RING_BYTES = 131072;
constexpr int TAB_OFF = RING_BYTES;
constexpr int MISC_OFF = TAB_OFF + 2048;
constexpr int LDS_BYTES = 147456;

struct Args {
    const float* x; const float* c; const float* w_in; const float* conv_w; const float* conv_b; const float* w_mq; const float* w_mk; const float* w_mv;
    const float* gate_bias; const float* g_head; const float* w_out; const float* w_ada; const float* b_ada; const float* w_router; const float* router_bias;
    const float* w_gate_e; const float* w_up_e; const float* w_down_e; const float* g_final;
    float* out; unsigned char* ws; int ph_lo, ph_hi;
};

struct TpItem { const float* src0; long long dsrc; int ldw; int inter; bf16_t* dst; int Kd; };
__device__ __forceinline__ void tp_load(const TpItem& t, float (&v)[32], int lane) {
    const int c = lane & 31;
    const float* p = t.inter ? (t.src0 + ((c & 1) ? t.dsrc : 0ll) + (c >> 1)) : (t.src0 + c);
#pragma unroll
    for (int i = 0; i < 32; ++i) v[i] = p[(size_t)(2 * i + (lane >> 5)) * t.ldw];
}
__device__ __forceinline__ void tp_finish(const TpItem& t, const float (&v)[32], LAS float* scr, int lane) {
#pragma unroll
    for (int i = 0; i < 32; ++i) scr[(2 * i + (lane >> 5)) * 33 + (lane & 31)] = v[i];
    asm volatile("s_waitcnt lgkmcnt(0)" ::: "memory");
    const int c = lane & 7;
#pragma unroll
    for (int j = 0; j < 4; ++j) { const int n = (lane >> 3) + 8 * j; const LAS float* s = scr + (8 * c) * 33 + n;
        u32x4 o; o.x = pk2(s[0 * 33], s[1 * 33]); o.y = pk2(s[2 * 33], s[3 * 33]); o.z = pk2(s[4 * 33], s[5 * 33]); o.w = pk2(s[6 * 33], s[7 * 33]);
        *(u32x4*)(t.dst + (size_t)n * t.Kd + 8 * c) = o; }
    asm volatile("s_waitcnt lgkmcnt(0)" ::: "memory");
}
constexpr int TP_N_DENSE = 2 * (16 * 88 + 16 * 32), TP_N_MOE = 2 * (16 * 16 * 32 + 16 * 8 * 32);
constexpr int TP_TAIL_INPROJ = 8192;
__device__ __forceinline__ TpItem tp_decode(const Args& a, int it, bool moe) {
    constexpr int I_IN = 16 * 88, I_OUT = 16 * 32, I_GU = 16 * 16 * 32, I_D = 16 * 8 * 32;
    TpItem t; t.inter = 0; t.dsrc = 0;
    if (!moe) {
        const int l = it / (I_IN + I_OUT); int r = it % (I_IN + I_OUT);
        if (r < I_IN) { const int kb = r / 88, nb = r % 88, n0 = nb * 32, k0 = kb * 64; const int ns = n0 < 512 ? n0 : n0 + 8;
            t.src0 = a.w_in + (size_t)l * 1024 * DIN + (size_t)k0 * DIN + ns; t.ldw = DIN; t.Kd = 1024; t.dst = (bf16_t*)(a.ws + WS_WIN) + (size_t)l * LDU * 1024 + (size_t)n0 * 1024 + k0; return t; }
        r -= I_IN;
        { const int kb = r / 32, nb = r % 32, n0 = nb * 32, k0 = kb * 64;
            t.src0 = a.w_out + (size_t)l * 1024 * 1024 + (size_t)k0 * 1024 + n0; t.ldw = 1024; t.Kd = 1024; t.dst = (bf16_t*)(a.ws + WS_WOUT) + (size_t)l * 1024 * 1024 + (size_t)n0 * 1024 + k0; return t; }
    }
    const int l = it / (I_GU + I_D); int r = it % (I_GU + I_D);
    if (r < I_GU) { const int e = r / 512, rr = r % 512, kb = rr / 32, nb = rr % 32, n0 = nb * 32, k0 = kb * 64;
        t.src0 = a.w_gate_e + ((size_t)l * 16 + e) * 1024 * 512 + (size_t)k0 * 512 + n0 / 2; t.dsrc = (long long)(((uintptr_t)a.w_up_e - (uintptr_t)a.w_gate_e) / 4); t.inter = 1;
        t.ldw = 512; t.Kd = 1024; t.dst = (bf16_t*)(a.ws + WS_WGU) + ((size_t)l * 16 + e) * 1024 * 1024 + (size_t)n0 * 1024 + k0; return t; }
    r -= I_GU;
    { const int e = r / 256, rr = r % 256, kb = rr / 32, nb = rr % 32, n0 = nb * 32, k0 = kb * 64;
        t.src0 = a.w_down_e + ((size_t)l * 16 + e) * 512 * 1024 + (size_t)k0 * 1024 + n0; t.ldw = 1024; t.Kd = 512; t.dst = (bf16_t*)(a.ws + WS_WD) + ((size_t)l * 16 + e) * 1024 * 512 + (size_t)n0 * 512 + k0; return t; }
}
__device__ __forceinline__ void tp_run(const Args& a, bool moe, int lo, int hi, LAS float* scr, int gw, int ngw) {
    const int lane = lane_id_opaque();
    asm volatile("" : "+s"(gw));
    float va[32], vb[32]; TpItem ta, tb;
    int it = lo + gw;
    if (it < hi) { ta = tp_decode(a, it, moe); tp_load(ta, va, lane); }
#pragma unroll 1
    for (;;) {
        if (it >= hi) break;
        if (it + ngw < hi) { tb = tp_decode(a, it + ngw, moe); tp_load(tb, vb, lane); }
        tp_finish(ta, va, scr, lane);
        it += ngw; if (it >= hi) break;
        if (it + ngw < hi) { ta = tp_decode(a, it + ngw, moe); tp_load(ta, va, lane); }
        tp_finish(tb, vb, scr, lane);
        it += ngw;
    }
}

__device__ __forceinline__ void phase_prologue(const Args& a, LAS unsigned char* lds, int gw, int ngw, int wave_) {
    const int lane = lane_id_opaque(), tid = wave_ * 64 + lane;
    LAS float* cact = (LAS float*)(lds + 98304);
    for (int i = tid; i < 8192; i += NWAVES * 64) { const float cv = a.c[i]; cact[i] = cv * sigmoidf_(cv); }
    __syncthreads();
    float* mod = (float*)(a.ws + WS_MOD);
    {
        LAS float* part = (LAS float*)(lds + 69632);
        for (int it = (int)blockIdx.x; it < 2 * 96; it += (int)gridDim.x) {
            const int l = it / 96, j = (it % 96) * 64 + lane;
            const float* w = a.w_ada + (size_t)l * 1024 * NMOD + j + (size_t)(wave_ * 128) * NMOD;
            float acc[8];
#pragma unroll
            for (int b = 0; b < 8; ++b) acc[b] = 0.f;
#pragma unroll 1
            for (int k = 0; k < 128; k += 32) {
                float wv[32];
#pragma unroll
                for (int kk = 0; kk < 32; ++kk) wv[kk] = w[(size_t)(k + kk) * NMOD];
#pragma unroll
                for (int b = 0; b < 8; ++b)
#pragma unroll
                    for (int k4 = 0; k4 < 32; k4 += 4) { const f32x4 cv = *(const LAS f32x4*)(cact + b * 1024 + wave_ * 128 + k + k4);
                        acc[b] += (cv[0] * wv[k4] + cv[1] * wv[k4 + 1]) + (cv[2] * wv[k4 + 2] + cv[3] * wv[k4 + 3]); }
            }
#pragma unroll
            for (int b = 0; b < 8; ++b) part[(wave_ * 8 + b) * 64 + lane] = acc[b];
            __syncthreads();
            { const int b = wave_; float sum = a.b_ada[l * NMOD + j];
#pragma unroll
              for (int w8 = 0; w8 < 8; ++w8) sum += part[(w8 * 8 + b) * 64 + lane];
              mod[((size_t)l * 8 + b) * NMOD + j] = sum; }
            __syncthreads();
        }
    }
    { bf16_t* WT = (bf16_t*)(a.ws + WS_MLS + MLS_WT);
      for (int i = gw * 64 + lane; i < 2 * 3 * 4 * 4096; i += ngw * 64) {
          const int d = i & 63, e = (i >> 6) & 63, h = (i >> 12) & 3, w = (i >> 14) % 3, l = i / (3 * 4 * 4096);
          const float* src = (w == 0) ? a.w_mq : (w == 1 ? a.w_mk : a.w_mv);
          const float v = src[((size_t)(l * 4 + h) * 64 + d) * 64 + e];
          WT[i] = f2bf(w == 1 ? v * 0.125f : v); } }
    tp_run(a, false, 0, TP_N_DENSE, (LAS float*)(lds + (tid >> 6) * 8704), gw, ngw);
    tp_run(a, true, TP_TAIL_INPROJ, TP_N_MOE / 2, (LAS float*)(lds + (tid >> 6) * 8704), gw, ngw);
}

__device__ __forceinline__ void tp_tail(const Args& a, int nunits, int G, int lo, int hi, LAS unsigned char* lds, int wave_) {
    const int rem = nunits % G;
    if ((int)blockIdx.x < rem || lo >= hi) return;
    tp_run(a, true, lo, hi, (LAS float*)(lds + wave_ * 8704), ((int)blockIdx.x - rem) * NWAVES + wave_, (G - rem) * NWAVES);
}
template <int HALF, int OFF, int N> __device__ __forceinline__ void reduce_tr_step(float (&v)[N], int lane) {
    const bool up = (lane & OFF) != 0;
#pragma unroll
    for (int i = 0; i < HALF; ++i) { const float snd = up ? v[i] : v[i + HALF], kep = up ? v[i + HALF] : v[i]; v[i] = kep + bperm_f(snd, lane ^ OFF); }
}
template <int N> __device__ __forceinline__ float reduce_tr(float (&v)[N], int lane);
template <> __device__ __forceinline__ float reduce_tr<16>(float (&v)[16], int lane) {
    reduce_tr_step<8, 32>(v, lane); reduce_tr_step<4, 16>(v, lane); reduce_tr_step<2, 8>(v, lane); reduce_tr_step<1, 4>(v, lane);
    float r = v[0]; r += bperm_f(r, lane ^ 2); r += bperm_f(r, lane ^ 1); return r; }
template <> __device__ __forceinline__ float reduce_tr<8>(float (&v)[8], int lane) {
    reduce_tr_step<4, 32>(v, lane); reduce_tr_step<2, 16>(v, lane); reduce_tr_step<1, 8>(v, lane);
    float r = v[0]; r += bperm_f(r, lane ^ 4); r += bperm_f(r, lane ^ 2); r += bperm_f(r, lane ^ 1); return r; }
template <int MODE, bool XBF>
__device__ __forceinline__ void phase_norm(const Args& a, int l, const void* xin, LAS unsigned char* lds, int gw, int ngw, int wave_) {
    const int lane = lane_id_opaque(), tid = wave_ * 64 + lane;
    constexpr int NC = (MODE == 1) ? 8 : 16;
    LAS float* wl = (LAS float*)lds;
    LAS int* hist = (LAS int*)(lds + 65536); LAS int* basek = hist + 32; LAS int* rowinfo = hist + 64;
    const int lc = l; l &= 1;
    const float* modl = (const float*)(a.ws + WS_MOD) + (size_t)l * 8 * NMOD;
    const int shift_off = (MODE == 1) ? 0 : 3072, scale_off = (MODE == 1) ? 1024 : 4096;
    if (MODE == 1) { const float* W = a.w_in + (size_t)l * 1024 * DIN + 512; for (int i = tid; i < 1024 * 8; i += NWAVES * 64) wl[(i & 7) * 1024 + (i >> 3)] = W[(size_t)(i >> 3) * DIN + (i & 7)]; }
    else { for (int i = tid; i < 1024 * 16; i += NWAVES * 64) wl[(i & 15) * 1024 + (i >> 4)] = a.w_router[i]; if (tid < 32) hist[tid] = 0; }
    __syncthreads();
    bf16_t* H = (bf16_t*)(a.ws + WS_H);
    float* gate = (float*)(a.ws + WS_GATE); float* rw = (float*)(a.ws + WS_RW); int* list = (int*)(a.ws + WS_LIST);
    int* cnt = (int*)(a.ws + WS_CTL) + CW_CNT + lc * 32;
    const int rows_per = (T_TOK + ngw - 1) / ngw;
    const int row0 = gw * rows_per;
    f32x4 msc[4], msh[4];
    { const int b = row0 / SEQ;
#pragma unroll
      for (int j = 0; j < 4; ++j) { const int k0 = XBF ? (8 * lane + 512 * (j >> 1) + 4 * (j & 1)) : (4 * lane + 256 * j); msc[j] = *(const f32x4*)(modl + (size_t)b * NMOD + scale_off + k0); msh[j] = *(const f32x4*)(modl + (size_t)b * NMOD + shift_off + k0);
#pragma unroll
          for (int q = 0; q < 4; ++q) msc[j][q] += 1.f; } }
    f32x4 nx0[4], nx1[4];
#define NORM_LOAD(T0, LN) do { \
        if (XBF) { _Pragma("unroll") for (int jj = 0; jj < 2; ++jj) { const u32x4 q0 = *((const u32x4*)((const bf16_t*)xin + (size_t)(T0) * DM) + (LN) + 64 * jj), q1 = *((const u32x4*)((const bf16_t*)xin + (size_t)((T0) + 1) * DM) + (LN) + 64 * jj); \
                nx0[2 * jj] = bf4_lo(q0); nx0[2 * jj + 1] = bf4_hi(q0); nx1[2 * jj] = bf4_lo(q1); nx1[2 * jj + 1] = bf4_hi(q1); } } \
        else { _Pragma("unroll") for (int j = 0; j < 4; ++j) { nx0[j] = *((const f32x4*)((const float*)xin + (size_t)(T0) * DM) + (LN) + 64 * j); nx1[j] = *((const f32x4*)((const float*)xin + (size_t)((T0) + 1) * DM) + (LN) + 64 * j); } } } while (0)
    NORM_LOAD(row0, lane);
#pragma unroll 1
    for (int i = 0; i < rows_per; i += 2) {
        const int lane = lane_id_opaque();
        const int t0 = row0 + i; if (t0 >= T_TOK) break;
        constexpr bool has1 = true; const int t1 = t0 + 1;
        f32x4 v0[4], v1[4]; float ss0 = 0.f, ss1 = 0.f;
#pragma unroll
        for (int j = 0; j < 4; ++j) { v0[j] = nx0[j]; v1[j] = nx1[j]; }
        { const int tn = (i + 2 < rows_per) ? t0 + 2 : t0;
          NORM_LOAD(tn, lane); }
#pragma unroll
        for (int j = 0; j < 4; ++j) { ss0 += (v0[j][0] * v0[j][0] + v0[j][1] * v0[j][1]) + (v0[j][2] * v0[j][2] + v0[j][3] * v0[j][3]); ss1 += (v1[j][0] * v1[j][0] + v1[j][1] * v1[j][1]) + (v1[j][2] * v1[j][2] + v1[j][3] * v1[j][3]); }
#pragma unroll
        for (int o = 32; o > 0; o >>= 1) { ss0 += bperm_f(ss0, lane ^ o); ss1 += bperm_f(ss1, lane ^ o); }
        const float rs0 = rsqrtf(ss0 * (1.f / 1024.f) + EPS), rs1 = rsqrtf(ss1 * (1.f / 1024.f) + EPS);
        float lg0[NC], lg1[NC];
#pragma unroll
        for (int e = 0; e < NC; ++e) { lg0[e] = 0.f; lg1[e] = 0.f; }
#pragma unroll
        for (int j = 0; j < 4; ++j) {
            const int k0 = XBF ? (8 * lane + 512 * (j >> 1) + 4 * (j & 1)) : (4 * lane + 256 * j);
            f32x4 h0, h1;
#pragma unroll
            for (int q = 0; q < 4; ++q) { h0[q] = v0[j][q] * rs0 * msc[j][q] + msh[j][q]; h1[q] = v1[j][q] * rs1 * msc[j][q] + msh[j][q]; }
            u32x2 o0; o0.x = pk2(h0[0], h0[1]); o0.y = pk2(h0[2], h0[3]); *(u32x2*)(H + (size_t)t0 * DM + k0) = o0;
            if (has1) { u32x2 o1; o1.x = pk2(h1[0], h1[1]); o1.y = pk2(h1[2], h1[3]); *(u32x2*)(H + (size_t)t1 * DM + k0) = o1; }
#pragma unroll
            for (int e8 = 0; e8 < NC; e8 += 8) {
#pragma unroll
                for (int e = e8; e < e8 + 8; ++e) { const f32x4 w = *(const LAS f32x4*)(wl + e * 1024 + k0);
                    lg0[e] += (h0[0] * w[0] + h0[1] * w[1]) + (h0[2] * w[2] + h0[3] * w[3]); lg1[e] += (h1[0] * w[0] + h1[1] * w[1]) + (h1[2] * w[2] + h1[3] * w[3]); }
                __builtin_amdgcn_sched_barrier(0);
            }
        }
        const float r0 = reduce_tr<NC>(lg0, lane), r1 = reduce_tr<NC>(lg1, lane);
        if (MODE == 1) {
            if ((lane & 7) == 0) { gate[(size_t)t0 * 8 + (lane >> 3)] = r0; if (has1) gate[(size_t)t1 * 8 + (lane >> 3)] = r1; }
        } else {
#pragma unroll
            for (int rr = 0; rr < 2; ++rr) {
                if (rr == 1 && !has1) break;
                const float rv = rr ? r1 : r0; const int t = rr ? t1 : t0;
                float sc[16], bs[16];
#pragma unroll
                for (int e = 0; e < 16; ++e) { const float lgt = __int_as_float(__builtin_amdgcn_readlane(__float_as_int(rv), 4 * e)); sc[e] = sigmoidf_(lgt); bs[e] = sc[e] + a.router_bias[e]; }
                float best_gs = -1e30f; int bk = 0; float bw0 = 0.f, bw1 = 0.f;
#pragma unroll
                for (int g = 0; g < 4; ++g) {
                    int i0 = 0; float q0 = bs[4 * g]; float s0 = sc[4 * g];
#pragma unroll
                    for (int j = 1; j < 4; ++j) if (bs[4 * g + j] > q0) { q0 = bs[4 * g + j]; i0 = j; s0 = sc[4 * g + j]; }
                    int i1 = -1; float q1 = -1e30f; float s1 = 0.f;
#pragma unroll
                    for (int j = 0; j < 4; ++j) if (j != i0 && bs[4 * g + j] > q1) { q1 = bs[4 * g + j]; i1 = j; s1 = sc[4 * g + j]; }
                    const float gs = q0 + q1;
                    if (gs > best_gs) { best_gs = gs;
                        const int lo = i0 < i1 ? i0 : i1, hi = i0 < i1 ? i1 : i0; const float wlo = i0 < i1 ? s0 : s1, whi = i0 < i1 ? s1 : s0;
                        const int pq = (lo == 0) ? (hi - 1) : (lo == 1 ? hi + 1 : 5);
                        bk = 6 * g + pq; bw0 = wlo; bw1 = whi; }
                }
                if (lane == 0) {
                    const float inv = 1.f / (bw0 + bw1);
                    *(f32x2*)(rw + (size_t)t * 2) = (f32x2){bw0 * inv, bw1 * inv};
                    const int pos = __hip_atomic_fetch_add(&hist[bk], 1, __ATOMIC_RELAXED, __HIP_MEMORY_SCOPE_WORKGROUP);
                    rowinfo[t - (int)blockIdx.x * (NWAVES * rows_per)] = bk | (pos << 8);
                }
            }
        }
    }
#undef NORM_LOAD
    if (MODE == 2) {
        __syncthreads();
        if (tid < NBUCK) { const int n = hist[tid]; basek[tid] = n ? atomicAdd(&cnt[tid], n) : 0; }
        __syncthreads();
        const int nrows = NWAVES * rows_per, brow0 = (int)blockIdx.x * nrows;
        for (int i = tid; i < nrows; i += NWAVES * 64) { const int t = brow0 + i; if (t < T_TOK) { const int ri = rowinfo[i]; const int k = ri & 255; list[(size_t)k * T_TOK + basek[k] + (ri >> 8)] = t; } }
    }
}

__device__ __forceinline__ void build_moe_tab(const Args& a, int l, LAS int* tab, int wave_) {
    const int tid = wave_ * 64 + lane_id_opaque();
    const int* cnt = (const int*)(a.ws + WS_CTL) + CW_CNT + l * 32;
    if (tid < 32) tab[tid] = (tid < NBUCK) ? cnt[tid] : 0;
    __syncthreads();
    if (tid < NBUCK) {
        int base = 0;
#pragma unroll 1
        for (int j = 0; j < tid; ++j) base += (tab[j] + 255) >> 8;
        const int mine = (tab[tid] + 255) >> 8;
#pragma unroll 1
        for (int i = 0; i < mine; ++i) { tab[32 + base + i] = tid; tab[192 + base + i] = i * 256; }
        if (tid == NBUCK - 1) tab[352] = base + mine;
    }
    __syncthreads();
}

__device__ __forceinline__ void phase_final(const Args& a, int gw, int ngw, float oscale, const XcdBarrier& bar, int wave_) {
    const int lane = lane_id_opaque();
    const bf16_t* XB = (const bf16_t*)(a.ws + WS_H);
    const int rows_per = (T_TOK + ngw - 1) / ngw, row0 = gw * rows_per;
    f32x4 g[4];
#pragma unroll
    for (int j = 0; j < 4; ++j) g[j] = *(const f32x4*)(a.g_final + 8 * lane + 512 * (j >> 1) + 4 * (j & 1));
    u32x4 nx[2][2];
#pragma unroll
    for (int rr = 0; rr < 2; ++rr)
#pragma unroll
        for (int jj = 0; jj < 2; ++jj) nx[rr][jj] = *((const u32x4*)(XB + (size_t)(row0 + rr) * DM) + lane + 64 * jj);
#pragma unroll 1
    for (int i = 0; i < rows_per; i += 2) {
        const int t0 = row0 + i; if (t0 >= T_TOK) break;
        u32x4 xv[2][2];
#pragma unroll
        for (int rr = 0; rr < 2; ++rr)
#pragma unroll
            for (int jj = 0; jj < 2; ++jj) xv[rr][jj] = nx[rr][jj];
        { const int tn = (i + 2 < rows_per) ? t0 + 2 : t0;
#pragma unroll
          for (int rr = 0; rr < 2; ++rr)
#pragma unroll
              for (int jj = 0; jj < 2; ++jj) nx[rr][jj] = *((const u32x4*)(XB + (size_t)(tn + rr) * DM) + lane + 64 * jj); }
#pragma unroll
        for (int rr = 0; rr < 2; ++rr) {
            const f32x4 v[4] = {bf4_lo(xv[rr][0]), bf4_hi(xv[rr][0]), bf4_lo(xv[rr][1]), bf4_hi(xv[rr][1])};
            float ss = 0.f;
#pragma unroll
            for (int j = 0; j < 4; ++j) ss += (v[j][0] * v[j][0] + v[j][1] * v[j][1]) + (v[j][2] * v[j][2] + v[j][3] * v[j][3]);
            ss = wave_sum_l(ss, lane);
            const float rstd = rsqrtf(ss * (1.f / 1024.f) + EPS) * oscale;
            float* orow = a.out + (size_t)(t0 + rr) * DM;
#pragma unroll
            for (int j = 0; j < 4; ++j) *(f32x4*)(orow + 8 * lane + 512 * (j >> 1) + 4 * (j & 1)) = v[j] * rstd * g[j];
        }
    }
}

typedef float f32x16 __attribute__((ext_vector_type(16)));
typedef short s16x4 __attribute__((ext_vector_type(4)));
typedef short v4i16_t __attribute__((ext_vector_type(4)));
#define MFMA32(a, b, c) __builtin_amdgcn_mfma_f32_32x32x16_bf16((a), (b), (c), 0, 0, 0)
__device__ __forceinline__ int crow(int i, int h) { return (i & 3) + 8 * (i >> 2) + 4 * h; }
__device__ __forceinline__ unsigned cvtpk(float lo, float hi) { typedef float f2_t __attribute__((ext_vector_type(2))); typedef __bf16 b2_t __attribute__((ext_vector_type(2)));
    f2_t v = {lo, hi}; b2_t b = __builtin_convertvector(v, b2_t); return __builtin_bit_cast(unsigned, b); }
__device__ __forceinline__ bf16x8 pack8(const f32x16& x, int s) { u32x4 p; p.x = cvtpk(x[8 * s], x[8 * s + 1]); p.y = cvtpk(x[8 * s + 2], x[8 * s + 3]); p.z = cvtpk(x[8 * s + 4], x[8 * s + 5]); p.w = cvtpk(x[8 * s + 6], x[8 * s + 7]); return __builtin_bit_cast(bf16x8, p); }
__device__ __forceinline__ void halves(float v, float& v0, float& v1) { auto rr = __builtin_amdgcn_permlane32_swap(__float_as_uint(v), __float_as_uint(v), false, false); v0 = __uint_as_float(rr[0]); v1 = __uint_as_float(rr[1]); }
__device__ __forceinline__ s16x4 vtr(const LAS unsigned char* p) { return __builtin_bit_cast(s16x4, __builtin_amdgcn_ds_read_tr16_b64_v4i16((LAS v4i16_t*)p)); }
constexpr int VP = 144;
__device__ __forceinline__ bf16x8 vt_frag(const LAS unsigned char* vl, int vtr0, int s, int db) {
    const s16x4 lo = vtr(vl + vtr0 + s * (16 * VP) + db * 64), hi = vtr(vl + vtr0 + s * (16 * VP) + 8 * VP + db * 64);
    return __builtin_shufflevector(lo, hi, 0, 1, 2, 3, 4, 5, 6, 7); }

#define KT_WRITE(KL, KV) do { _Pragma("unroll") for (int i = 0; i < 4; ++i) *(LAS u32x4*)((KL) + (vrow + 8 * i) * 144 + vseg * 16) = KV[i]; } while (0)
#define KT_FRAG(KL, D0) (*(const LAS bf16x8*)((KL) + r * 144 + 32 * (D0) + 16 * hh))
#ifndef SB_EARLY_EXIT
#define SB_EARLY_EXIT 1
#endif
__device__ __forceinline__ void sb_item(const bf16_t* U, const float* gh  , bf16_t* Y, LAS unsigned char* vl, int b, int h, int qt, int lane) {
    const int r = lane & 31, hh = lane >> 5;
    const size_t rowb = (size_t)b * SEQ;
    const bf16_t* Qp = U + (rowb + 32 * qt + r) * LDU + OFF_SB + h * 64 + 8 * hh;
    bf16x8 qf[4];
#pragma unroll
    for (int d0 = 0; d0 < 4; ++d0) qf[d0] = *(const bf16x8*)(Qp + 16 * d0);
    f32x16 o0, o1;
#pragma unroll
    for (int i = 0; i < 16; ++i) { o0[i] = 0.f; o1[i] = 0.f; }
    float carry = 1.f;
    f32x4 gha[4], ghb[4];
#pragma unroll
    for (int g = 0; g < 4; ++g) { gha[g] = *(const f32x4*)(gh + 8 * g + 4 * hh); ghb[g] = *(const f32x4*)(gh + 32 + 8 * g + 4 * hh); }
    const bf16_t* Kb = U + rowb * LDU + OFF_SB + 384 + h * 64; const bf16_t* Vb = Kb + 384;
    const int vrow = lane >> 3, vseg = lane & 7;
    const int i16 = lane & 15, q4 = i16 >> 2, p4 = i16 & 3, blk = (lane >> 4) & 1;
    const int vtr0 = (4 * hh + q4) * VP + (16 * blk + 4 * p4) * 2;
    unsigned loff[4];
#pragma unroll
    for (int i = 0; i < 4; ++i) loff[i] = (unsigned)((vrow + 8 * i) * LDU + 8 * vseg) * 2u;
#define SB_LOAD(KT, KF, VV) do { const char* kb_ = (const char*)(Kb + (size_t)(32 * (KT)) * LDU); \
        _Pragma("unroll") for (int i = 0; i < 4; ++i) { KF[i] = *(const u32x4*)(kb_ + loff[i]); VV[i] = *(const u32x4*)(kb_ + 768 + loff[i]); } } while (0)
#define SB_TILE(KT, KF, VV) do { \
        KT_WRITE(kl, KF); \
        _Pragma("unroll") for (int i = 0; i < 4; ++i) *(LAS u32x4*)(vl + (vrow + 8 * i) * VP + vseg * 16) = VV[i]; \
        f32x16 sc; \
        _Pragma("unroll") for (int i = 0; i < 16; ++i) sc[i] = 0.f; \
        _Pragma("unroll") for (int d0 = 0; d0 < 4; ++d0) sc = MFMA32(KT_FRAG(kl, d0), qf[d0], sc); \
        float sg[16], kp[16]; \
        _Pragma("unroll") for (int i = 0; i < 16; ++i) { \
            const float z2 = fminf(sc[i] * (-0.125f * 1.4426950408889634f), 115.f); \
            const float e = __builtin_amdgcn_exp2f(z2); float sig = __builtin_amdgcn_rcpf(1.f + e); float keep = e * sig; \
            if ((KT) == qt) { const bool valid = crow(i, hh) < r; sig = valid ? sig : 0.f; keep = valid ? keep : 1.f; } \
            sg[i] = sig; kp[i] = keep; } \
        float G0[4], G1[4], PP[4]; \
        _Pragma("unroll") for (int g = 0; g < 4; ++g) { const float G = (kp[4 * g] * kp[4 * g + 1]) * (kp[4 * g + 2] * kp[4 * g + 3]); halves(G, G0[g], G1[g]); PP[g] = G0[g] * G1[g]; } \
        float SP[4]; SP[3] = 1.f; SP[2] = PP[3]; SP[1] = PP[3] * PP[2]; SP[0] = SP[1] * PP[1]; \
        const float total = SP[0] * PP[0]; \
        _Pragma("unroll") for (int g = 0; g < 4; ++g) { \
            const float r3 = carry * SP[g] * (hh ? 1.f : G1[g]); \
            const float r2 = r3 * kp[4 * g + 3], r1 = r2 * kp[4 * g + 2], r0 = r1 * kp[4 * g + 1]; \
            sc[4 * g + 3] = sg[4 * g + 3] * r3; sc[4 * g + 2] = sg[4 * g + 2] * r2; sc[4 * g + 1] = sg[4 * g + 1] * r1; sc[4 * g] = sg[4 * g] * r0; } \
        carry *= total; \
        const bf16x8 pb0 = pack8(sc, 0), pb1 = pack8(sc, 1); \
        o0 = MFMA32(vt_frag(vl, vtr0, 0, 0), pb0, o0); o0 = MFMA32(vt_frag(vl, vtr0, 1, 0), pb1, o0); \
        o1 = MFMA32(vt_frag(vl, vtr0, 0, 1), pb0, o1); o1 = MFMA32(vt_frag(vl, vtr0, 1, 1), pb1, o1); } while (0)
#define SB_DONE() (SB_EARLY_EXIT && __builtin_amdgcn_ballot_w64(carry >= 1e-37f) == 0ull)
    {
        u32x4 kA[4], kB[4], vA[4], vB[4];
        LAS unsigned char* kl = vl + 4608;
        int kt = qt;
        SB_LOAD(kt, kA, vA);
#pragma unroll 1
        for (;;) {
            if (kt > 0) SB_LOAD(kt - 1, kB, vB);
            SB_TILE(kt, kA, vA);
            if (kt == 0 || SB_DONE()) break;
            --kt;
            if (kt > 0) SB_LOAD(kt - 1, kA, vA);
            SB_TILE(kt, kB, vB);
            if (kt == 0 || SB_DONE()) break;
            --kt;
        }
    }
#undef SB_LOAD
#undef SB_TILE
#undef SB_DONE
    float ss = 0.f;
#pragma unroll
    for (int i = 0; i < 16; ++i) ss += o0[i] * o0[i] + o1[i] * o1[i];
    float s0, s1; halves(ss, s0, s1);
    const float rs = rsqrtf((s0 + s1) * (1.f / 64.f) + EPS);
    bf16_t* yr = Y + (rowb + 32 * qt + r) * 1024 + (10 + h) * 64;
#pragma unroll
    for (int g = 0; g < 4; ++g) {
        const int d0 = 8 * g + 4 * hh;
        const f32x4 ga = gha[g], gb = ghb[g];
        u32x2 wa, wb; wa.x = cvtpk(o0[4 * g] * rs * ga[0], o0[4 * g + 1] * rs * ga[1]); wa.y = cvtpk(o0[4 * g + 2] * rs * ga[2], o0[4 * g + 3] * rs * ga[3]);
        wb.x = cvtpk(o1[4 * g] * rs * gb[0], o1[4 * g + 1] * rs * gb[1]); wb.y = cvtpk(o1[4 * g + 2] * rs * gb[2], o1[4 * g + 3] * rs * gb[3]);
        *(u32x2*)(yr + d0) = wa; *(u32x2*)(yr + 32 + d0) = wb;
    }
}
__device__ __forceinline__ void phase_sb(const Args& a, int l, LAS unsigned char* lds, int gw, int ngw, int wave_) {
    const int lane = lane_id_opaque();
    LAS unsigned char* vl = lds + wave_ * 16384;
    const bf16_t* U = (const bf16_t*)(a.ws + WS_U); bf16_t* Y = (bf16_t*)(a.ws + WS_Y);
    for (int it = gw; it < NB * 6 * 128; it += ngw) {
        const int qt = 127 - (it % 128), h = (it / 128) % 6, b = it / 768;
        sb_item(U, a.g_head + l * 1024 + (10 + h) * 64, Y, vl, b, h, qt, lane);
    }
}


#ifdef TS_DIL
#define TSD(k) do { if (tsacc) { const unsigned long long t_ = __builtin_amdgcn_s_memrealtime(); if (TS_DIL == (k)) *tsacc += t_ - tsd_; tsd_ = t_; } } while (0)
#else
#define TSD(k) do { } while (0)
#endif
__device__ __forceinline__ void dil_item(const bf16_t* U, bf16_t* OP, int op_pitch, float* LSE, LAS unsigned char* vl, int b, int h, int p, int qi, int lane, unsigned long long* tsacc) {
#ifdef TS_DIL
    unsigned long long tsd_ = __builtin_amdgcn_s_memrealtime();
#endif
    const int r = lane & 31, hh = lane >> 5;
    const int sh = 2 * p, d = 1 << sh, nblk = (SEQ >> sh) / 32, c = qi / nblk, m0 = 32 * (qi % nblk);
    const size_t rowb = (size_t)b * SEQ;
    const int tq = ((m0 + r) << sh) + c;
    const bf16_t* Qp = U + (rowb + tq) * LDU + OFF_DIL + h * 64 + 8 * hh;
    bf16x8 qf[4];
#pragma unroll
    for (int d0 = 0; d0 < 4; ++d0) qf[d0] = *(const bf16x8*)(Qp + 16 * d0);
    const float sb = exp2f(-8.f * (float)(h + 1) / 6.f) * (float)d * 1.4426950408889634f;
    f32x16 o0, o1;
#pragma unroll
    for (int i = 0; i < 16; ++i) { o0[i] = 0.f; o1[i] = 0.f; }
    float m_run = -1e30f, l_run = 0.f;
    const bf16_t* Kb = U + rowb * LDU + OFF_DIL + 384 + h * 64; const bf16_t* Vb = Kb + 384;
    const int vrow = lane >> 3, vseg = lane & 7;
    const int i16 = lane & 15, q4 = i16 >> 2, p4 = i16 & 3, blk = (lane >> 4) & 1;
    const int vtr0 = (4 * hh + q4) * VP + (16 * blk + 4 * p4) * 2;
    unsigned loff[4];
#pragma unroll
    for (int i = 0; i < 4; ++i) loff[i] = (unsigned)(((vrow + 8 * i) << sh) * LDU + 8 * vseg) * 2u;
#define DL_LOAD(J, KF, VV) do { const int mk0_ = m0 - 128 + 32 * (J); const char* kb_ = (const char*)(Kb + (size_t)((mk0_ << sh) + c) * LDU); \
        _Pragma("unroll") for (int i = 0; i < 4; ++i) { KF[i] = *(const u32x4*)(kb_ + loff[i]); VV[i] = *(const u32x4*)(kb_ + 768 + loff[i]); } } while (0)
#define DL_TILE(J, KF, VV) do { \
        KT_WRITE(kl, KF); \
        _Pragma("unroll") for (int i = 0; i < 4; ++i) *(LAS u32x4*)(vl + (vrow + 8 * i) * VP + vseg * 16) = VV[i]; \
        f32x16 sc; \
        _Pragma("unroll") for (int i = 0; i < 16; ++i) sc[i] = 0.f; \
        _Pragma("unroll") for (int d0 = 0; d0 < 4; ++d0) sc = MFMA32(KT_FRAG(kl, d0), qf[d0], sc); \
        float mx = -1e30f; \
        const float base2 = -sb * (float)(r + 128 - 32 * (J) - 4 * hh); \
        _Pragma("unroll") for (int i = 0; i < 16; ++i) { \
            const int cr = crow(i, hh); \
            float v = fmaf(sb, (float)((i & 3) + 8 * (i >> 2)), fmaf(sc[i], 0.125f * 1.4426950408889634f, base2)); \
            if ((J) == 4) v = (cr <= r) ? v : -1e30f; \
            if ((J) == 0) v = (cr >= r) ? v : -1e30f; \
            sc[i] = v; mx = fmaxf(mx, v); } \
        float mx0, mx1; halves(mx, mx0, mx1); \
        const float m_new = fmaxf(m_run, fmaxf(mx0, mx1)); \
        const float corr = __builtin_amdgcn_exp2f(m_run - m_new); \
        float ps = 0.f; \
        _Pragma("unroll") for (int i = 0; i < 16; ++i) { const float pe = __builtin_amdgcn_exp2f(sc[i] - m_new); sc[i] = pe; ps += pe; } \
        float ps0, ps1; halves(ps, ps0, ps1); \
        l_run = l_run * corr + (ps0 + ps1); \
        if (__builtin_amdgcn_ballot_w64(m_new != m_run) != 0ull) { _Pragma("unroll") for (int i = 0; i < 16; ++i) { o0[i] *= corr; o1[i] *= corr; } } \
        m_run = m_new; \
        const bf16x8 pb0 = pack8(sc, 0), pb1 = pack8(sc, 1); \
        o0 = MFMA32(vt_frag(vl, vtr0, 0, 0), pb0, o0); o0 = MFMA32(vt_frag(vl, vtr0, 1, 0), pb1, o0); \
        o1 = MFMA32(vt_frag(vl, vtr0, 0, 1), pb0, o1); o1 = MFMA32(vt_frag(vl, vtr0, 1, 1), pb1, o1); } while (0)
    {
        TSD(0);
        const int jmin = (m0 >= 128) ? 0 : (4 - m0 / 32);
        u32x4 kA[4], kB[4], vA[4], vB[4];
        LAS unsigned char* kl = vl + 4608;
        int j = 4;
        DL_LOAD(j, kA, vA);
#pragma unroll 1
        for (;;) {
            if (j > jmin) DL_LOAD(j - 1, kB, vB);
            DL_TILE(j, kA, vA);
            if (j == jmin) break;
            --j;
            if (j > jmin) DL_LOAD(j - 1, kA, vA);
            DL_TILE(j, kB, vB);
            if (j == jmin) break;
            --j;
        }
    }
#undef DL_LOAD
#undef DL_TILE
    TSD(1);
    const float inv = 1.f / l_run;
    bf16_t* orow = OP + (rowb + tq) * op_pitch + h * 64;
#pragma unroll
    for (int g = 0; g < 4; ++g) {
        const int d0 = 8 * g + 4 * hh;
        u32x2 wa, wb; wa.x = cvtpk(o0[4 * g] * inv, o0[4 * g + 1] * inv); wa.y = cvtpk(o0[4 * g + 2] * inv, o0[4 * g + 3] * inv);
        wb.x = cvtpk(o1[4 * g] * inv, o1[4 * g + 1] * inv); wb.y = cvtpk(o1[4 * g + 2] * inv, o1[4 * g + 3] * inv);
        *(u32x2*)(orow + d0) = wa; *(u32x2*)(orow + 32 + d0) = wb;
    }
    if (hh == 0) LSE[(rowb + tq) * 6 + h] = m_run * 0.6931471805599453f + __logf(l_run);
    TSD(2);
}
__device__ __forceinline__ bf16_t* dil_op(unsigned char* ws, int p) { return (p == 0) ? (bf16_t*)(ws + WS_Y) + 256 : ((p == 1) ? (bf16_t*)(ws + WS_OP1) : (bf16_t*)(ws + WS_OP2)); }
__device__ __forceinline__ int dil_pitch(int p) { return p == 0 ? 1024 : 384; }
__device__ __forceinline__ void phase_dil(const Args& a, int l, LAS unsigned char* lds, int gw, int ngw, int wave_, int p_lo, int p_hi) {
    const int lane = lane_id_opaque();
    LAS unsigned char* vl = lds + wave_ * 16384;
    const bf16_t* U = (const bf16_t*)(a.ws + WS_U);
    for (int it = gw; it < (p_hi - p_lo) * NB * 6 * 128; it += ngw) {
        const int qi = it % 128, h = (it / 128) % 6, b = (it / 768) % NB, p = p_lo + it / (768 * NB);
        dil_item(U, dil_op(a.ws, p), dil_pitch(p), (float*)(a.ws + WS_LSE) + (size_t)p * T_TOK * 6, vl, b, h, p, qi, lane,
#ifdef TS_DIL
                 (gw == 77 && lane == 0 && l == 0) ? (unsigned long long*)((unsigned*)(a.ws + WS_CTL) + 12288) + 40 : nullptr
#else
                 nullptr
#endif
                 );
    }
}
__device__ __forceinline__ void phase_dil_merge(const Args& a, int l, int gw, int ngw) {
    const int lane = lane_id_opaque(); const int pr = lane >> 3, ch = lane & 7;
    const bf16_t* O0 = dil_op(a.ws, 0); const bf16_t* O1 = dil_op(a.ws, 1); const bf16_t* O2 = dil_op(a.ws, 2);
    const float* L0 = (const float*)(a.ws + WS_LSE); const float* L1 = L0 + (size_t)T_TOK * 6; const float* L2 = L1 + (size_t)T_TOK * 6;
    bf16_t* Y = (bf16_t*)(a.ws + WS_Y);
    for (int it = gw; it < T_TOK * 6 / 8; it += ngw) {
        const int pi = it * 8 + pr; const int t = pi / 6, hd = pi - 6 * t;
        const float l0 = L0[pi], l1 = L1[pi], l2 = L2[pi];
        const size_t o = (size_t)t * 384 + hd * 64 + ch * 8;
        const u32x4 a0 = *(const u32x4*)(O0 + (size_t)t * 1024 + hd * 64 + ch * 8), a1 = *(const u32x4*)(O1 + o), a2 = *(const u32x4*)(O2 + o);
        const float mx = fmaxf(l0, fmaxf(l1, l2));
        float w0 = __expf(l0 - mx), w1 = __expf(l1 - mx), w2 = __expf(l2 - mx); const float inv = 1.f / (w0 + w1 + w2); w0 *= inv; w1 *= inv; w2 *= inv;
        float v[8]; float ss = 0.f;
#pragma unroll
        for (int q = 0; q < 4; ++q) {
            v[2 * q]     = w0 * __uint_as_float(a0[q] << 16) + w1 * __uint_as_float(a1[q] << 16) + w2 * __uint_as_float(a2[q] << 16);
            v[2 * q + 1] = w0 * __uint_as_float(a0[q] & 0xffff0000u) + w1 * __uint_as_float(a1[q] & 0xffff0000u) + w2 * __uint_as_float(a2[q] & 0xffff0000u);
            ss += v[2 * q] * v[2 * q] + v[2 * q + 1] * v[2 * q + 1];
        }
#pragma unroll
        for (int of = 1; of < 8; of <<= 1) ss += bperm_f(ss, lane ^ of);
        const float rs = rsqrtf(ss * (1.f / 64.f) + EPS);
        const float* gh = a.g_head + l * 1024 + (4 + hd) * 64 + ch * 8;
        const f32x4 ga = *(const f32x4*)gh, gb = *(const f32x4*)(gh + 4);
        u32x4 w; w.x = cvtpk(v[0] * rs * ga[0], v[1] * rs * ga[1]); w.y = cvtpk(v[2] * rs * ga[2], v[3] * rs * ga[3]); w.z = cvtpk(v[4] * rs * gb[0], v[5] * rs * gb[1]); w.w = cvtpk(v[6] * rs * gb[2], v[7] * rs * gb[3]);
        *(u32x4*)(Y + (size_t)t * 1024 + (4 + hd) * 64 + ch * 8) = w;
    }
}

__device__ __forceinline__ float scan_add64(float v, int lane) {
#pragma unroll
    for (int o = 1; o < 64; o <<= 1) { const float t = bperm_f(v, lane - o); v = (lane >= o) ? v + t : v; }
    return v; }
__device__ __forceinline__ float scan_max64(float v, int lane) {
#pragma unroll
    for (int o = 1; o < 64; o <<= 1) { const float t = bperm_f(v, lane - o); v = (lane >= o) ? fmaxf(v, t) : v; }
    return v; }
__device__ __forceinline__ float bcast63(float v) { return __int_as_float(__builtin_amdgcn_readlane(__float_as_int(v), 63)); }

__device__ __forceinline__ void ml_b1_item(const Args& a, int l, LAS unsigned char* wl  , int b, int h, int c, int half) {
    const int bh = b * 4 + h;
    const size_t rowb = (size_t)b * SEQ + 128 * c;
    unsigned char* mls = a.ws + WS_MLS;
    LAS float* cw = (LAS float*)(wl + 9216);
    float w0, w1;
    const bf16_t* U = (const bf16_t*)(a.ws + WS_U);
    bf16_t* Qm = (bf16_t*)(a.ws + WS_QKV); bf16_t* Km = Qm + (size_t)T_TOK * 256; bf16_t* Vm = Km + (size_t)T_TOK * 256;
    { const int lane = lane_id_opaque();
    const float* GATE = (const float*)(a.ws + WS_GATE);
    const float gbi = a.gate_bias[l * 8 + h], gbf = a.gate_bias[l * 8 + 4 + h];
    const size_t t0 = rowb + lane, t1 = t0 + 64;
    const float ig0 = GATE[t0 * 8 + h] + gbi, ig1 = GATE[t1 * 8 + h] + gbi;
    const float lf0 = -softplusf_(-(GATE[t0 * 8 + 4 + h] + gbf)), lf1 = -softplusf_(-(GATE[t1 * 8 + 4 + h] + gbf));
    const float c0 = scan_add64(lf0, lane); const float c1 = scan_add64(lf1, lane) + bcast63(c0);
    const float a0 = ig0 - c0, a1 = ig1 - c1;
    const float p0 = scan_max64(a0, lane); const float p1 = fmaxf(scan_max64(a1, lane), bcast63(p0));
    const float Amax = bcast63(p1), Lsum = bcast63(c1);
    if (half == 0) {
    ((float*)(mls + MLS_CUM))[t0 * 4 + h] = c0; ((float*)(mls + MLS_CUM))[t1 * 4 + h] = c1;
    ((float*)(mls + MLS_AA))[t0 * 4 + h] = a0;  ((float*)(mls + MLS_AA))[t1 * 4 + h] = a1;
    ((float*)(mls + MLS_PM))[t0 * 4 + h] = p0;  ((float*)(mls + MLS_PM))[t1 * 4 + h] = p1;
    if (lane == 0) { ((float*)(mls + MLS_AMAX))[bh * 32 + c] = Amax; ((float*)(mls + MLS_LSUM))[bh * 32 + c] = Lsum; }
    }
    w0 = __expf(a0 - Amax); w1 = __expf(a1 - Amax);
#pragma unroll
    for (int j = 0; j < 4; ++j) cw[j * 64 + lane] = a.conv_w[(l * 4 + j) * 256 + h * 64 + lane];
    cw[256 + lane] = a.conv_b[l * 256 + h * 64 + lane];
    }
    const bf16_t* WT = (const bf16_t*)(mls + MLS_WT) + (size_t)(l * 3 * 4 + h) * 4096;
    LAS unsigned char* vt = wl; LAS unsigned char* kt = wl + 4608;
    f32x16 acc[2][2], nacc[2];
#pragma unroll
    for (int i = 0; i < 16; ++i) { acc[0][0][i] = 0.f; acc[0][1][i] = 0.f; acc[1][0][i] = 0.f; acc[1][1][i] = 0.f; nacc[0][i] = 0.f; nacc[1][i] = 0.f; }
    bf16x8 ones;
#pragma unroll
    for (int j = 0; j < 8; ++j) ones[j] = (short)0x3F80;
#pragma unroll 1
    for (int st = 2 * half; st < 2 * half + 2; ++st) {
        const int lane = lane_id_opaque(); const int r = lane & 31, hh = lane >> 5;
        const int i16 = lane & 15, q4 = i16 >> 2, p4 = i16 & 3, blk = (lane >> 4) & 1;
        const int vtr0 = (4 * hh + q4) * VP + (16 * blk + 4 * p4) * 2;
        const size_t row = rowb + 32 * st + r; const int tt = 128 * c + 32 * st + r;
        const float wt = bperm_f((st < 2) ? w0 : w1, 32 * (st & 1) + r);
        bf16x8 xcf[4], xmf[4];
        bf16x8 xa[4][4];
#pragma unroll
        for (int d0 = 0; d0 < 4; ++d0) {
            const int ch = 16 * d0 + 8 * hh;
#pragma unroll
            for (int j = 0; j < 4; ++j) { const bool ok = (tt - 3 + j >= 0); const bf16x8 ld = *(const bf16x8*)(U + (ok ? row - 3 + j : row) * LDU + OFF_ML_X + h * 64 + ch);
                const u32x4 lu = __builtin_bit_cast(u32x4, ld); u32x4 z; z.x = ok ? lu.x : 0u; z.y = ok ? lu.y : 0u; z.z = ok ? lu.z : 0u; z.w = ok ? lu.w : 0u; xa[d0][j] = __builtin_bit_cast(bf16x8, z); }
        }
#pragma unroll
        for (int d0 = 0; d0 < 4; ++d0) {
            const int ch = 16 * d0 + 8 * hh;
            const bf16x8 (&x)[4] = xa[d0];
            xmf[d0] = x[3];
            float xv[8];
            { const f32x4 ba = *(const LAS f32x4*)(cw + 256 + ch), bb = *(const LAS f32x4*)(cw + 256 + ch + 4);
              xv[0] = ba[0]; xv[1] = ba[1]; xv[2] = ba[2]; xv[3] = ba[3]; xv[4] = bb[0]; xv[5] = bb[1]; xv[6] = bb[2]; xv[7] = bb[3]; }
#pragma unroll
            for (int j = 0; j < 4; ++j) { const f32x4 wa = *(const LAS f32x4*)(cw + j * 64 + ch), wb = *(const LAS f32x4*)(cw + j * 64 + ch + 4);
#pragma unroll
                for (int e = 0; e < 4; ++e) { xv[e] += wa[e] * bf2f((bf16_t)x[j][e]); xv[4 + e] += wb[e] * bf2f((bf16_t)x[j][4 + e]); } }
            u32x4 pk;
            pk.x = cvtpk(xv[0] * sigmoidf_(xv[0]), xv[1] * sigmoidf_(xv[1])); pk.y = cvtpk(xv[2] * sigmoidf_(xv[2]), xv[3] * sigmoidf_(xv[3]));
            pk.z = cvtpk(xv[4] * sigmoidf_(xv[4]), xv[5] * sigmoidf_(xv[5])); pk.w = cvtpk(xv[6] * sigmoidf_(xv[6]), xv[7] * sigmoidf_(xv[7]));
            xcf[d0] = __builtin_bit_cast(bf16x8, pk);
        }
#pragma unroll
        for (int w = 0; w < 3; ++w) {
            bf16x8 wf[2][4];
#pragma unroll
            for (int eb = 0; eb < 2; ++eb)
#pragma unroll
                for (int d0 = 0; d0 < 4; ++d0) wf[eb][d0] = *(const bf16x8*)(WT + (size_t)w * 4 * 4096 + (32 * eb + r) * 64 + 16 * d0 + 8 * hh);
#pragma unroll
            for (int eb = 0; eb < 2; ++eb) {
                f32x16 pr;
#pragma unroll
                for (int i = 0; i < 16; ++i) pr[i] = 0.f;
#pragma unroll
                for (int d0 = 0; d0 < 4; ++d0) pr = MFMA32(wf[eb][d0], (w == 2) ? xmf[d0] : xcf[d0], pr);
                bf16_t* dst = ((w == 0) ? Qm : (w == 1 ? Km : Vm)) + row * 256 + h * 64 + 32 * eb;
#pragma unroll
                for (int g = 0; g < 4; ++g) {
                    const int e0 = 8 * g + 4 * hh;
                    u32x2 o; o.x = cvtpk(pr[4 * g], pr[4 * g + 1]); o.y = cvtpk(pr[4 * g + 2], pr[4 * g + 3]);
                    *(u32x2*)(dst + e0) = o;
                    if (w == 1) { u32x2 k2; k2.x = cvtpk(pr[4 * g] * wt, pr[4 * g + 1] * wt); k2.y = cvtpk(pr[4 * g + 2] * wt, pr[4 * g + 3] * wt); *(LAS u32x2*)(kt + r * VP + (32 * eb + e0) * 2) = k2; }
                    if (w == 2) *(LAS u32x2*)(vt + r * VP + (32 * eb + e0) * 2) = o;
                }
            }
            __builtin_amdgcn_sched_barrier(0);
        }
#pragma unroll
        for (int sk = 0; sk < 2; ++sk) {
            const bf16x8 kb0 = vt_frag(kt, vtr0, sk, 0), kb1 = vt_frag(kt, vtr0, sk, 1), va0 = vt_frag(vt, vtr0, sk, 0), va1 = vt_frag(vt, vtr0, sk, 1);
            acc[0][0] = MFMA32(va0, kb0, acc[0][0]); acc[0][1] = MFMA32(va0, kb1, acc[0][1]);
            acc[1][0] = MFMA32(va1, kb0, acc[1][0]); acc[1][1] = MFMA32(va1, kb1, acc[1][1]);
            nacc[0] = MFMA32(ones, kb0, nacc[0]); nacc[1] = MFMA32(ones, kb1, nacc[1]);
        }
    }
    const int lane = lane_id_opaque(); const int r = lane & 31, hh = lane >> 5;
    float* CL = (float*)(a.ws + WS_CLOC) + ((size_t)half * 1024 + bh * 32 + c) * 4096;
#pragma unroll
    for (int eb = 0; eb < 2; ++eb)
#pragma unroll
        for (int db = 0; db < 2; ++db)
#pragma unroll
            for (int i = 0; i < 16; ++i) CL[(32 * eb + crow(i, hh)) * 64 + 32 * db + r] = acc[eb][db][i];
    if (hh == 0) { float* NL = (float*)(mls + MLS_NLOC) + ((size_t)half * 1024 + bh * 32 + c) * 64; NL[r] = nacc[0][0]; NL[32 + r] = nacc[1][0]; }
}

__device__ __forceinline__ void phase_ml_b2(const Args& a, int gthread, int nthreads) {
    unsigned char* mls = a.ws + WS_MLS;
    const float* AM = (const float*)(mls + MLS_AMAX); const float* LS = (const float*)(mls + MLS_LSUM);
    for (int idx = gthread; idx < 32 * 4096; idx += nthreads) {
        const int bh = idx >> 12, ed = idx & 4095;
        const float* CL = (const float*)(a.ws + WS_CLOC) + (size_t)bh * 32 * 4096 + ed;
        bf16_t* CT = (bf16_t*)(a.ws + WS_CT) + (size_t)bh * 32 * 4096 + ed;
        const bool isn = ed < 64;
        const float* NL = (const float*)(mls + MLS_NLOC) + (size_t)bh * 32 * 64 + (ed & 63);
        float* NCp = (float*)(mls + MLS_NC) + (size_t)bh * 32 * 64 + (ed & 63);
        float C = 0.f, n = 0.f, m = 0.f;
        float cl[32];
#pragma unroll
        for (int c = 0; c < 32; ++c) cl[c] = CL[(size_t)c * 4096] + CL[(size_t)(1024 + c) * 4096];
#pragma unroll
        for (int c = 0; c < 32; ++c) {
            CT[(size_t)c * 4096] = f2bf(C);
            if (isn) NCp[c * 64] = n;
            if (ed == 0) ((float*)(mls + MLS_MC))[bh * 32 + c] = m;
            const float A = AM[bh * 32 + c], L = LS[bh * 32 + c];
            const float M = fmaxf(m, A); const float dec = __expf(m - M), sc = __expf(A - M);
            C = dec * C + sc * cl[c];
            if (isn) n = dec * n + sc * (NL[c * 64] + NL[(1024 + c) * 64]);
            m = L + M;
        }
    }
}

__device__ __forceinline__ void ml_b3_item(const Args& a, int l, LAS unsigned char* wl, int b, int h, int c, int qt, int lane) {
    const int r = lane & 31, hh = lane >> 5, bh = b * 4 + h;
    const size_t rowc = (size_t)b * SEQ + 128 * c, rowq = rowc + 32 * qt + r;
    unsigned char* mls = a.ws + WS_MLS;
    const bf16_t* Qm = (const bf16_t*)(a.ws + WS_QKV); const bf16_t* Km = Qm + (size_t)T_TOK * 256; const bf16_t* Vm = Km + (size_t)T_TOK * 256;
    LAS float* atab = (LAS float*)(wl + 4608);
    atab[lane] = ((const float*)(mls + MLS_AA))[(rowc + lane) * 4 + h]; atab[64 + lane] = ((const float*)(mls + MLS_AA))[(rowc + 64 + lane) * 4 + h];
    const float cum_t = ((const float*)(mls + MLS_CUM))[rowq * 4 + h], pm_t = ((const float*)(mls + MLS_PM))[rowq * 4 + h];
    const float m_c = ((const float*)(mls + MLS_MC))[bh * 32 + c];
    const float M_t = fmaxf(m_c, pm_t), inter = __expf(m_c - M_t), m_t = cum_t + M_t;
    bf16x8 qf[4];
#pragma unroll
    for (int d0 = 0; d0 < 4; ++d0) qf[d0] = *(const bf16x8*)(Qm + rowq * 256 + h * 64 + 16 * d0 + 8 * hh);
    const bf16_t* og = (const bf16_t*)(a.ws + WS_U) + rowq * LDU + OFF_ML_O + h * 64;
    const float* gh = a.g_head + l * 1024 + h * 64;
    u32x2 oga[4], ogb[4]; f32x4 gha[4], ghb[4];
#pragma unroll
    for (int g = 0; g < 4; ++g) { const int d0 = 8 * g + 4 * hh; oga[g] = *(const u32x2*)(og + d0); ogb[g] = *(const u32x2*)(og + 32 + d0); gha[g] = *(const f32x4*)(gh + d0); ghb[g] = *(const f32x4*)(gh + 32 + d0); }
    const float* NCp = (const float*)(mls + MLS_NC) + (size_t)(bh * 32 + c) * 64;
    f32x4 nca[4], ncb[4];
#pragma unroll
    for (int d0 = 0; d0 < 4; ++d0) { nca[d0] = *(const f32x4*)(NCp + 16 * d0 + 8 * hh); ncb[d0] = *(const f32x4*)(NCp + 16 * d0 + 8 * hh + 4); }
    const bf16_t* CT = (const bf16_t*)(a.ws + WS_CT) + (size_t)(bh * 32 + c) * 4096;
    bf16x8 ctf[2][4];
#pragma unroll
    for (int d0 = 0; d0 < 4; ++d0) { ctf[0][d0] = *(const bf16x8*)(CT + (size_t)r * 64 + 16 * d0 + 8 * hh); ctf[1][d0] = *(const bf16x8*)(CT + (size_t)(32 + r) * 64 + 16 * d0 + 8 * hh); }
    f32x16 n0, n1;
#pragma unroll
    for (int i = 0; i < 16; ++i) { n0[i] = 0.f; n1[i] = 0.f; }
#pragma unroll
    for (int d0 = 0; d0 < 4; ++d0) { n0 = MFMA32(ctf[0][d0], qf[d0], n0); n1 = MFMA32(ctf[1][d0], qf[d0], n1); }
    float qn = 0.f;
#pragma unroll
    for (int d0 = 0; d0 < 4; ++d0) { const f32x4 na = nca[d0], nb = ncb[d0];
#pragma unroll
        for (int e = 0; e < 4; ++e) { qn += bf2f((bf16_t)qf[d0][e]) * na[e]; qn += bf2f((bf16_t)qf[d0][4 + e]) * nb[e]; } }
    float qn0, qn1; halves(qn, qn0, qn1); qn = qn0 + qn1;
#pragma unroll
    for (int i = 0; i < 16; ++i) { n0[i] *= inter; n1[i] *= inter; }
    float dsum = 0.f;
    const int vrow = lane >> 3, vseg = lane & 7;
    const int i16 = lane & 15, q4 = i16 >> 2, p4 = i16 & 3, blk = (lane >> 4) & 1;
    const int vtr0 = (4 * hh + q4) * VP + (16 * blk + 4 * p4) * 2;
    LAS unsigned char* vl = wl;
    unsigned loff[4];
#pragma unroll
    for (int i = 0; i < 4; ++i) loff[i] = (unsigned)((vrow + 8 * i) * 256 + 8 * vseg) * 2u;
#define B3_LOAD(KT, KF, VV) do { const size_t tb_ = (rowc + 32 * (KT)) * 256 + h * 64; const char* kb_ = (const char*)(Km + tb_); const char* vb_ = (const char*)(Vm + tb_); \
        _Pragma("unroll") for (int i = 0; i < 4; ++i) { KF[i] = *(const u32x4*)(kb_ + loff[i]); VV[i] = *(const u32x4*)(vb_ + loff[i]); } } while (0)
#define B3_TILE(KT, KF, VV) do { \
        KT_WRITE(kl, KF); \
        _Pragma("unroll") for (int i = 0; i < 4; ++i) *(LAS u32x4*)(vl + (vrow + 8 * i) * VP + vseg * 16) = VV[i]; \
        f32x16 sc; \
        _Pragma("unroll") for (int i = 0; i < 16; ++i) sc[i] = 0.f; \
        _Pragma("unroll") for (int d0 = 0; d0 < 4; ++d0) sc = MFMA32(KT_FRAG(kl, d0), qf[d0], sc); \
        _Pragma("unroll") for (int g = 0; g < 4; ++g) { \
            const f32x4 av = *(const LAS f32x4*)(atab + 32 * (KT) + 8 * g + 4 * hh); \
            _Pragma("unroll") for (int e = 0; e < 4; ++e) { const int i = 4 * g + e; float dm = __expf(av[e] - M_t); if ((KT) == qt && crow(i, hh) > r) dm = 0.f; const float pv = sc[i] * dm; sc[i] = pv; dsum += pv; } } \
        const bf16x8 pb0 = pack8(sc, 0), pb1 = pack8(sc, 1); \
        n0 = MFMA32(vt_frag(vl, vtr0, 0, 0), pb0, n0); n0 = MFMA32(vt_frag(vl, vtr0, 1, 0), pb1, n0); \
        n1 = MFMA32(vt_frag(vl, vtr0, 0, 1), pb0, n1); n1 = MFMA32(vt_frag(vl, vtr0, 1, 1), pb1, n1); } while (0)
    {
        u32x4 kA[4], kB[4], vA[4], vB[4];
        LAS unsigned char* kl = wl + 8192;
        int kt = 0;
        B3_LOAD(kt, kA, vA);
#pragma unroll 1
        for (;;) {
            if (kt < qt) B3_LOAD(kt + 1, kB, vB);
            B3_TILE(kt, kA, vA);
            if (kt == qt) break;
            ++kt;
            if (kt < qt) B3_LOAD(kt + 1, kA, vA);
            B3_TILE(kt, kB, vB);
            if (kt == qt) break;
            ++kt;
        }
    }
#undef B3_LOAD
#undef B3_TILE
    float ds0, ds1; halves(dsum, ds0, ds1);
    const float den = inter * qn + (ds0 + ds1);
    const float hinv = 1.f / fmaxf(fabsf(den), __expf(-m_t));
    float ss = 0.f;
#pragma unroll
    for (int g = 0; g < 4; ++g) {
        const int d0 = 8 * g + 4 * hh;
        const u32x2 ga = oga[g], gb = ogb[g];
        const float oa[4] = {__uint_as_float(ga.x << 16), __uint_as_float(ga.x & 0xffff0000u), __uint_as_float(ga.y << 16), __uint_as_float(ga.y & 0xffff0000u)};
        const float ob[4] = {__uint_as_float(gb.x << 16), __uint_as_float(gb.x & 0xffff0000u), __uint_as_float(gb.y << 16), __uint_as_float(gb.y & 0xffff0000u)};
#pragma unroll
        for (int e = 0; e < 4; ++e) { const float va = sigmoidf_(oa[e]) * n0[4 * g + e] * hinv, vb = sigmoidf_(ob[e]) * n1[4 * g + e] * hinv; n0[4 * g + e] = va; n1[4 * g + e] = vb; ss += va * va + vb * vb; }
    }
    float s0, s1; halves(ss, s0, s1);
    const float rs = rsqrtf((s0 + s1) * (1.f / 64.f) + EPS);
    bf16_t* yr = (bf16_t*)(a.ws + WS_Y) + rowq * 1024 + h * 64;
#pragma unroll
    for (int g = 0; g < 4; ++g) {
        const int d0 = 8 * g + 4 * hh;
        const f32x4 ga = gha[g], gb = ghb[g];
        u32x2 wa, wb; wa.x = cvtpk(n0[4 * g] * rs * ga[0], n0[4 * g + 1] * rs * ga[1]); wa.y = cvtpk(n0[4 * g + 2] * rs * ga[2], n0[4 * g + 3] * rs * ga[3]);
        wb.x = cvtpk(n1[4 * g] * rs * gb[0], n1[4 * g + 1] * rs * gb[1]); wb.y = cvtpk(n1[4 * g + 2] * rs * gb[2], n1[4 * g + 3] * rs * gb[3]);
        *(u32x2*)(yr + d0) = wa; *(u32x2*)(yr + 32 + d0) = wb;
    }
}
__device__ __forceinline__ void phase_ml_b1(const Args& a, int l, LAS unsigned char* lds, int gw, int ngw, int wave_) {
    for (int it = gw; it < NB * 4 * 32 * 2; it += ngw) ml_b1_item(a, l, lds + wave_ * 16384, it / 256, (it / 64) & 3, (it >> 1) & 31, it & 1);
}
__device__ __forceinline__ void phase_ml_b3(const Args& a, int l, LAS unsigned char* lds, int gw, int ngw, int wave_) {
    const int lane = lane_id_opaque();
    for (int it = gw, k = 0; it < NB * 4 * 32 * 4; it += ngw, ++k) ml_b3_item(a, l, lds + wave_ * 16384, it / 512, (it / 128) & 3, (it >> 2) & 31, (k & 1) ? (it & 3) : 3 - (it & 3), lane);
}

__device__ __forceinline__ Args load_args() {
#if defined(__HIP_DEVICE_COMPILE__)
    typedef const __attribute__((address_space(4))) Args* KArgs;
    KArgs p_ = (KArgs)__builtin_amdgcn_kernarg_segment_ptr(); asm volatile("" : "+s"(p_)); return *p_;
#else
    return Args{};
#endif
}
#define KA() load_args()
__global__ void __launch_bounds__(NWAVES * 64, 2) fwd(Args a_unused) {
    extern __shared__ __attribute__((aligned(16))) unsigned char lds_raw[];
    LAS unsigned char* lds = (LAS unsigned char*)lds_raw;
    const int wave = __builtin_amdgcn_readfirstlane((int)threadIdx.x >> 6);
    const int G = gridDim.x, gw = blockIdx.x * NWAVES + wave, ngw = G * NWAVES;
    volatile LAS unsigned* MISC = (volatile LAS unsigned*)(lds + MISC_OFF);
    { const int t0 = wave * 64 + lane_id_opaque(); if (t0 < 32) MISC[t0] = 0u; }
    __syncthreads();
#if defined(MK_SPLIT)
    int lo, hi; unsigned* ctl; { const Args a = KA(); ctl = (unsigned*)(a.ws + WS_CTL); lo = a.ph_lo; hi = a.ph_hi; }
#else
    constexpr int lo = 0, hi = 22; unsigned* ctl; { const Args a = KA(); ctl = (unsigned*)(a.ws + WS_CTL); }
#endif
    XcdBarrier bar; bar.bar = ctl + CW_BAR; bar.x = 0; bar.st = nullptr;
    if (hi - lo > 1) bar = xcd_barrier_post(ctl + CW_BAR, MISC + 8, wave == 0 && lane_id_opaque() == 0);
#define IN(k) (lo <= (k) && (k) < hi)
#ifndef DISMASK
#define DISMASK 0
#endif
#define DIS(k) ((DISMASK >> (k)) & 1)
#ifndef REPMASK
#define REPMASK 0
#endif
#define NREP(k) ((((REPMASK) >> (k)) & 1) ? (1 + opaque_one()) : 1)
#define REPSYNC(k) do { if (rep_ + 1 < nrep_) xcd_barrier(bar, wave); } while (0)
#ifdef TS_PHASE
#define SEAM(k) do { if (IN(k) && IN((k) + 1)) { xcd_barrier(bar, wave); if (blockIdx.x == 0 && wave == 0 && lane_id_opaque() == 0) ((unsigned long long*)(ctl + 12288))[(k) + 1] = __builtin_amdgcn_s_memrealtime(); } } while (0)
#else
#define SEAM(k) do { if (IN(k) && IN((k) + 1)) xcd_barrier(bar, wave); } while (0)
#endif
    if (IN(0) && !DIS(0)) _Pragma("unroll 1") for (int rep_ = 0, nrep_ = NREP(0); rep_ < nrep_; ++rep_) { const Args a = KA(); phase_prologue(a, lds, gw, ngw, wave); REPSYNC(0); }
    SEAM(0);
    for (int l = 0; l < 2; ++l) {
        const int pb = 1 + 10 * l;
        if (IN(pb + 0) && !DIS(1)) _Pragma("unroll 1") for (int rep_ = 0, nrep_ = NREP(1); rep_ < nrep_; ++rep_) { const Args a = KA(); if (l == 0) phase_norm<1, false>(a, l, a.x, lds, gw, ngw, wave); else phase_norm<1, true>(a, l, a.out, lds, gw, ngw, wave); __syncthreads(); REPSYNC(1); }
        SEAM(pb + 0);
        if (IN(pb + 1) && !DIS(2)) _Pragma("unroll 1") for (int rep_ = 0, nrep_ = NREP(2); rep_ < nrep_; ++rep_) { const Args a = KA();
            ProbDense P{(const char*)(a.ws + WS_H), (const char*)(a.ws + WS_WIN) + (size_t)l * LDU * 1024 * 2, 1024};
            pg8::StaticOrder S; S.init(T_TOK / 256, LDU / 256, G, (int)blockIdx.x);
            EpiU E{(bf16_t*)(a.ws + WS_U)};
            pg8::gemm_phase(lds, P, S, E, wave);
            if (l == 0) tp_tail(a, (T_TOK / 256) * (LDU / 256), G, 0, TP_TAIL_INPROJ, lds, wave);
            REPSYNC(2);
        }
        SEAM(pb + 1);
        if (IN(pb + 2) && !DIS(8)) { const Args a = KA();
            _Pragma("unroll 1") for (int rep_ = 0, nrep_ = NREP(11); rep_ < nrep_; ++rep_) { phase_ml_b1(a, l, lds, gw, ngw, wave); REPSYNC(11); }
            _Pragma("unroll 1") for (int rep_ = 0, nrep_ = NREP(12); rep_ < nrep_; ++rep_) { phase_sb(a, l, lds, gw, ngw, wave); REPSYNC(12); }
            phase_dil(a, l, lds, gw, ngw, wave, 0, 1); }
        SEAM(pb + 2);
        if (IN(pb + 3) && !DIS(9)) { const Args a = KA();
            _Pragma("unroll 1") for (int rep_ = 0, nrep_ = NREP(13); rep_ < nrep_; ++rep_) { phase_ml_b2(a, (int)blockIdx.x * (NWAVES * 64) + wave * 64 + lane_id_opaque(), G * NWAVES * 64); REPSYNC(13); }
            _Pragma("unroll 1") for (int rep_ = 0, nrep_ = NREP(14); rep_ < nrep_; ++rep_) { phase_dil(a, l, lds, gw, ngw, wave, 1, 3); REPSYNC(14); } }
        SEAM(pb + 3);
        if (IN(pb + 4) && !DIS(10)) { const Args a = KA();
            _Pragma("unroll 1") for (int rep_ = 0, nrep_ = NREP(15); rep_ < nrep_; ++rep_) { phase_ml_b3(a, l, lds, gw, ngw, wave); REPSYNC(15); }
            _Pragma("unroll 1") for (int rep_ = 0, nrep_ = NREP(16); rep_ < nrep_; ++rep_) { phase_dil_merge(a, l, gw, ngw); REPSYNC(16); } }
        SEAM(pb + 4);
        if (IN(pb + 5) && !DIS(3)) _Pragma("unroll 1") for (int rep_ = 0, nrep_ = ((l == 0) ? NREP(3) : 1); rep_ < nrep_; ++rep_) { const Args a = KA(); const float* xin = (l == 0) ? a.x : a.out; const float* modl = (const float*)(a.ws + WS_MOD) + (size_t)l * 8 * NMOD;
            ProbDense P{(const char*)(a.ws + WS_Y), (const char*)(a.ws + WS_WOUT) + (size_t)l * 1024 * 1024 * 2, 1024};
            pg8::StaticOrder S; S.init(T_TOK / 256, 4, G, (int)blockIdx.x);
            if (l == 0) { EpiOut<false> E{a.x, (bf16_t*)a.out, modl + 2048}; pg8::gemm_phase(lds, P, S, E, wave); }
            else { EpiOut<true> E{a.out, (bf16_t*)a.out, modl + 2048}; pg8::gemm_phase(lds, P, S, E, wave); }
            if (l == 0) REPSYNC(3);
        }
        SEAM(pb + 5);
        if (IN(pb + 6) && !DIS(4)) _Pragma("unroll 1") for (int rep_ = 0, nrep_ = NREP(4); rep_ < nrep_; ++rep_) { const Args a = KA(); phase_norm<2, true>(a, (rep_ + 1 < nrep_) ? l + 2 : l, a.out, lds, gw, ngw, wave); __syncthreads(); REPSYNC(4); }
        SEAM(pb + 6);
        if (IN(pb + 7) && !DIS(5)) _Pragma("unroll 1") for (int rep_ = 0, nrep_ = NREP(5); rep_ < nrep_; ++rep_) { const Args a = KA();
            LAS int* tab = (LAS int*)(lds + TAB_OFF); build_moe_tab(a, l, tab, wave);
            const int nMt = tab[352];
            ProbGU P{(const char*)(a.ws + WS_H), (const char*)(a.ws + WS_WGU) + (size_t)l * 16 * 1024 * 1024 * 2, (const int*)(a.ws + WS_LIST), tab};
            pg8::StaticOrder S; S.init(nMt, 8, G, (int)blockIdx.x);
            EpiGU E{(bf16_t*)(a.ws + WS_U), (const int*)(a.ws + WS_LIST), (const float*)(a.ws + WS_RW), tab};
            pg8::gemm_phase(lds, P, S, E, wave);
            if (l == 0) tp_tail(a, nMt * 8, G, TP_N_MOE / 2, TP_N_MOE / 2 + 5120, lds, wave);
            REPSYNC(5);
        }
        SEAM(pb + 7);
        if (IN(pb + 8) && !DIS(6)) _Pragma("unroll 1") for (int rep_ = 0, nrep_ = NREP(6); rep_ < nrep_; ++rep_) { const Args a = KA(); const float* modl = (const float*)(a.ws + WS_MOD) + (size_t)l * 8 * NMOD;
            LAS int* tab = (LAS int*)(lds + TAB_OFF); build_moe_tab(a, l, tab, wave);
            const int nMt = tab[352];
            ProbDown P{(const char*)(a.ws + WS_U), (const char*)(a.ws + WS_WD) + (size_t)l * 16 * 1024 * 512 * 2, tab};
            pg8::StaticOrder S; S.init(nMt, 4, G, (int)blockIdx.x);
            EpiDown E{(const bf16_t*)a.out, (rep_ + 1 < nrep_) ? (bf16_t*)(a.ws + WS_Y) : ((l == 1) ? (bf16_t*)(a.ws + WS_H) : (bf16_t*)a.out), (const int*)(a.ws + WS_LIST), modl + 5120, tab};
            pg8::gemm_phase(lds, P, S, E, wave);
            if (l == 0) tp_tail(a, nMt * 4, G, TP_N_MOE / 2 + 5120, TP_N_MOE, lds, wave);
            REPSYNC(6);
        }
        SEAM(pb + 8);
    }
#if defined(TS_DIL)
    if (IN(21)) { const Args a = KA(); const unsigned long long* st = (const unsigned long long*)(ctl + 12288);
        const float eps = (float)(long long)st[40] * 0.01f * TS_SCALE; phase_final(a, gw, ngw, 1.f + eps, bar, wave); }
#elif defined(TS_PHASE)
    if (IN(21)) { const Args a = KA(); const unsigned long long* st = (const unsigned long long*)(ctl + 12288);
        const float eps = (float)(long long)(st[TS_PHASE + 1] - st[TS_PHASE]) * 0.01f * TS_SCALE; phase_final(a, gw, ngw, 1.f + eps, bar, wave); }
#else
    if (IN(21) && !DIS(7)) { const Args a = KA(); phase_final(a, gw, ngw, 1.f, bar, wave); }
#endif
#undef IN
#undef SEAM
}

extern "C" void kernel_launch(void* const* d_in, const int* in_sizes, int n_in, void* d_out, int out_size, void* d_ws, size_t ws_size, hipStream_t stream) {
    static int grid = 0;
    if (grid == 0) {
        int dev = 0, cus = 0;
        if (ws_size < WS_END) { fprintf(stderr, "kernel_launch: workspace too small (%zu < %zu)\n", ws_size, (size_t)WS_END); grid = -1; return; }
        if (hipGetDevice(&dev) != hipSuccess || hipDeviceGetAttribute(&cus, hipDeviceAttributeMultiprocessorCount, dev) != hipSuccess) { grid = -1; return; }
        if (hipFuncSetAttribute((const void*)fwd, hipFuncAttributeMaxDynamicSharedMemorySize, LDS_BYTES) != hipSuccess) { fprintf(stderr, "kernel_launch: hipFuncSetAttribute failed\n"); grid = -1; return; }
        (void)hipGetLastError();
        grid = 256;
        if (cus < 256) { fprintf(stderr, "kernel_launch: needs 256 CUs, device has %d\n", cus); grid = -1; return; }
    }
    if (grid < 0) return;
    Args a{};
    a.x = (const float*)d_in[0]; a.c = (const float*)d_in[1]; a.w_in = (const float*)d_in[2]; a.conv_w = (const float*)d_in[3]; a.conv_b = (const float*)d_in[4];
    a.w_mq = (const float*)d_in[5]; a.w_mk = (const float*)d_in[6]; a.w_mv = (const float*)d_in[7]; a.gate_bias = (const float*)d_in[8]; a.g_head = (const float*)d_in[9];
    a.w_out = (const float*)d_in[10]; a.w_ada = (const float*)d_in[11]; a.b_ada = (const float*)d_in[12]; a.w_router = (const float*)d_in[13]; a.router_bias = (const float*)d_in[14];
    a.w_gate_e = (const float*)d_in[15]; a.w_up_e = (const float*)d_in[16]; a.w_down_e = (const float*)d_in[17]; a.g_final = (const float*)d_in[18];
    a.out = (float*)d_out; a.ws = (unsigned char*)d_ws;
    char* ws = (char*)d_ws;
    (void)hipMemsetAsync(ws + WS_CTL, 0, CTL_BYTES, stream);
    float* gate = (float*)(ws + WS_GATE); bf16_t* U = (bf16_t*)(ws + WS_U);
    bf16_t* Y = (bf16_t*)(ws + WS_Y); bf16_t* Qm = (bf16_t*)(ws + WS_QKV); bf16_t* Km = Qm + (size_t)T_TOK * 256; bf16_t* Vm = Km + (size_t)T_TOK * 256;
#define RUN(lo_, hi_) do { a.ph_lo = (lo_); a.ph_hi = (hi_); hipLaunchKernelGGL(fwd, dim3(grid), dim3(NWAVES * 64), LDS_BYTES, stream, a); } while (0)
#if defined(MK_SPLIT)
    RUN(0, 1);
    for (int l = 0; l < 2; ++l) { const int pb = 1 + 10 * l; for (int k = 0; k < 9; ++k) RUN(pb + k, pb + k + 1); }
    RUN(21, 22);
#else
    RUN(0, 22);
#endif
#undef RUN
}
```
